# Optimizing an MI355X kernel written in HIP

```python
import math
import jax, jax.numpy as jnp
from jax import lax
import numpy as np

D_MODEL = 1024
BATCH = 2
SEQ = 16384
DEPTH = 1
DEC_BATCH = 16
DEC_SEQ = 32
PAST_LEN = 1024

CHUNK = 64
N_META = 16
FFN_DIM = ((8 * D_MODEL // 3 + 127) // 128) * 128
NORM_EPS = 1e-6
D_INNER = 2 * D_MODEL
SSM_HEAD_DIM = 64
SSM_HEADS = D_INNER // SSM_HEAD_DIM
SSM_GROUPS = 4
SSM_STATE = 128
CONV_WIDTH = 4
CONV_DIM = D_INNER + 2 * SSM_GROUPS * SSM_STATE
SSD_BLOCK = 64
MLA_HEADS = D_MODEL // 64
Q_LORA = 3 * D_MODEL // 8
KV_LORA = D_MODEL // 4
QK_NOPE_DIM = 64
QK_ROPE_DIM = 32
V_HEAD_DIM = 64
ROPE_THETA = 10000.0
Q_BLOCK = 128
OFF_Z = 0
OFF_XBC = OFF_Z + D_INNER
OFF_DT = OFF_XBC + CONV_DIM
OFF_CQ = OFF_DT + SSM_HEADS
OFF_CKV = OFF_CQ + Q_LORA
OFF_KROPE = OFF_CKV + KV_LORA
OFF_GATE = OFF_KROPE + QK_ROPE_DIM
IN_DIM = OFF_GATE + 2 * D_MODEL

kernel_name = 'hybrid_ssd_mla_streaming_encoder_step'


def rmsnorm(x, g):
    xf = x.astype(jnp.float32)
    y = xf * lax.rsqrt(jnp.mean(xf * xf, axis=-1, keepdims=True) + NORM_EPS)
    return (y * g.astype(jnp.float32)).astype(x.dtype)


def swiglu(xn, w_gu, w_down):
    gu = xn @ w_gu
    return (jax.nn.silu(gu[..., :FFN_DIM]) * gu[..., FFN_DIM:]) @ w_down


def rope(x, pos):
    half = x.shape[-1] // 2
    inv = ROPE_THETA ** (-jnp.arange(half, dtype=jnp.float32) / half)
    ang = pos.astype(jnp.float32)[:, None] * inv[None, :]
    shape = (1, pos.shape[0]) + (1,) * (x.ndim - 3) + (half,)
    cos = jnp.cos(ang).reshape(shape)
    sin = jnp.sin(ang).reshape(shape)
    xf = x.astype(jnp.float32)
    x1, x2 = xf[..., :half], xf[..., half:]
    return jnp.concatenate([x1 * cos - x2 * sin, x1 * sin + x2 * cos], axis=-1).astype(x.dtype)


def ssd_scan(x, dt, A, B, C, state0):
    b, t, nh, hp = x.shape
    ng, ns = B.shape[2], B.shape[3]
    hg = nh // ng
    pad = (-t) % SSD_BLOCK
    nc = (t + pad) // SSD_BLOCK

    def blocks(a, tail):
        a = jnp.pad(a.astype(jnp.float32), [(0, 0), (0, pad)] + [(0, 0)] * (a.ndim - 2))
        return jnp.moveaxis(a.reshape((b, nc, SSD_BLOCK) + tail), 1, 0)

    xc = blocks(x.reshape(b, t, ng, hg, hp), (ng, hg, hp))
    dtc = blocks(dt.reshape(b, t, ng, hg), (ng, hg))
    bc = blocks(B, (ng, ns))
    cc = blocks(C, (ng, ns))
    a_g = A.astype(jnp.float32).reshape(ng, hg)
    causal = jnp.tril(jnp.ones((SSD_BLOCK, SSD_BLOCK), dtype=bool))

    def step(state, inp):
        xk, dtk, bk, ck = inp
        a_cs = jnp.cumsum(dtk * a_g, axis=1)
        seg = a_cs[:, :, None] - a_cs[:, None, :]
        decay = jnp.exp(jnp.where(causal[None, :, :, None, None], seg, -jnp.inf))
        cb = jnp.einsum('bign,bjgn->bijg', ck, bk)
        xdt = dtk[..., None] * xk
        y = jnp.einsum('bijg,bijgh,bjghp->bighp', cb, decay, xdt)
        y = y + jnp.einsum('bign,bghpn->bighp', ck, state) * jnp.exp(a_cs)[..., None]
        total = a_cs[:, -1]
        w = jnp.exp(total[:, None] - a_cs)[..., None] * xdt
        state = state * jnp.exp(total)[..., None, None] + jnp.einsum('bjgn,bjghp->bghpn', bk, w)
        return state, y

    s0 = state0.astype(jnp.float32).reshape(b, ng, hg, hp, ns)
    s_t, ys = lax.scan(step, s0, (xc, dtc, bc, cc))
    y = jnp.moveaxis(ys, 0, 1).reshape(b, nc * SSD_BLOCK, nh, hp)[:, :t]
    return y, s_t.reshape(b, nh, hp, ns)


def ssd_branch(z, xbc, dt_raw, conv_prev, ssm_prev, lp):
    b, t = xbc.shape[:2]
    if conv_prev is None:
        conv_prev = jnp.zeros((b, CONV_WIDTH - 1, CONV_DIM), xbc.dtype)
    if ssm_prev is None:
        ssm_prev = jnp.zeros((b, SSM_HEADS, SSM_HEAD_DIM, SSM_STATE), jnp.float32)
    full = jnp.concatenate([conv_prev.astype(xbc.dtype), xbc], axis=1)
    conv_w = lp['conv_w']
    conv = lp['conv_b'] + full[:, 0:t] * conv_w[0]
    for k in range(1, CONV_WIDTH):
        conv = conv + full[:, k:k + t] * conv_w[k]
    xbc_c = jax.nn.silu(conv)
    xs = xbc_c[..., :D_INNER].reshape(b, t, SSM_HEADS, SSM_HEAD_DIM)
    bm = xbc_c[..., D_INNER:D_INNER + SSM_GROUPS * SSM_STATE].reshape(b, t, SSM_GROUPS, SSM_STATE)
    cm = xbc_c[..., D_INNER + SSM_GROUPS * SSM_STATE:].reshape(b, t, SSM_GROUPS, SSM_STATE)
    dt = jax.nn.softplus(dt_raw.astype(jnp.float32) + lp['dt_bias'].astype(jnp.float32))
    a = -jnp.exp(lp['a_log'].astype(jnp.float32))
    y, ssm_new = ssd_scan(xs, dt, a, bm, cm, ssm_prev)
    y = y + lp['ssm_d'].astype(jnp.float32)[:, None] * xs.astype(jnp.float32)
    y = y.reshape(b, t, D_INNER) * jax.nn.silu(z.astype(jnp.float32))
    yg = y.reshape(b, t, SSM_GROUPS, D_INNER // SSM_GROUPS)
    yg = yg * lax.rsqrt(jnp.mean(yg * yg, axis=-1, keepdims=True) + NORM_EPS)
    y = (yg.reshape(b, t, D_INNER) * lp['ssm_norm'].astype(jnp.float32)).astype(z.dtype)
    return y @ lp['ssm_w_out'], full[:, -(CONV_WIDTH - 1):], ssm_new


def chunk_causal_attention(q_nope, q_rope, k_nope, k_rope, v, q_chunk, k_chunk):
    b, t = q_nope.shape[:2]
    scale = (QK_NOPE_DIM + QK_ROPE_DIM) ** -0.5

    def attend(blk):
        qn, qr, qc = blk
        s = jnp.einsum('bqhd,bkhd->bhqk', qn, k_nope) + jnp.einsum('bqhd,bkd->bhqk', qr, k_rope)
        visible = k_chunk[None, :] <= qc[:, None]
        s = jnp.where(visible[None, None], s.astype(jnp.float32) * scale, -jnp.inf)
        p = jax.nn.softmax(s, axis=-1).astype(v.dtype)
        return jnp.einsum('bhqk,bkhd->bqhd', p, v)

    if t <= Q_BLOCK:
        return attend((q_nope, q_rope, q_chunk))
    pad = (-t) % Q_BLOCK
    nb = (t + pad) // Q_BLOCK

    def blocks(a):
        a = jnp.pad(a, [(0, 0), (0, pad)] + [(0, 0)] * (a.ndim - 2))
        return jnp.moveaxis(a.reshape((b, nb, Q_BLOCK) + a.shape[2:]), 1, 0)

    qc = jnp.pad(q_chunk, (0, pad), mode='edge').reshape(nb, Q_BLOCK)
    out = lax.map(attend, (blocks(q_nope), blocks(q_rope), qc))
    out = jnp.moveaxis(out, 0, 1).reshape(b, nb * Q_BLOCK, MLA_HEADS, V_HEAD_DIM)
    return out[:, :t]


def mla_branch(cq, q_pos, k_ckv, k_rope, k_pos, lp):
    b, t = cq.shape[:2]
    nk = k_ckv.shape[1]
    q = (rmsnorm(cq, lp['q_norm']) @ lp['w_uq']).reshape(b, t, MLA_HEADS, QK_NOPE_DIM + QK_ROPE_DIM)
    q_nope = q[..., :QK_NOPE_DIM]
    q_rope = rope(q[..., QK_NOPE_DIM:], q_pos)
    kv = (k_ckv @ lp['w_ukv']).reshape(b, nk, MLA_HEADS, QK_NOPE_DIM + V_HEAD_DIM)
    o = chunk_causal_attention(q_nope, q_rope, kv[..., :QK_NOPE_DIM], k_rope, kv[..., QK_NOPE_DIM:],
                               q_pos // CHUNK, k_pos // CHUNK)
    return o.reshape(b, t, MLA_HEADS * V_HEAD_DIM) @ lp['mla_w_out']


def pre_mix(x, lp):
    h = x + 0.5 * swiglu(rmsnorm(x, lp['ffn1_norm']), lp['ffn1_w_gu'], lp['ffn1_w_down'])
    return h, rmsnorm(h, lp['mix_norm'])


def kv_rows(kvp, pos, lp):
    return rmsnorm(kvp[..., :KV_LORA], lp['kv_norm']), rope(kvp[..., KV_LORA:], pos)


def run_layer(x, pos, prefix, conv_prev, ssm_prev, lp):
    h, u = pre_mix(x, lp)
    proj = u @ lp['w_in']
    y_s, conv_new, ssm_new = ssd_branch(proj[..., OFF_Z:OFF_XBC], proj[..., OFF_XBC:OFF_DT],
                                        proj[..., OFF_DT:OFF_CQ], conv_prev, ssm_prev, lp)
    ckv, krope = kv_rows(proj[..., OFF_CKV:OFF_GATE], pos, lp)
    if prefix is None:
        keys_ckv, keys_kr, k_pos = ckv, krope, pos
    else:
        p_ckv, p_kr, p_pos = prefix
        keys_ckv = jnp.concatenate([p_ckv.astype(ckv.dtype), ckv], axis=1)
        keys_kr = jnp.concatenate([p_kr.astype(krope.dtype), krope], axis=1)
        k_pos = jnp.concatenate([p_pos, pos])
    y_m = mla_branch(proj[..., OFF_CQ:OFF_CKV], pos, keys_ckv, keys_kr, k_pos, lp)
    gates = jax.nn.sigmoid((proj[..., OFF_GATE:] + lp['gate_bias']).astype(jnp.float32)).astype(x.dtype)
    merged = gates[..., :D_MODEL] * y_s + gates[..., D_MODEL:] * y_m
    h = h + merged @ lp['w_mix_out']
    h = h + 0.5 * swiglu(rmsnorm(h, lp['ffn2_norm']), lp['ffn2_w_gu'], lp['ffn2_w_down'])
    return h, (ckv, krope, ssm_new, conv_new)


def setup_inputs(seed: int = 0) -> dict:
    key = jax.random.key(seed)
    ks = jax.random.split(key, 32)
    f32 = jnp.float32
    L = DEPTH

    def nrm(k, shape, scale):
        return jax.random.normal(k, shape, f32) * scale

    def gain(k, shape):
        return 1.0 + 0.02 * jax.random.normal(k, shape, f32)

    dt0 = jnp.exp(jax.random.uniform(ks[15], (L, SSM_HEADS), f32, math.log(1e-3), math.log(1e-1)))
    return {
        'x_prompt': nrm(ks[0], (BATCH, SEQ, D_MODEL), 1.0),
        'x_sample': nrm(ks[1], (DEC_BATCH, DEC_SEQ, D_MODEL), 1.0),
        'cache_ckv': nrm(ks[2], (L, DEC_BATCH, PAST_LEN, KV_LORA), 1.0),
        'cache_krope': nrm(ks[3], (L, DEC_BATCH, PAST_LEN, QK_ROPE_DIM), 1.0),
        'state_ssm': nrm(ks[4], (L, DEC_BATCH, SSM_HEADS, SSM_HEAD_DIM, SSM_STATE), 0.5),
        'state_conv': nrm(ks[5], (L, DEC_BATCH, CONV_WIDTH - 1, CONV_DIM), 1.0),
        'meta_tokens': nrm(ks[6], (N_META, D_MODEL), 1.0),
        'ffn1_norm': gain(ks[7], (L, D_MODEL)),
        'ffn1_w_gu': nrm(ks[8], (L, D_MODEL, 2 * FFN_DIM), D_MODEL ** -0.5),
        'ffn1_w_down': nrm(ks[9], (L, FFN_DIM, D_MODEL), FFN_DIM ** -0.5),
        'mix_norm': gain(ks[10], (L, D_MODEL)),
        'w_in': nrm(ks[11], (L, D_MODEL, IN_DIM), D_MODEL ** -0.5),
        'gate_bias': nrm(ks[12], (L, 2 * D_MODEL), 0.1),
        'conv_w': nrm(ks[13], (L, CONV_WIDTH, CONV_DIM), CONV_WIDTH ** -0.5),
        'conv_b': nrm(ks[14], (L, CONV_DIM), 0.02),
        'dt_bias': dt0 + jnp.log(-jnp.expm1(-dt0)),
        'a_log': jnp.log(jax.random.uniform(ks[16], (L, SSM_HEADS), f32, 1.0, 16.0)),
        'ssm_d': 1.0 + 0.1 * jax.random.normal(ks[17], (L, SSM_HEADS), f32),
        'ssm_norm': gain(ks[18], (L, D_INNER)),
        'ssm_w_out': nrm(ks[19], (L, D_INNER, D_MODEL), D_INNER ** -0.5),
        'q_norm': gain(ks[20], (L, Q_LORA)),
        'w_uq': nrm(ks[21], (L, Q_LORA, MLA_HEADS * (QK_NOPE_DIM + QK_ROPE_DIM)), Q_LORA ** -0.5),
        'kv_norm': gain(ks[22], (L, KV_LORA)),
        'w_ukv': nrm(ks[23], (L, KV_LORA, MLA_HEADS * (QK_NOPE_DIM + V_HEAD_DIM)), KV_LORA ** -0.5),
        'mla_w_out': nrm(ks[24], (L, MLA_HEADS * V_HEAD_DIM, D_MODEL), (MLA_HEADS * V_HEAD_DIM) ** -0.5),
        'w_mix_out': nrm(ks[25], (L, D_MODEL, D_MODEL), D_MODEL ** -0.5),
        'ffn2_norm': gain(ks[26], (L, D_MODEL)),
        'ffn2_w_gu': nrm(ks[27], (L, D_MODEL, 2 * FFN_DIM), D_MODEL ** -0.5),
        'ffn2_w_down': nrm(ks[28], (L, FFN_DIM, D_MODEL), FFN_DIM ** -0.5),
        'final_norm': gain(ks[29], (D_MODEL,)),
    }


def reference(x_prompt, x_sample, cache_ckv, cache_krope, state_ssm, state_conv, meta_tokens,
              ffn1_norm, ffn1_w_gu, ffn1_w_down, mix_norm, w_in, gate_bias, conv_w, conv_b,
              dt_bias, a_log, ssm_d, ssm_norm, ssm_w_out, q_norm, w_uq, kv_norm, w_ukv, mla_w_out,
              w_mix_out, ffn2_norm, ffn2_w_gu, ffn2_w_down, final_norm):
    b, seq = x_prompt.shape[:2]
    db, dseq = x_sample.shape[:2]
    past = cache_ckv.shape[2]
    meta = meta_tokens.astype(x_prompt.dtype)[None]
    meta_pos = jnp.arange(N_META, dtype=jnp.int32) - N_META
    p_pos = jnp.arange(N_META + seq, dtype=jnp.int32) - N_META
    s_pos = past + jnp.arange(dseq, dtype=jnp.int32)
    prefix_pos = jnp.concatenate([meta_pos, jnp.arange(past, dtype=jnp.int32)])

    hp = jnp.concatenate([jnp.broadcast_to(meta, (b, N_META, D_MODEL)), x_prompt], axis=1)
    hs = x_sample
    hm = meta
    ckv_p, kr_p, ssm_p, conv_p = [], [], [], []
    ckv_s, kr_s, ssm_s, conv_s = [], [], [], []
    for l in range(DEPTH):
        lp = {'ffn1_norm': ffn1_norm[l], 'ffn1_w_gu': ffn1_w_gu[l], 'ffn1_w_down': ffn1_w_down[l],
              'mix_norm': mix_norm[l], 'w_in': w_in[l], 'gate_bias': gate_bias[l],
              'conv_w': conv_w[l], 'conv_b': conv_b[l], 'dt_bias': dt_bias[l], 'a_log': a_log[l],
              'ssm_d': ssm_d[l], 'ssm_norm': ssm_norm[l], 'ssm_w_out': ssm_w_out[l],
              'q_norm': q_norm[l], 'w_uq': w_uq[l], 'kv_norm': kv_norm[l], 'w_ukv': w_ukv[l],
              'mla_w_out': mla_w_out[l], 'w_mix_out': w_mix_out[l], 'ffn2_norm': ffn2_norm[l],
              'ffn2_w_gu': ffn2_w_gu[l], 'ffn2_w_down': ffn2_w_down[l]}
        hp, st = run_layer(hp, p_pos, None, None, None, lp)
        ckv_p.append(st[0]); kr_p.append(st[1]); ssm_p.append(st[2]); conv_p.append(st[3])
        _, um = pre_mix(hm, lp)
        m_ckv, m_kr = kv_rows(um @ lp['w_in'][:, OFF_CKV:OFF_GATE], meta_pos, lp)
        prefix = (jnp.concatenate([jnp.broadcast_to(m_ckv, (db, N_META, KV_LORA)), cache_ckv[l].astype(m_ckv.dtype)], axis=1),
                  jnp.concatenate([jnp.broadcast_to(m_kr, (db, N_META, QK_ROPE_DIM)), cache_krope[l].astype(m_kr.dtype)], axis=1),
                  prefix_pos)
        hs, st = run_layer(hs, s_pos, prefix, state_conv[l], state_ssm[l], lp)
        ckv_s.append(st[0]); kr_s.append(st[1]); ssm_s.append(st[2]); conv_s.append(st[3])
        if l + 1 < DEPTH:
            hm = run_layer(hm, meta_pos, None, None, None, lp)[0]

    y_prompt = rmsnorm(hp[:, N_META:], final_norm)
    y_sample = rmsnorm(hs, final_norm)
    return (y_prompt, y_sample,
            jnp.stack(ckv_p), jnp.stack(kr_p), jnp.stack(ssm_p), jnp.stack(conv_p),
            jnp.stack(ckv_s), jnp.stack(kr_s), jnp.stack(ssm_s), jnp.stack(conv_s))
```

```cpp
#include <hip/hip_runtime.h>
#include <hip/hip_cooperative_groups.h>
#include <cstdio>
#include <cstdint>
namespace cg = cooperative_groups;
namespace pg8 {
#define PG8_LAS __attribute__((address_space(3)))
typedef unsigned short bf16_t;
typedef short bf16x8 __attribute__((ext_vector_type(8)));
typedef float f32x4 __attribute__((ext_vector_type(4)));
typedef unsigned u32x4 __attribute__((ext_vector_type(4)));
constexpr int BM = 256, BK = 64, HALF = 128, HTB = HALF * BK * 2  , STAGE_BYTES = 8 * HTB, NXCD = 8, WGM = 8;

__host__ __device__ __forceinline__ int lds_byte(int r, int c) { const int st = (r >> 4) * 2 + (c >> 5), rr = r & 15, cc = c & 31, ob = rr * 64 + cc * 2; return st * 1024 + (ob ^ (((ob >> 9) & 1) << 5)); }
__host__ __device__ __forceinline__ void stage_rc(int b, int& R, int& C) { const int st = b / 1024, sb = b % 1024, swz = sb ^ (((sb >> 9) & 1) << 5); R = (st >> 1) * 16 + swz / 64; C = (st & 1) * 32 + (swz % 64) / 2; }
__host__ __device__ __forceinline__ int perm32(int rho) { const int n = rho >> 4, i = rho & 15; return 8 * (i >> 2) + 4 * n + (i & 3); }

struct Unit { int pm, pn; };
struct Gemm { const bf16_t* A; const bf16_t* Bt; int M, N, K; };

struct StaticOrder {
    int nM, nN, nwg, G, c;
    __host__ __device__ void init(int M, int N, int G_, int c_) { nM = M / BM; nN = N / BM; nwg = nM * nN; G = G_; c = c_; }
    __host__ __device__ bool next(int i, Unit& u) const {
        const long L = (long)i * G + c; if (L >= nwg) return false;
        int wgid = (int)L; { const int q = nwg / NXCD, r = nwg % NXCD, xcd = wgid % NXCD, off = wgid / NXCD; wgid = (xcd < r ? xcd * (q + 1) : r * (q + 1) + (xcd - r) * q) + off; }
        const int nig = WGM * nN, gid = wgid / nig, fm = gid * WGM, gsz = (nM - fm) < WGM ? (nM - fm) : WGM;
        u.pm = fm + ((wgid % nig) % gsz); u.pn = (wgid % nig) / gsz; return true;
    }
    __device__ __forceinline__ void a_ready(const Unit&) const {}
    __device__ __forceinline__ void done(const Unit&) const {}
};
template <class Epi, class Sched, bool ALIGN_EPI = false, bool SP2 = false>
__device__ __forceinline__ void gemm_phase(PG8_LAS unsigned char* lds, const Gemm g, const Sched& S, const Epi& E, const int wid) {
    const int lane = (int)(__builtin_amdgcn_mbcnt_hi(~0u, __builtin_amdgcn_mbcnt_lo(~0u, 0u)) & 63u), tid = wid * 64 + lane, wr = wid >> 2, wc = wid & 3, fr = lane & 15, fq = lane >> 4;
    const int K = g.K, nt = K / BK;
    unsigned voffA[2], voffB[2];
#pragma unroll
    for (int i = 0; i < 2; ++i) { int R, C; stage_rc(tid * 16 + i * 8192, R, C); const int Rb = Epi::PERM ? ((R & ~31) + perm32(R & 31)) : R;
        voffA[i] = (unsigned)(R * K + C) * 2u; voffB[i] = (unsigned)(Rb * K + C) * 2u; }
    const size_t kstep = (size_t)(BK * 2);
    const size_t hstep = (size_t)HALF * K * 2;
    const size_t tstep = 2 * hstep;
    const unsigned ldsw = (unsigned)wid * 1024u;
    const int aoff = lds_byte(wr * 64 + fr, fq * 8), boff = lds_byte(wc * 32 + fr, fq * 8);
#define PG8_SA(b, h) (((b) * 2 + (h)) * HTB)
#define PG8_SB(b, h) ((4 + (b) * 2 + (h)) * HTB)
#define PG8_STAGE(bufoff, gbase, voff) do { _Pragma("unroll") for (int _i = 0; _i < 2; ++_i) \
        __builtin_amdgcn_global_load_lds((const unsigned*)((const char*)(gbase) + (voff)[_i]), (PG8_LAS unsigned*)(lds + (bufoff) + ldsw + _i * 8192), 16, 0, 0); } while (0)
#define PG8_LDA(dst, b, h) do { _Pragma("unroll") for (int m = 0; m < 4; ++m) _Pragma("unroll") for (int k = 0; k < 2; ++k) dst[m][k] = *(const PG8_LAS bf16x8*)(lds + PG8_SA(b, h) + aoff + m * 2048 + k * 1024); } while (0)
#define PG8_LDB(dst, b, h) do { _Pragma("unroll") for (int n = 0; n < 2; ++n) _Pragma("unroll") for (int k = 0; k < 2; ++k) dst[n][k] = *(const PG8_LAS bf16x8*)(lds + PG8_SB(b, h) + boff + n * 2048 + k * 1024); } while (0)
#define PG8_MMA(ai, bj, At, Bt) do { __builtin_amdgcn_s_setprio(1); _Pragma("unroll") for (int m = 0; m < 4; ++m) _Pragma("unroll") for (int n = 0; n < 2; ++n) _Pragma("unroll") for (int k = 0; k < 2; ++k) \
        acc[ai][bj][m][n] = __builtin_amdgcn_mfma_f32_16x16x32_bf16(Bt[n][k], At[m][k], acc[ai][bj][m][n], 0, 0, 0); __builtin_amdgcn_s_setprio(0); } while (0)
#define PG8_WAIT_V(n) asm volatile("s_waitcnt vmcnt(" #n ")" ::: "memory")
#define PG8_WAIT_L(n) asm volatile("s_waitcnt lgkmcnt(" #n ")" ::: "memory")
#define PG8_BAR __builtin_amdgcn_s_barrier()
#define PG8_SCHED __builtin_amdgcn_sched_barrier(0)
    Unit cur, nxt; int ui = 0;
    if (!S.next(0, cur)) return;
    f32x4 acc[2][2][4][2];
#pragma unroll
    for (int a = 0; a < 2; ++a)
#pragma unroll
        for (int b = 0; b < 2; ++b)
#pragma unroll
            for (int m = 0; m < 4; ++m)
#pragma unroll
                for (int n = 0; n < 2; ++n) acc[a][b][m][n] = (f32x4){0.f, 0.f, 0.f, 0.f};
    bf16x8 At[4][2], B0[2][2], B1[2][2];
    const char* cA = (const char*)g.A + (size_t)cur.pm * tstep; const char* cB = (const char*)g.Bt + (size_t)cur.pn * tstep;
    S.a_ready(cur);
    if constexpr (SP2) {
        PG8_STAGE(PG8_SB(0, 0), cB, voffB); PG8_STAGE(PG8_SB(0, 1), cB + hstep, voffB); PG8_STAGE(PG8_SA(0, 0), cA, voffA); PG8_STAGE(PG8_SA(0, 1), cA + hstep, voffA);
        if (wr == 1) PG8_BAR;
        PG8_WAIT_V(2); PG8_BAR;
        PG8_STAGE(PG8_SB(1, 0), cB + kstep, voffB); PG8_STAGE(PG8_SA(1, 0), cA + kstep, voffA); PG8_STAGE(PG8_SB(1, 1), cB + hstep + kstep, voffB);
        PG8_WAIT_V(6); PG8_BAR;
    } else {
        PG8_STAGE(PG8_SB(0, 0), cB, voffB); PG8_STAGE(PG8_SA(0, 0), cA, voffA); PG8_STAGE(PG8_SB(0, 1), cB + hstep, voffB); PG8_STAGE(PG8_SA(0, 1), cA + hstep, voffA);
        if (wr == 1) PG8_BAR;
        PG8_WAIT_V(4); PG8_BAR;
        PG8_STAGE(PG8_SB(1, 0), cB + kstep, voffB); PG8_STAGE(PG8_SA(1, 0), cA + kstep, voffA); PG8_STAGE(PG8_SB(1, 1), cB + hstep + kstep, voffB);
        PG8_WAIT_V(6); PG8_BAR;
    }
    for (;;) {
        const bool has_next = S.next(ui + 1, nxt);
        const char* nA = has_next ? (const char*)g.A + (size_t)nxt.pm * tstep : cA; const char* nB = has_next ? (const char*)g.Bt + (size_t)nxt.pn * tstep : cB;
        for (int t = 0; t < nt; t += 2) {
            const bool last = (t == nt - 2);
            const char* a1 = cA + (size_t)(t + 1) * kstep;
            const char* a2 = last ? nA : cA + (size_t)(t + 2) * kstep; const char* b2 = last ? nB : cB + (size_t)(t + 2) * kstep;
            const char* a3 = a2 + kstep; const char* b3 = b2 + kstep;
            if (last && has_next) S.a_ready(nxt);
            if constexpr (SP2) {
            PG8_LDB(B0, 0, 0); PG8_LDB(B1, 0, 1); PG8_SCHED; PG8_LDA(At, 0, 0); PG8_STAGE(PG8_SA(1, 1), a1 + hstep, voffA);
            PG8_WAIT_V(8); PG8_WAIT_L(0); PG8_BAR; PG8_MMA(0, 0, At, B0); PG8_MMA(0, 1, At, B1); PG8_BAR; PG8_SCHED;
            PG8_LDA(At, 0, 1); PG8_STAGE(PG8_SB(0, 0), b2, voffB); PG8_STAGE(PG8_SB(0, 1), b2 + hstep, voffB); PG8_STAGE(PG8_SA(0, 0), a2, voffA);
            PG8_WAIT_V(8); PG8_WAIT_L(0); PG8_BAR; PG8_MMA(1, 0, At, B0); PG8_MMA(1, 1, At, B1); PG8_BAR; PG8_SCHED;
            PG8_LDB(B0, 1, 0); PG8_LDB(B1, 1, 1); PG8_SCHED; PG8_LDA(At, 1, 0); PG8_STAGE(PG8_SA(0, 1), a2 + hstep, voffA);
            PG8_WAIT_V(8); PG8_WAIT_L(0); PG8_BAR; PG8_MMA(0, 0, At, B0); PG8_MMA(0, 1, At, B1); PG8_BAR; PG8_SCHED;
            PG8_LDA(At, 1, 1); PG8_STAGE(PG8_SB(1, 0), b3, voffB); PG8_STAGE(PG8_SB(1, 1), b3 + hstep, voffB); PG8_STAGE(PG8_SA(1, 0), a3, voffA);
            PG8_WAIT_V(8); PG8_WAIT_L(0); PG8_BAR; PG8_MMA(1, 0, At, B0); PG8_MMA(1, 1, At, B1); PG8_BAR; PG8_SCHED;
            } else {
            PG8_LDB(B0, 0, 0); PG8_SCHED; PG8_LDA(At, 0, 0); PG8_STAGE(PG8_SA(1, 1), a1 + hstep, voffA);
            PG8_WAIT_L(8); PG8_BAR; PG8_WAIT_L(0); PG8_MMA(0, 0, At, B0); PG8_BAR; PG8_SCHED;
            PG8_LDB(B1, 0, 1); PG8_STAGE(PG8_SB(0, 0), b2, voffB);
            PG8_BAR; PG8_WAIT_L(0); PG8_MMA(0, 1, At, B1); PG8_BAR;
            PG8_LDA(At, 0, 1); PG8_STAGE(PG8_SA(0, 0), a2, voffA);
            PG8_BAR; PG8_WAIT_L(0); PG8_MMA(1, 0, At, B0); PG8_BAR; PG8_SCHED;
            PG8_STAGE(PG8_SB(0, 1), b2 + hstep, voffB);
            PG8_WAIT_V(6); PG8_BAR; PG8_MMA(1, 1, At, B1); PG8_BAR;
            PG8_LDB(B0, 1, 0); PG8_SCHED; PG8_LDA(At, 1, 0); PG8_STAGE(PG8_SA(0, 1), a2 + hstep, voffA);
            PG8_WAIT_L(8); PG8_BAR; PG8_WAIT_L(0); PG8_MMA(0, 0, At, B0); PG8_BAR; PG8_SCHED;
            PG8_LDB(B1, 1, 1); PG8_STAGE(PG8_SB(1, 0), b3, voffB);
            PG8_BAR; PG8_WAIT_L(0); PG8_MMA(0, 1, At, B1); PG8_BAR;
            PG8_LDA(At, 1, 1); PG8_STAGE(PG8_SA(1, 0), a3, voffA);
            PG8_BAR; PG8_WAIT_L(0); PG8_MMA(1, 0, At, B0); PG8_BAR; PG8_SCHED;
            PG8_STAGE(PG8_SB(1, 1), b3 + hstep, voffB);
            PG8_WAIT_V(6); PG8_BAR; PG8_MMA(1, 1, At, B1); PG8_BAR;
            }
        }
        if constexpr (ALIGN_EPI) { if (wr == 0) PG8_BAR; }
        if constexpr (!Epi::AFTER_DRAIN) { E(acc, cur, wr, wc, fr, fq); S.done(cur); }
        if (!has_next) break;
#pragma unroll
        for (int a = 0; a < 2; ++a)
#pragma unroll
            for (int b = 0; b < 2; ++b)
#pragma unroll
                for (int m = 0; m < 4; ++m)
#pragma unroll
                    for (int n = 0; n < 2; ++n) acc[a][b][m][n] = (f32x4){0.f, 0.f, 0.f, 0.f};
        cur = nxt; cA = nA; cB = nB; ++ui;
        if constexpr (ALIGN_EPI) { if (wr == 1) PG8_BAR; }
    }
    PG8_WAIT_V(0);
    if constexpr (!ALIGN_EPI) { if (wr == 0) PG8_BAR; }
    PG8_BAR;
    if constexpr (Epi::AFTER_DRAIN) { E.fused(acc, cur, wr, wc, fr, fq, lds, wid, lane); S.done(cur); }
#undef PG8_SA
#undef PG8_SB
#undef PG8_STAGE
#undef PG8_LDA
#undef PG8_LDB
#undef PG8_MMA
#undef PG8_WAIT_V
#undef PG8_WAIT_L
#undef PG8_BAR
#undef PG8_SCHED
}
}
using namespace pg8;
#define LAS __attribute__((address_space(3)))
typedef short v4i16_t __attribute__((ext_vector_type(4)));
typedef unsigned u32x2 __attribute__((ext_vector_type(2)));
typedef float f32x2 __attribute__((ext_vector_type(2)));

constexpr int D = 1024, FFN = 2816;
constexpr int R_S0 = 32768;
constexpr int R_M0 = 33280;
constexpr int R_ACT = 33296;
constexpr int R1 = 33536;
constexpr int R2 = 33280;
constexpr int RK = 49920;
constexpr int R_C0 = 33536;
constexpr int NCHUNK = 146;
constexpr float EPS = 1e-6f;
constexpr float QSCALE = 0.14724448f;

constexpr size_t MiB = 1048576;
constexpr size_t WS_W_IN = 0, WS_W_GU = 16252928, WS_W_D = 27787264, WS_W_SO = 33554432, WS_W_UQ = 37748736, WS_W_K = 38928384, WS_W_V = 39452672,
                 WS_W_MO = 39976960, WS_W_MIX = 42074112, WS_ROPE = 44171264, WS_HMETA = 46270464, WS_KRB = 47319040, WS_TOT = 50513920, WS_BAR = 50540544;
constexpr size_t WS_Z = 49 * MiB, WS_X = 180 * MiB, WS_U = 376 * MiB + MiB / 2, WS_MISC = 442 * MiB, WS_HALO = WS_MISC + (size_t)R1 * 768 * 2;
constexpr size_t WS_DT = WS_U, WS_ACS = WS_U + 4292608, WS_CQN = WS_U + 8585216, WS_CKVB = WS_U + 34144256, WS_S = WS_U + 57 * MiB;
constexpr size_t WS_YS = 447 * MiB, WS_Q = WS_Z, WS_KN = WS_X, WS_VT = WS_X + 102236160, WS_O = WS_U, WS_G = WS_X, WS_ACT = WS_X;
constexpr size_t WS_END = 512 * MiB;
static_assert(WS_S + (size_t)NCHUNK * 32 * 8192 * 2 <= WS_END && WS_O + (size_t)R2 * 1024 * 2 <= WS_YS && WS_YS + (size_t)R2 * 1024 * 2 <= WS_END, "ws map 4");
static_assert(WS_END <= 512 * MiB, "ws map");
static_assert(WS_CKVB + (size_t)RK * 256 * 2 <= WS_S, "ws map 2");
static_assert(WS_HALO + 514 * 3 * 3072 * 2 <= 512 * MiB, "ws map 3");

constexpr size_t OUT_YP = 0, OUT_YS = 33554432, OUT_CKVP = 34078720, OUT_KRP = 42475520, OUT_SSMP = 43525120, OUT_CONVP = 44049408,
                 OUT_CKVS = 44067840, OUT_KRS = 44198912, OUT_SSMS = 44215296, OUT_CONVS = 48409600;

enum { I_XP = 0, I_XS, I_CCKV, I_CKR, I_SSSM, I_SCONV, I_META, I_F1N, I_F1GU, I_F1D, I_MIXN, I_WIN, I_GBIAS, I_CONVW, I_CONVB, I_DTB, I_ALOG, I_SSMD,
       I_SSMN, I_WSO, I_QN, I_WUQ, I_KVN, I_WUKV, I_WMO, I_WMIX, I_F2N, I_F2GU, I_F2D, I_FINN };

struct Args { const float* in[30]; float* out; unsigned char* ws; int ph_lo, ph_hi; };

__device__ __forceinline__ unsigned f2bf(float f) { unsigned u = __builtin_bit_cast(unsigned, f); return (u + 0x7fffu + ((u >> 16) & 1u)) >> 16; }
typedef float f32x2_t __attribute__((ext_vector_type(2))); typedef __bf16 bf16x2_t __attribute__((ext_vector_type(2)));
__device__ __forceinline__ unsigned cvtpk(float lo, float hi) { f32x2_t v = {lo, hi}; bf16x2_t b = __builtin_convertvector(v, bf16x2_t); return __builtin_bit_cast(unsigned, b); }
__device__ __forceinline__ float bflo(unsigned u) { return __builtin_bit_cast(float, u << 16); }
__device__ __forceinline__ float bfhi(unsigned u) { return __builtin_bit_cast(float, u & 0xffff0000u); }
__device__ __forceinline__ float bf2f(bf16_t b) { return __builtin_bit_cast(float, (unsigned)b << 16); }
__device__ __forceinline__ float wave_sum(float v) {
#pragma unroll
    for (int o = 1; o < 64; o <<= 1) v += __shfl_xor(v, o);
    return v;
}
__device__ __forceinline__ float silu_f(float x) { return x * __builtin_amdgcn_rcpf(1.f + __expf(-x)); }
__device__ __forceinline__ float sigmoid_f(float x) { return __builtin_amdgcn_rcpf(1.f + __expf(-x)); }
__device__ __forceinline__ float softplus_f(float x) { return x > 20.f ? x : log1pf(__expf(x)); }
__device__ __forceinline__ int pos_idx(int row) {
    if (row < R_S0) return (row & 16383) + 16;
    if (row < R_M0) return 1024 + ((row - R_S0) & 31) + 16;
    return row - R_M0;
}
__device__ __forceinline__ void chunk_info(int ci, int& row0, int& ntok) {
    if (ci < 130) { const int b = ci / 65, k = ci - b * 65; if (k == 0) { row0 = R_M0; ntok = 16; } else { row0 = b * 16384 + 256 * (k - 1); ntok = 256; } }
    else { row0 = R_S0 + 32 * (ci - 130); ntok = 32; }
}
__device__ __forceinline__ v4i16_t ldtr(const LAS bf16_t* p) { return __builtin_amdgcn_ds_read_tr16_b64_v4i16((LAS v4i16_t*)p); }
__device__ __forceinline__ bf16x8 cat8(v4i16_t a, v4i16_t b) { return __builtin_shufflevector(a, b, 0, 1, 2, 3, 4, 5, 6, 7); }
__device__ __forceinline__ bf16x8 cat8u(u32x2 a, u32x2 b) { u32x4 t = {a.x, a.y, b.x, b.y}; return __builtin_bit_cast(bf16x8, t); }
#define MFMA16(a, b, c) __builtin_amdgcn_mfma_f32_16x16x32_bf16((a), (b), (c), 0, 0, 0)

struct EpiSwiglu {
    static constexpr bool PERM = true, AFTER_DRAIN = false; bf16_t* O;
    __device__ __forceinline__ void operator()(const f32x4 (&acc)[2][2][4][2], const Unit& u, int wr, int wc, int fr, int fq) const {
        const int row0 = u.pm * 256 + wr * 64 + fr, col0 = u.pn * 128 + wc * 32 + 8 * fq;
#pragma unroll
        for (int ai = 0; ai < 2; ++ai)
#pragma unroll
            for (int m = 0; m < 4; ++m) {
                const f32x4 g0 = acc[ai][0][m][0], g1 = acc[ai][0][m][1], u0 = acc[ai][1][m][0], u1 = acc[ai][1][m][1];
                u32x4 w; w.x = cvtpk(silu_f(g0[0]) * u0[0], silu_f(g0[1]) * u0[1]); w.y = cvtpk(silu_f(g0[2]) * u0[2], silu_f(g0[3]) * u0[3]);
                w.z = cvtpk(silu_f(g1[0]) * u1[0], silu_f(g1[1]) * u1[1]); w.w = cvtpk(silu_f(g1[2]) * u1[2], silu_f(g1[3]) * u1[3]);
                *(u32x4*)(O + (size_t)(row0 + ai * 128 + m * 16) * FFN + col0) = w;
            }
    }
};
struct RowMap { float* out; float* hmeta; const float* xp; const float* xs; const float* meta; };
__device__ __forceinline__ float* hrow(const RowMap& a, int row) { return row < R2 ? a.out + (size_t)row * D : a.hmeta + (size_t)(row - R2) * D; }
__device__ __forceinline__ const float* xrow(const RowMap& a, int row) {
    if (row < R_S0) return a.xp + (size_t)row * D;
    if (row < R_M0) return a.xs + (size_t)(row - R_S0) * D;
    if (row < R_ACT) return a.meta + (size_t)(row - R_M0) * D;
    return nullptr;
}
struct EpiResid {
    static constexpr bool PERM = true, AFTER_DRAIN = false; RowMap a; float s; int mode;
    __device__ __forceinline__ void operator()(const f32x4 (&acc)[2][2][4][2], const Unit& u, int wr, int wc, int fr, int fq) const {
        const int row0 = u.pm * 256 + wr * 64 + fr, col0 = u.pn * 256 + wc * 32 + 8 * fq;
#pragma unroll
        for (int ai = 0; ai < 2; ++ai)
#pragma unroll
            for (int m = 0; m < 4; ++m) {
                const int row = row0 + ai * 128 + m * 16; float* hp = hrow(a, row); const float* bp = mode ? hp : xrow(a, row);
#pragma unroll
                for (int bj = 0; bj < 2; ++bj) {
                    const int c = col0 + bj * 128; f32x4 b0 = {0.f, 0.f, 0.f, 0.f}, b1 = b0;
                    if (bp) { b0 = *(const f32x4*)(bp + c); b1 = *(const f32x4*)(bp + c + 4); }
                    *(f32x4*)(hp + c) = b0 + acc[ai][bj][m][0] * s; *(f32x4*)(hp + c + 4) = b1 + acc[ai][bj][m][1] * s;
                }
            }
    }
};
struct EpiProj {
    static constexpr bool PERM = true, AFTER_DRAIN = false; bf16_t *Z, *X, *MISC, *HALO; float* out;
    __device__ __forceinline__ void operator()(const f32x4 (&acc)[2][2][4][2], const Unit& u, int wr, int wc, int fr, int fq) const {
        const int row0 = u.pm * 256 + wr * 64 + fr; const int pn = u.pn;
#pragma unroll
        for (int ai = 0; ai < 2; ++ai)
#pragma unroll
            for (int m = 0; m < 4; ++m) {
                const int row = row0 + ai * 128 + m * 16;
#pragma unroll
                for (int bj = 0; bj < 2; ++bj) {
                    const f32x4 v0 = acc[ai][bj][m][0], v1 = acc[ai][bj][m][1];
                    u32x4 w; w.x = cvtpk(v0[0], v0[1]); w.y = cvtpk(v0[2], v0[3]); w.z = cvtpk(v1[0], v1[1]); w.w = cvtpk(v1[2], v1[3]);
                    const int ct = bj * 128 + wc * 32 + 8 * fq;
                    if (pn < 8) { *(u32x4*)(Z + (size_t)row * 2048 + pn * 256 + ct) = w; }
                    else if (pn < 20) {
                        const int cx = (pn - 8) * 256 + ct;
                        *(u32x4*)(X + (size_t)row * 3072 + cx) = w;
                        if (row < R_S0) {
                            const int r6 = row & 63;
                            if (r6 >= 61) { const int T = (row >> 6) + 1; if (T & 255) *(u32x4*)(HALO + ((size_t)T * 3 + (r6 - 61)) * 3072 + cx) = w; }
                            const int t = row & 16383;
                            if (t >= 16381) { float* o = out + OUT_CONVP + ((size_t)(row >> 14) * 3 + (t - 16381)) * 3072 + cx; *(f32x4*)o = v0; *(f32x4*)(o + 4) = v1; }
                        } else if (row < R_M0) {
                            const int t = (row - R_S0) & 31, db = (row - R_S0) >> 5;
                            if (t >= 29) { float* o = out + OUT_CONVS + ((size_t)db * 3 + (t - 29)) * 3072 + cx; *(f32x4*)o = v0; *(f32x4*)(o + 4) = v1; }
                        } else if (row >= R_M0 + 13 && row < R_ACT) {
                            const int sl = row - R_M0 - 13;
                            *(u32x4*)(HALO + ((size_t)0 * 3 + sl) * 3072 + cx) = w; *(u32x4*)(HALO + ((size_t)256 * 3 + sl) * 3072 + cx) = w;
                        }
                    } else { *(u32x4*)(MISC + (size_t)row * 768 + (pn - 20) * 256 + ct) = w; }
                }
            }
    }
};
struct EpiBf16 {
    static constexpr bool PERM = true, AFTER_DRAIN = false; bf16_t* O; int ldc; float sc;
    __device__ __forceinline__ void operator()(const f32x4 (&acc)[2][2][4][2], const Unit& u, int wr, int wc, int fr, int fq) const {
        const int row0 = u.pm * 256 + wr * 64 + fr, col0 = u.pn * 256 + wc * 32 + 8 * fq;
#pragma unroll
        for (int ai = 0; ai < 2; ++ai)
#pragma unroll
            for (int m = 0; m < 4; ++m)
#pragma unroll
                for (int bj = 0; bj < 2; ++bj) {
                    const f32x4 v0 = acc[ai][bj][m][0] * sc, v1 = acc[ai][bj][m][1] * sc;
                    u32x4 w; w.x = cvtpk(v0[0], v0[1]); w.y = cvtpk(v0[2], v0[3]); w.z = cvtpk(v1[0], v1[1]); w.w = cvtpk(v1[2], v1[3]);
                    *(u32x4*)(O + (size_t)(row0 + ai * 128 + m * 16) * ldc + col0 + bj * 128) = w;
                }
    }
};
struct EpiGate {
    static constexpr bool PERM = true, AFTER_DRAIN = false; bf16_t* G; const float* bias;
    __device__ __forceinline__ void operator()(const f32x4 (&acc)[2][2][4][2], const Unit& u, int wr, int wc, int fr, int fq) const {
        const int row0 = u.pm * 256 + wr * 64 + fr, col0 = u.pn * 256 + wc * 32 + 8 * fq;
#pragma unroll
        for (int bj = 0; bj < 2; ++bj) {
            const int c = col0 + bj * 128; const f32x4 b0 = *(const f32x4*)(bias + c), b1 = *(const f32x4*)(bias + c + 4);
#pragma unroll
            for (int ai = 0; ai < 2; ++ai)
#pragma unroll
                for (int m = 0; m < 4; ++m) {
                    const f32x4 v0 = acc[ai][bj][m][0] + b0, v1 = acc[ai][bj][m][1] + b1;
                    u32x4 w; w.x = cvtpk(sigmoid_f(v0[0]), sigmoid_f(v0[1])); w.y = cvtpk(sigmoid_f(v0[2]), sigmoid_f(v0[3]));
                    w.z = cvtpk(sigmoid_f(v1[0]), sigmoid_f(v1[1])); w.w = cvtpk(sigmoid_f(v1[2]), sigmoid_f(v1[3]));
                    *(u32x4*)(G + (size_t)(row0 + ai * 128 + m * 16) * 2048 + c) = w;
                }
        }
    }
};
struct EpiMerge {
    static constexpr bool PERM = true, AFTER_DRAIN = false; const bf16_t* G; bf16_t* YS;
    __device__ __forceinline__ void operator()(const f32x4 (&acc)[2][2][4][2], const Unit& u, int wr, int wc, int fr, int fq) const {
        const int row0 = u.pm * 256 + wr * 64 + fr, col0 = u.pn * 256 + wc * 32 + 8 * fq;
#pragma unroll
        for (int ai = 0; ai < 2; ++ai)
#pragma unroll
            for (int m = 0; m < 4; ++m)
#pragma unroll
                for (int bj = 0; bj < 2; ++bj) {
                    const int row = row0 + ai * 128 + m * 16, c = col0 + bj * 128;
                    const u32x4 gs = *(const u32x4*)(G + (size_t)row * 2048 + c), gm = *(const u32x4*)(G + (size_t)row * 2048 + 1024 + c), ys = *(const u32x4*)(YS + (size_t)row * 1024 + c);
                    const f32x4 v0 = acc[ai][bj][m][0], v1 = acc[ai][bj][m][1];
                    u32x4 w;
                    w.x = cvtpk(bflo(gs.x) * bflo(ys.x) + bflo(gm.x) * v0[0], bfhi(gs.x) * bfhi(ys.x) + bfhi(gm.x) * v0[1]);
                    w.y = cvtpk(bflo(gs.y) * bflo(ys.y) + bflo(gm.y) * v0[2], bfhi(gs.y) * bfhi(ys.y) + bfhi(gm.y) * v0[3]);
                    w.z = cvtpk(bflo(gs.z) * bflo(ys.z) + bflo(gm.z) * v1[0], bfhi(gs.z) * bfhi(ys.z) + bfhi(gm.z) * v1[1]);
                    w.w = cvtpk(bflo(gs.w) * bflo(ys.w) + bflo(gm.w) * v1[2], bfhi(gs.w) * bfhi(ys.w) + bfhi(gm.w) * v1[3]);
                    *(u32x4*)(YS + (size_t)row * 1024 + c) = w;
                }
    }
};
__device__ __forceinline__ int lane_id() { return (int)(__builtin_amdgcn_mbcnt_hi(~0u, __builtin_amdgcn_mbcnt_lo(~0u, 0u)) & 63u); }
template <class Epi> __device__ __forceinline__ void run_gemm(LAS unsigned char* lds, const bf16_t* A, const bf16_t* Bt, int M, int N, int K, const Epi& E, int wave) {
    Gemm g{A, Bt, M, N, K}; StaticOrder S; S.init(M, N, (int)gridDim.x, (int)blockIdx.x);
    gemm_phase<Epi, StaticOrder, false, true>(lds, g, S, E, wave);
    __syncthreads();
}

__device__ __forceinline__ int srccol(int mapid, int n) {
    switch (mapid) {
        case 0: return n;
        case 1: { const int pn = n >> 8, bj = (n >> 7) & 1, i = n & 127; return (bj ? FFN : 0) + pn * 128 + i; }
        case 2: return n < 5824 ? n : (n < 5888 ? -1 : n - 64);
        case 3: return n < 1024 ? (n >> 6) * 96 + (n & 63) : ((n - 1024) >> 5) * 96 + 64 + ((n - 1024) & 31);
        case 4: return (n >> 6) * 128 + (n & 63);
        default: return (n >> 6) * 128 + 64 + (n & 63);
    }
}
__device__ __forceinline__ void xpose_matrix(const float* __restrict__ src, int K, int Nsrc, bf16_t* dst, int Ndst, int mapid, LAS float* scr, int tid) {
    const int nblk = Ndst >> 6, nitems = (K >> 6) * nblk;
    for (int item = blockIdx.x; item < nitems; item += gridDim.x) {
        const int kb = item / nblk, nb = item - kb * nblk, k0 = kb * 64, n0 = nb * 64;
        __syncthreads();
#pragma unroll
        for (int i = 0; i < 8; ++i) { const int idx = tid + 512 * i, kk = idx >> 6, nn = idx & 63; const int sc = srccol(mapid, n0 + nn);
            scr[nn * 65 + kk] = sc >= 0 ? src[(size_t)(k0 + kk) * Nsrc + sc] : 0.f; }
        __syncthreads();
        { const int nn = tid >> 3, c = tid & 7; const LAS float* s = scr + nn * 65 + 8 * c;
          u32x4 o; o.x = cvtpk(s[0], s[1]); o.y = cvtpk(s[2], s[3]); o.z = cvtpk(s[4], s[5]); o.w = cvtpk(s[6], s[7]);
          *(u32x4*)(dst + (size_t)(n0 + nn) * K + k0 + 8 * c) = o; }
    }
}
__device__ __forceinline__ void norm_row_bf16(const float* src, const float* gain, bf16_t* dst, int lane) {
    f32x4 v[4]; float s = 0.f;
#pragma unroll
    for (int j = 0; j < 4; ++j) { v[j] = src ? ((const f32x4*)src)[lane + 64 * j] : (f32x4){0.f, 0.f, 0.f, 0.f}; s += v[j][0] * v[j][0] + v[j][1] * v[j][1] + v[j][2] * v[j][2] + v[j][3] * v[j][3]; }
    const float rs = rsqrtf(wave_sum(s) * (1.f / 1024.f) + EPS);
#pragma unroll
    for (int j = 0; j < 4; ++j) { const f32x4 g = ((const f32x4*)gain)[lane + 64 * j];
        u32x2 o = {cvtpk(v[j][0] * rs * g[0], v[j][1] * rs * g[1]), cvtpk(v[j][2] * rs * g[2], v[j][3] * rs * g[3])}; ((u32x2*)dst)[lane + 64 * j] = o; }
}

__device__ __forceinline__ void p5_phase(const Args& a, const int wave) {
    const int lane = lane_id(); int tid = wave * 64 + lane; asm volatile("" : "+v"(tid)); tid &= 511; const int gw = blockIdx.x * 8 + wave, NGW = gridDim.x * 8;
    unsigned char* ws = a.ws;
    const bf16_t* misc = (const bf16_t*)(ws + WS_MISC); float* dt = (float*)(ws + WS_DT); float* acs = (float*)(ws + WS_ACS); float* tot = (float*)(ws + WS_TOT);
    bf16_t* cqn = (bf16_t*)(ws + WS_CQN); bf16_t* ckvb = (bf16_t*)(ws + WS_CKVB); bf16_t* krb = (bf16_t*)(ws + WS_KRB); bf16_t* xc = (bf16_t*)(ws + WS_X);
    const bf16_t* halo = (const bf16_t*)(ws + WS_HALO); const float* rope = (const float*)(ws + WS_ROPE);
    { const int idx = blockIdx.x * 512 + tid;
      if (idx < NCHUNK * 32) { const int ci = idx >> 5, h = idx & 31; int row0, ntok; chunk_info(ci, row0, ntok);
          const float A = -__expf(a.in[I_ALOG][h]), bias = a.in[I_DTB][h]; float accv = 0.f;
          for (int t = 0; t < ntok; t += 8) { float v[8];
#pragma unroll
              for (int k = 0; k < 8; ++k) v[k] = bf2f(misc[(size_t)(row0 + t + k) * 768 + h]);
#pragma unroll
              for (int k = 0; k < 8; ++k) { accv += softplus_f(v[k] + bias) * A; acs[(size_t)(row0 + t + k) * 32 + h] = accv; } }
          tot[ci * 32 + h] = accv; } }
    for (int row = gw; row < R_ACT; row += NGW) {
        const bf16_t* mr = misc + (size_t)row * 768;
        if (lane < 32) dt[(size_t)row * 32 + lane] = softplus_f(bf2f(mr[lane]) + a.in[I_DTB][lane]);
        { const unsigned* cp = (const unsigned*)(mr + 32) + 3 * lane; const unsigned c0 = cp[0], c1 = cp[1], c2 = cp[2];
          float q[6] = {bflo(c0), bfhi(c0), bflo(c1), bfhi(c1), bflo(c2), bfhi(c2)}; float ss = 0.f;
#pragma unroll
          for (int e = 0; e < 6; ++e) ss += q[e] * q[e];
          const float rs = rsqrtf(wave_sum(ss) * (1.f / 384.f) + EPS);
          if (row < R2) { const float* gq = a.in[I_QN] + 6 * lane; unsigned* op = (unsigned*)(cqn + (size_t)row * 384) + 3 * lane;
              op[0] = cvtpk(q[0] * rs * gq[0], q[1] * rs * gq[1]); op[1] = cvtpk(q[2] * rs * gq[2], q[3] * rs * gq[3]); op[2] = cvtpk(q[4] * rs * gq[4], q[5] * rs * gq[5]); } }
        { const u32x2 kv = *(const u32x2*)(mr + 416 + 4 * lane); float v[4] = {bflo(kv.x), bfhi(kv.x), bflo(kv.y), bfhi(kv.y)};
          const float rs = rsqrtf(wave_sum(v[0] * v[0] + v[1] * v[1] + v[2] * v[2] + v[3] * v[3]) * (1.f / 256.f) + EPS);
          const f32x4 g = *(const f32x4*)(a.in[I_KVN] + 4 * lane); const f32x4 o = {v[0] * rs * g[0], v[1] * rs * g[1], v[2] * rs * g[2], v[3] * rs * g[3]};
          if (row < R_S0) *(f32x4*)(a.out + OUT_CKVP + ((size_t)(row >> 14) * 16400 + 16 + (row & 16383)) * 256 + 4 * lane) = o;
          else if (row < R_M0) *(f32x4*)(a.out + OUT_CKVS + (size_t)(row - R_S0) * 256 + 4 * lane) = o;
          else { *(f32x4*)(a.out + OUT_CKVP + (size_t)(row - R_M0) * 256 + 4 * lane) = o; *(f32x4*)(a.out + OUT_CKVP + (size_t)(16400 + row - R_M0) * 256 + 4 * lane) = o; }
          u32x2 ob = {cvtpk(o[0], o[1]), cvtpk(o[2], o[3])}; *(u32x2*)(ckvb + (size_t)row * 256 + 4 * lane) = ob; }
        if (lane < 16) { const float x1 = bf2f(mr[672 + lane]), x2 = bf2f(mr[688 + lane]); const f32x2 cs = *(const f32x2*)(rope + ((size_t)pos_idx(row) * 16 + lane) * 2);
          const float o1 = x1 * cs[0] - x2 * cs[1], o2 = x1 * cs[1] + x2 * cs[0];
          if (row < R_S0) { float* p = a.out + OUT_KRP + ((size_t)(row >> 14) * 16400 + 16 + (row & 16383)) * 32; p[lane] = o1; p[16 + lane] = o2; }
          else if (row < R_M0) { float* p = a.out + OUT_KRS + (size_t)(row - R_S0) * 32; p[lane] = o1; p[16 + lane] = o2; }
          else { float* p = a.out + OUT_KRP + (size_t)(row - R_M0) * 32; p[lane] = o1; p[16 + lane] = o2; p += (size_t)16400 * 32; p[lane] = o1; p[16 + lane] = o2; }
          krb[(size_t)row * 32 + lane] = (bf16_t)f2bf(o1); krb[(size_t)row * 32 + 16 + lane] = (bf16_t)f2bf(o2); }
    }
    for (int row = R_ACT + gw; row < R1; row += NGW) { u32x2 z = {0u, 0u}; *(u32x2*)(ckvb + (size_t)row * 256 + 4 * lane) = z; if (lane < 16) ((unsigned*)(krb + (size_t)row * 32))[lane] = 0u; }
    for (int r = gw; r < 16384; r += NGW) {
        const f32x4 v = *(const f32x4*)(a.in[I_CCKV] + (size_t)r * 256 + 4 * lane); u32x2 o = {cvtpk(v[0], v[1]), cvtpk(v[2], v[3])}; *(u32x2*)(ckvb + (size_t)(R_C0 + r) * 256 + 4 * lane) = o;
        if (lane < 8) { const f32x4 k = *(const f32x4*)(a.in[I_CKR] + (size_t)r * 32 + 4 * lane); u32x2 ok = {cvtpk(k[0], k[1]), cvtpk(k[2], k[3])}; *(u32x2*)(krb + (size_t)(R_C0 + r) * 32 + 4 * lane) = ok; }
    }
    for (int item = gw; item < 529 * 6; item += NGW) {
        const int T = item / 6, cc = item - T * 6, c0 = cc * 512 + lane * 8;
        int row0, nrows; float p0[8], p1[8], p2[8];
        if (T < 512) { row0 = T * 64; nrows = 64; const bf16_t* hp = halo + (size_t)T * 3 * 3072 + c0;
            const u32x4 h0 = *(const u32x4*)hp, h1 = *(const u32x4*)(hp + 3072), h2 = *(const u32x4*)(hp + 6144);
#pragma unroll
            for (int e = 0; e < 4; ++e) { p0[2 * e] = bflo(h0[e]); p0[2 * e + 1] = bfhi(h0[e]); p1[2 * e] = bflo(h1[e]); p1[2 * e + 1] = bfhi(h1[e]); p2[2 * e] = bflo(h2[e]); p2[2 * e + 1] = bfhi(h2[e]); } }
        else if (T == 512) { row0 = R_M0; nrows = 16;
#pragma unroll
            for (int e = 0; e < 8; ++e) { p0[e] = 0.f; p1[e] = 0.f; p2[e] = 0.f; } }
        else { const int db = T - 513; row0 = R_S0 + 32 * db; nrows = 32; const float* sp = a.in[I_SCONV] + (size_t)db * 3 * 3072 + c0;
#pragma unroll
            for (int e = 0; e < 8; ++e) { p0[e] = sp[e]; p1[e] = sp[3072 + e]; p2[e] = sp[6144 + e]; } }
        float w0[8], w1[8], w2[8], w3[8], bb[8];
#pragma unroll
        for (int e = 0; e < 8; ++e) { w0[e] = a.in[I_CONVW][c0 + e]; w1[e] = a.in[I_CONVW][3072 + c0 + e]; w2[e] = a.in[I_CONVW][6144 + c0 + e]; w3[e] = a.in[I_CONVW][9216 + c0 + e]; bb[e] = a.in[I_CONVB][c0 + e]; }
        for (int t0 = 0; t0 < nrows; t0 += 4) {
            u32x4 raw[4];
#pragma unroll
            for (int k = 0; k < 4; ++k) raw[k] = *(const u32x4*)(xc + (size_t)(row0 + t0 + k) * 3072 + c0);
#pragma unroll
            for (int k = 0; k < 4; ++k) { float x[8], y[8];
#pragma unroll
                for (int e = 0; e < 4; ++e) { x[2 * e] = bflo(raw[k][e]); x[2 * e + 1] = bfhi(raw[k][e]); }
#pragma unroll
                for (int e = 0; e < 8; ++e) { y[e] = silu_f(bb[e] + w0[e] * p0[e] + w1[e] * p1[e] + w2[e] * p2[e] + w3[e] * x[e]); p0[e] = p1[e]; p1[e] = p2[e]; p2[e] = x[e]; }
                u32x4 o; o.x = cvtpk(y[0], y[1]); o.y = cvtpk(y[2], y[3]); o.z = cvtpk(y[4], y[5]); o.w = cvtpk(y[6], y[7]);
                *(u32x4*)(xc + (size_t)(row0 + t0 + k) * 3072 + c0) = o; }
        }
    }
}

__device__ __forceinline__ void p6_phase(const Args& a, LAS unsigned char* L, const int wave) {
    const int lane = lane_id(); int tid = wave * 64 + lane; asm volatile("" : "+v"(tid)); tid &= 511;
    unsigned char* ws = a.ws; const bf16_t* xc = (const bf16_t*)(ws + WS_X); const float* dt = (const float*)(ws + WS_DT); const float* acs = (const float*)(ws + WS_ACS);
    const float* tot = (const float*)(ws + WS_TOT); bf16_t* S = (bf16_t*)(ws + WS_S);
    LAS bf16_t* Bs = (LAS bf16_t*)L; LAS bf16_t* Xs = (LAS bf16_t*)(L + 18432); LAS float* scs = (LAS float*)(L + 86016);
    const int li = lane & 15, quad = lane >> 4;
    const unsigned voffB = (unsigned)((tid >> 4) * 3072 + (tid & 15) * 8), voffX = (unsigned)((tid >> 6) * 3072 + (tid & 63) * 8);
    for (int unit = blockIdx.x; unit < NCHUNK * 4; unit += gridDim.x) {
        const int ci = unit >> 2, g = unit & 3, h = 8 * g + wave; int row0, ntok; chunk_info(ci, row0, ntok);
        f32x4 acc[8][4];
#pragma unroll
        for (int nb = 0; nb < 8; ++nb)
#pragma unroll
            for (int pb = 0; pb < 4; ++pb) acc[nb][pb] = (f32x4){0.f, 0.f, 0.f, 0.f};
        const int nsub = (ntok + 63) >> 6;
        for (int jb = 0; jb < nsub; ++jb) {
            const int rj = row0 + 64 * jb;
            __syncthreads();
            { const int hh = tid >> 6, t = tid & 63; const size_t r = (size_t)(rj + t) * 32 + 8 * g + hh; float v = 0.f;
              if (64 * jb + t < ntok) v = __expf(tot[ci * 32 + 8 * g + hh] - acs[r]) * dt[r];
              scs[hh * 64 + t] = v; }
#pragma unroll
            for (int i = 0; i < 2; ++i) { const bf16_t* gb = xc + (size_t)(rj + 32 * i) * 3072 + 2048 + 128 * g;
                *(LAS u32x4*)(Bs + ((tid >> 4) + 32 * i) * 144 + (tid & 15) * 8) = *(const u32x4*)(gb + voffB); }
            __syncthreads();
#pragma unroll
            for (int i = 0; i < 8; ++i) { const int t = (tid >> 6) + 8 * i, c = tid & 63; const bf16_t* gb = xc + (size_t)(rj + 8 * i) * 3072 + 512 * g;
                const u32x4 v = *(const u32x4*)(gb + voffX); const float s = scs[(c >> 3) * 64 + t];
                u32x4 o; o.x = cvtpk(bflo(v.x) * s, bfhi(v.x) * s); o.y = cvtpk(bflo(v.y) * s, bfhi(v.y) * s); o.z = cvtpk(bflo(v.z) * s, bfhi(v.z) * s); o.w = cvtpk(bflo(v.w) * s, bfhi(v.w) * s);
                *(LAS u32x4*)(Xs + t * 528 + c * 8) = o; }
            __syncthreads();
#pragma unroll
            for (int s2 = 0; s2 < 2; ++s2) {
                const int tok0 = 32 * s2 + 4 * quad + (li >> 2), cq4 = 4 * (li & 3);
                bf16x8 Bf[4];
#pragma unroll
                for (int pb = 0; pb < 4; ++pb) Bf[pb] = cat8(ldtr(Xs + tok0 * 528 + 64 * wave + 16 * pb + cq4), ldtr(Xs + (tok0 + 16) * 528 + 64 * wave + 16 * pb + cq4));
#pragma unroll
                for (int nb = 0; nb < 8; ++nb) { const bf16x8 Af = cat8(ldtr(Bs + tok0 * 144 + 16 * nb + cq4), ldtr(Bs + (tok0 + 16) * 144 + 16 * nb + cq4));
#pragma unroll
                    for (int pb = 0; pb < 4; ++pb) acc[nb][pb] = MFMA16(Af, Bf[pb], acc[nb][pb]); }
            }
        }
        bf16_t* Sp = S + ((size_t)(ci * 32 + h) * 64) * 128;
#pragma unroll
        for (int nb = 0; nb < 8; ++nb)
#pragma unroll
            for (int pb = 0; pb < 4; ++pb) { u32x2 o = {cvtpk(acc[nb][pb][0], acc[nb][pb][1]), cvtpk(acc[nb][pb][2], acc[nb][pb][3])};
                *(u32x2*)(Sp + (size_t)(16 * pb + li) * 128 + 16 * nb + 4 * quad) = o; }
    }
}

__device__ __forceinline__ void p7_phase(const Args& a, const int wave) {
    int tid = wave * 64 + lane_id(); asm volatile("" : "+v"(tid)); tid &= 511;
    unsigned char* ws = a.ws; bf16_t* S = (bf16_t*)(ws + WS_S); const float* tot = (const float*)(ws + WS_TOT);
    const int gt = blockIdx.x * 512 + tid, NT = gridDim.x * 512;
    for (int e = gt; e < 131072; e += NT) {
        const int b = e >> 16, rem = e & 65535, h = rem >> 11; f32x4 st = {0.f, 0.f, 0.f, 0.f};
        for (int k0 = 0; k0 < 65; k0 += 5) { u32x2 v[5]; float dec[5];
#pragma unroll
            for (int k = 0; k < 5; ++k) { const int ci = b * 65 + k0 + k; v[k] = *(const u32x2*)(S + (size_t)ci * 262144 + rem * 4); dec[k] = __expf(tot[ci * 32 + h]); }
#pragma unroll
            for (int k = 0; k < 5; ++k) { const int ci = b * 65 + k0 + k; u32x2 o = {cvtpk(st[0], st[1]), cvtpk(st[2], st[3])}; *(u32x2*)(S + (size_t)ci * 262144 + rem * 4) = o;
                st[0] = st[0] * dec[k] + bflo(v[k].x); st[1] = st[1] * dec[k] + bfhi(v[k].x); st[2] = st[2] * dec[k] + bflo(v[k].y); st[3] = st[3] * dec[k] + bfhi(v[k].y); } }
        *(f32x4*)(a.out + OUT_SSMP + (size_t)b * 262144 + rem * 4) = st;
    }
    for (int e = gt; e < 16 * 65536; e += NT) {
        const int db = e >> 16, rem = e & 65535, h = rem >> 11, ci = 130 + db;
        const f32x4 s0 = *(const f32x4*)(a.in[I_SSSM] + (size_t)db * 262144 + rem * 4); const u32x2 v = *(const u32x2*)(S + (size_t)ci * 262144 + rem * 4); const float dec = __expf(tot[ci * 32 + h]);
        u32x2 o = {cvtpk(s0[0], s0[1]), cvtpk(s0[2], s0[3])}; *(u32x2*)(S + (size_t)ci * 262144 + rem * 4) = o;
        const f32x4 r = {s0[0] * dec + bflo(v.x), s0[1] * dec + bfhi(v.x), s0[2] * dec + bflo(v.y), s0[3] * dec + bfhi(v.y)};
        *(f32x4*)(a.out + OUT_SSMS + (size_t)db * 262144 + rem * 4) = r;
    }
}

__device__ __forceinline__ void p8_phase(const Args& a, LAS unsigned char* L, const int wave) {
    const int lane = lane_id(); int tid = wave * 64 + lane; asm volatile("" : "+v"(tid)); tid &= 511;
    unsigned char* ws = a.ws; const bf16_t* xc = (const bf16_t*)(ws + WS_X); const float* dt = (const float*)(ws + WS_DT); const float* acs = (const float*)(ws + WS_ACS);
    const bf16_t* S = (const bf16_t*)(ws + WS_S); bf16_t* zb = (bf16_t*)(ws + WS_Z);
    LAS bf16_t* Cs = (LAS bf16_t*)L; LAS bf16_t* Bs = (LAS bf16_t*)(L + 18432); LAS bf16_t* Xs = (LAS bf16_t*)(L + 36864);
    LAS float* aj = (LAS float*)(L + 104448); LAS float* dj = (LAS float*)(L + 106496); LAS float* red = (LAS float*)(L + 108544);
    const int li = lane & 15, quad = lane >> 4;
    const unsigned voffB = (unsigned)((tid >> 4) * 3072 + (tid & 15) * 8), voffX = (unsigned)((tid >> 6) * 3072 + (tid & 63) * 8);
    for (int u = blockIdx.x; u < 2120; u += gridDim.x) {
        int ci, i, g;
        if (u < 2048) { i = 3 - (u >> 9); const int rest = u & 511; ci = (rest >> 8) * 65 + 1 + ((rest & 255) >> 2); g = rest & 3; }
        else { int v = u - 2048; i = 0; g = v & 3; if (v < 8) ci = (v >> 2) * 65; else ci = 130 + ((v - 8) >> 2); }
        int row0, ntok; chunk_info(ci, row0, ntok);
        const int rb = row0 + 64 * i, nti = (ntok - 64 * i) < 64 ? (ntok - 64 * i) : 64, h = 8 * g + wave;
        __syncthreads();
#pragma unroll
        for (int i2 = 0; i2 < 2; ++i2) { const bf16_t* gb = xc + (size_t)(rb + 32 * i2) * 3072 + 2560 + 128 * g;
            *(LAS u32x4*)(Cs + ((tid >> 4) + 32 * i2) * 144 + (tid & 15) * 8) = *(const u32x4*)(gb + voffB); }
        __syncthreads();
        const bf16_t* Sp = S + ((size_t)(ci * 32 + h) * 64) * 128;
        const float Dh = a.in[I_SSMD][h];
        { constexpr int ih = 0;
        f32x4 acc[4][4];
#pragma unroll
        for (int pb = 0; pb < 4; ++pb)
#pragma unroll
            for (int ib = 0; ib < 4; ++ib) acc[pb][ib] = (f32x4){0.f, 0.f, 0.f, 0.f};
#pragma unroll
        for (int ks = 0; ks < 4; ++ks) { bf16x8 Af[4], Bf[4];
#pragma unroll
            for (int pb = 0; pb < 4; ++pb) Af[pb] = *(const bf16x8*)(Sp + (size_t)(16 * pb + li) * 128 + 32 * ks + 8 * quad);
#pragma unroll
            for (int ib = 0; ib < 4; ++ib) Bf[ib] = *(const LAS bf16x8*)(Cs + (32 * ih + 16 * ib + li) * 144 + 32 * ks + 8 * quad);
#pragma unroll
            for (int pb = 0; pb < 4; ++pb)
#pragma unroll
                for (int ib = 0; ib < 4; ++ib) acc[pb][ib] = MFMA16(Af[pb], Bf[ib], acc[pb][ib]);
            __builtin_amdgcn_sched_barrier(0); }
        float ai[4];
#pragma unroll
        for (int ib = 0; ib < 4; ++ib) { ai[ib] = acs[(size_t)(rb + 32 * ih + 16 * ib + li) * 32 + h]; const float e = __expf(ai[ib]);
#pragma unroll
            for (int pb = 0; pb < 4; ++pb) acc[pb][ib] = acc[pb][ib] * e; }
        for (int j = 0; j <= i; ++j) {
            const int rj = row0 + 64 * j;
            __syncthreads();
#pragma unroll
            for (int i2 = 0; i2 < 2; ++i2) { const bf16_t* gb = xc + (size_t)(rj + 32 * i2) * 3072 + 2048 + 128 * g;
                *(LAS u32x4*)(Bs + ((tid >> 4) + 32 * i2) * 144 + (tid & 15) * 8) = *(const u32x4*)(gb + voffB); }
#pragma unroll
            for (int i2 = 0; i2 < 8; ++i2) { const bf16_t* gb = xc + (size_t)(rj + 8 * i2) * 3072 + 512 * g;
                *(LAS u32x4*)(Xs + ((tid >> 6) + 8 * i2) * 528 + (tid & 63) * 8) = *(const u32x4*)(gb + voffX); }
            { const int hh = tid >> 6, t = tid & 63; const size_t r = (size_t)(rj + t) * 32 + 8 * g + hh; aj[hh * 64 + t] = acs[r]; dj[hh * 64 + t] = dt[r]; }
            __syncthreads();
#pragma unroll
            for (int ib = 0; ib < 4; ++ib) {
                f32x4 cb[4];
#pragma unroll
                for (int jb = 0; jb < 4; ++jb) cb[jb] = (f32x4){0.f, 0.f, 0.f, 0.f};
#pragma unroll
                for (int ks = 0; ks < 4; ++ks) { const bf16x8 Bc = *(const LAS bf16x8*)(Cs + (32 * ih + 16 * ib + li) * 144 + 32 * ks + 8 * quad);
#pragma unroll
                    for (int jb = 0; jb < 4; ++jb) { const bf16x8 Ab = *(const LAS bf16x8*)(Bs + (16 * jb + li) * 144 + 32 * ks + 8 * quad); cb[jb] = MFMA16(Ab, Bc, cb[jb]); } }
                const int ti = 32 * ih + 16 * ib + li;
#pragma unroll
                for (int jb = 0; jb < 4; ++jb) { const f32x4 a4 = *(const LAS f32x4*)(aj + wave * 64 + 16 * jb + 4 * quad), d4 = *(const LAS f32x4*)(dj + wave * 64 + 16 * jb + 4 * quad);
#pragma unroll
                    for (int jj = 0; jj < 4; ++jj) { const int tj = 16 * jb + 4 * quad + jj; float val = cb[jb][jj] * __expf(fminf(ai[ib] - a4[jj], 0.f)) * d4[jj];
                        if (j == i && tj > ti) val = 0.f; cb[jb][jj] = val; } }
#pragma unroll
                for (int s2 = 0; s2 < 2; ++s2) { u32x4 pk = {cvtpk(cb[2 * s2][0], cb[2 * s2][1]), cvtpk(cb[2 * s2][2], cb[2 * s2][3]), cvtpk(cb[2 * s2 + 1][0], cb[2 * s2 + 1][1]), cvtpk(cb[2 * s2 + 1][2], cb[2 * s2 + 1][3])};
                    const bf16x8 P = __builtin_bit_cast(bf16x8, pk); const LAS bf16_t* xp = Xs + (32 * s2 + 4 * quad + (li >> 2)) * 528 + 64 * wave + 4 * (li & 3);
#pragma unroll
                    for (int pb = 0; pb < 4; ++pb) { const bf16x8 XAf = cat8(ldtr(xp + 16 * pb), ldtr(xp + 16 * 528 + 16 * pb)); acc[pb][ib] = MFMA16(XAf, P, acc[pb][ib]); } }
                __builtin_amdgcn_sched_barrier(0);
            }
        }
        float ss[4];
#pragma unroll
        for (int ib = 0; ib < 4; ++ib) { ss[ib] = 0.f; const int ti = 32 * ih + 16 * ib + li;
#pragma unroll
            for (int pb = 0; pb < 4; ++pb) { const int p0 = 16 * pb + 4 * quad; const u32x2 xr = *(const LAS u32x2*)(Xs + ti * 528 + 64 * wave + p0);
                const u32x2 zr = *(const u32x2*)(zb + (size_t)(rb + ti) * 2048 + 64 * h + p0);
                const float x4[4] = {bflo(xr.x), bfhi(xr.x), bflo(xr.y), bfhi(xr.y)}, z4[4] = {bflo(zr.x), bfhi(zr.x), bflo(zr.y), bfhi(zr.y)};
#pragma unroll
                for (int jj = 0; jj < 4; ++jj) { const float y = (acc[pb][ib][jj] + Dh * x4[jj]) * silu_f(z4[jj]); acc[pb][ib][jj] = y; ss[ib] += y * y; } }
            ss[ib] += __shfl_xor(ss[ib], 16); ss[ib] += __shfl_xor(ss[ib], 32);
            if (quad == 0) red[wave * 64 + ti] = ss[ib]; }
        __syncthreads();
#pragma unroll
        for (int ib = 0; ib < 4; ++ib) { const int ti = 32 * ih + 16 * ib + li; float t8 = 0.f;
#pragma unroll
            for (int w = 0; w < 8; ++w) t8 += red[w * 64 + ti];
            const float rs = rsqrtf(t8 * (1.f / 512.f) + EPS);
            if (ti < nti) {
#pragma unroll
                for (int pb = 0; pb < 4; ++pb) { const int p0 = 16 * pb + 4 * quad; const f32x4 gn = *(const f32x4*)(a.in[I_SSMN] + 64 * h + p0);
                    u32x2 o = {cvtpk(acc[pb][ib][0] * rs * gn[0], acc[pb][ib][1] * rs * gn[1]), cvtpk(acc[pb][ib][2] * rs * gn[2], acc[pb][ib][3] * rs * gn[3])};
                    *(u32x2*)(zb + (size_t)(rb + ti) * 2048 + 64 * h + p0) = o; } } }
        }
    }
}

__device__ __forceinline__ void attn_tile(bool prompt, int b_or_db, int tt, int& row0, int& nv) {
    if (tt == 0) { row0 = R_M0; nv = 16; return; }
    if (prompt) { row0 = b_or_db * 16384 + 64 * (tt - 1); nv = 64; }
    else if (tt <= 16) { row0 = R_C0 + 1024 * b_or_db + 64 * (tt - 1); nv = 64; }
    else { row0 = R_S0 + 32 * b_or_db; nv = 32; }
}
__device__ __forceinline__ void p11_phase(const Args& a, LAS unsigned char* L, const int wave) {
    const int lane = lane_id(); int tid = wave * 64 + lane; asm volatile("" : "+v"(tid)); tid &= 511;
    unsigned char* ws = a.ws; const bf16_t* Q = (const bf16_t*)(ws + WS_Q); const bf16_t* Kn = (const bf16_t*)(ws + WS_KN); const bf16_t* Vt = (const bf16_t*)(ws + WS_VT);
    const bf16_t* krb = (const bf16_t*)(ws + WS_KRB); bf16_t* O = (bf16_t*)(ws + WS_O); const float* rope = (const float*)(ws + WS_ROPE);
    LAS bf16_t* Ks = (LAS bf16_t*)L; LAS bf16_t* Vs = (LAS bf16_t*)(L + 13312);
    const int li = lane & 15, quad = lane >> 4;
    for (int u = blockIdx.x; u < 2304; u += gridDim.x) {
        bool prompt, active; int bq, hd, qr0, ntiles, limit;
        if (u < 2048) { const int k = u >> 8, c32 = (u & 255) >> 5, qblk = 63 - 8 * k - ((k & 1) ? 7 - c32 : c32); prompt = true; bq = (u & 31) >> 4; hd = u & 15;
            qr0 = bq * 16384 + 256 * qblk; ntiles = 4 * qblk + 5; limit = 4 * qblk + (wave >> 1) + 1; active = true; }
        else { const int v = u - 2048; prompt = false; bq = v >> 4; hd = v & 15; qr0 = R_S0 + 32 * bq; ntiles = 18; limit = 17; active = (wave == 0); }
        const int qrow = qr0 + 32 * wave;
        bf16x8 qf[2][3];
#pragma unroll
        for (int qb = 0; qb < 2; ++qb) {
            const int r = active ? qrow + 16 * qb + li : 0; const bf16_t* qp = Q + (size_t)r * 1536;
            qf[qb][0] = *(const bf16x8*)(qp + hd * 64 + 8 * quad); qf[qb][1] = *(const bf16x8*)(qp + hd * 64 + 32 + 8 * quad);
            const u32x4 x1 = *(const u32x4*)(qp + 1024 + hd * 32 + 8 * (quad & 1)), x2 = *(const u32x4*)(qp + 1024 + hd * 32 + 16 + 8 * (quad & 1));
            const float* rp = rope + ((size_t)pos_idx(r) * 16 + 8 * (quad & 1)) * 2; float ov[8];
#pragma unroll
            for (int e = 0; e < 4; ++e) { const f32x4 cs = *(const f32x4*)(rp + 4 * e);
                const float a0 = bflo(x1[e]), a1 = bfhi(x1[e]), b0 = bflo(x2[e]), b1 = bfhi(x2[e]);
                ov[2 * e] = quad < 2 ? a0 * cs[0] - b0 * cs[1] : a0 * cs[1] + b0 * cs[0]; ov[2 * e + 1] = quad < 2 ? a1 * cs[2] - b1 * cs[3] : a1 * cs[3] + b1 * cs[2]; }
            u32x4 pkq = {cvtpk(ov[0], ov[1]), cvtpk(ov[2], ov[3]), cvtpk(ov[4], ov[5]), cvtpk(ov[6], ov[7])}; qf[qb][2] = __builtin_bit_cast(bf16x8, pkq);
        }
        float mrun[2] = {-INFINITY, -INFINITY}, lrun[2] = {0.f, 0.f}; f32x4 o[4][2];
#pragma unroll
        for (int db = 0; db < 4; ++db) { o[db][0] = (f32x4){0.f, 0.f, 0.f, 0.f}; o[db][1] = o[db][0]; }
        int row0, nv; attn_tile(prompt, bq, 0, row0, nv);
        u32x4 pkn = *(const u32x4*)(Kn + (size_t)(row0 + (tid >> 3)) * 1024 + hd * 64 + (tid & 7) * 8);
        u32x4 pkr = *(const u32x4*)(krb + (size_t)(row0 + ((tid & 255) >> 2)) * 32 + (tid & 3) * 8);
        u32x4 pvt = *(const u32x4*)(Vt + (size_t)(hd * 64 + (tid >> 3)) * RK + row0 + (tid & 7) * 8);
        for (int tt = 0; tt < ntiles; ++tt) {
            const int nvc = nv;
            __syncthreads();
            *(LAS u32x4*)(Ks + (tid >> 3) * 104 + (tid & 7) * 8) = pkn;
            if (tid < 256) *(LAS u32x4*)(Ks + (tid >> 2) * 104 + 64 + (tid & 3) * 8) = pkr;
            *(LAS u32x4*)(Vs + (tid >> 3) * 72 + (tid & 7) * 8) = pvt;
            __syncthreads();
            if (tt + 1 < ntiles) { attn_tile(prompt, bq, tt + 1, row0, nv);
                pkn = *(const u32x4*)(Kn + (size_t)(row0 + (tid >> 3)) * 1024 + hd * 64 + (tid & 7) * 8);
                pkr = *(const u32x4*)(krb + (size_t)(row0 + ((tid & 255) >> 2)) * 32 + (tid & 3) * 8);
                pvt = *(const u32x4*)(Vt + (size_t)(hd * 64 + (tid >> 3)) * RK + row0 + (tid & 7) * 8); }
            if (active && tt <= limit) {
                f32x4 s[4][2];
#pragma unroll
                for (int kb = 0; kb < 4; ++kb) { s[kb][0] = (f32x4){0.f, 0.f, 0.f, 0.f}; s[kb][1] = s[kb][0]; }
#pragma unroll
                for (int ks = 0; ks < 3; ++ks)
#pragma unroll
                    for (int kb = 0; kb < 4; ++kb) { const bf16x8 kf = *(const LAS bf16x8*)(Ks + (16 * kb + li) * 104 + 32 * ks + 8 * quad);
                        s[kb][0] = MFMA16(kf, qf[0][ks], s[kb][0]); s[kb][1] = MFMA16(kf, qf[1][ks], s[kb][1]); }
                if (nvc < 64) {
#pragma unroll
                    for (int kb = 0; kb < 4; ++kb)
#pragma unroll
                        for (int jj = 0; jj < 4; ++jj) if (16 * kb + 4 * quad + jj >= nvc) { s[kb][0][jj] = -INFINITY; s[kb][1][jj] = -INFINITY; } }
                bf16x8 P[2][2];
#pragma unroll
                for (int qb = 0; qb < 2; ++qb) {
                    float mx = -INFINITY;
#pragma unroll
                    for (int kb = 0; kb < 4; ++kb) mx = fmaxf(mx, fmaxf(fmaxf(s[kb][qb][0], s[kb][qb][1]), fmaxf(s[kb][qb][2], s[kb][qb][3])));
                    mx = fmaxf(mx, __shfl_xor(mx, 16)); mx = fmaxf(mx, __shfl_xor(mx, 32));
                    const float mn = fmaxf(mrun[qb], mx), alpha = __builtin_amdgcn_exp2f(mrun[qb] - mn); mrun[qb] = mn;
                    float rsum = 0.f;
#pragma unroll
                    for (int kb = 0; kb < 4; ++kb)
#pragma unroll
                        for (int jj = 0; jj < 4; ++jj) { const float p = __builtin_amdgcn_exp2f(s[kb][qb][jj] - mn); s[kb][qb][jj] = p; rsum += p; }
                    lrun[qb] = lrun[qb] * alpha + rsum;
#pragma unroll
                    for (int db = 0; db < 4; ++db) o[db][qb] = o[db][qb] * alpha;
#pragma unroll
                    for (int s2 = 0; s2 < 2; ++s2) { u32x4 pk = {cvtpk(s[2 * s2][qb][0], s[2 * s2][qb][1]), cvtpk(s[2 * s2][qb][2], s[2 * s2][qb][3]), cvtpk(s[2 * s2 + 1][qb][0], s[2 * s2 + 1][qb][1]), cvtpk(s[2 * s2 + 1][qb][2], s[2 * s2 + 1][qb][3])};
                        P[qb][s2] = __builtin_bit_cast(bf16x8, pk); }
                }
#pragma unroll
                for (int s2 = 0; s2 < 2; ++s2)
#pragma unroll
                    for (int db = 0; db < 4; ++db) { const LAS bf16_t* vp = Vs + (16 * db + li) * 72 + 32 * s2 + 4 * quad;
                        const bf16x8 vf = cat8u(*(const LAS u32x2*)vp, *(const LAS u32x2*)(vp + 16));
                        o[db][0] = MFMA16(vf, P[0][s2], o[db][0]); o[db][1] = MFMA16(vf, P[1][s2], o[db][1]); }
            }
        }
        if (active) {
#pragma unroll
            for (int qb = 0; qb < 2; ++qb) { float l = lrun[qb]; l += __shfl_xor(l, 16); l += __shfl_xor(l, 32); const float inv = 1.f / l;
#pragma unroll
                for (int db = 0; db < 4; ++db) { u32x2 w = {cvtpk(o[db][qb][0] * inv, o[db][qb][1] * inv), cvtpk(o[db][qb][2] * inv, o[db][qb][3] * inv)};
                    *(u32x2*)(O + (size_t)(qrow + 16 * qb + li) * 1024 + hd * 64 + 16 * db + 4 * quad) = w; } }
        }
    }
}

#ifndef ONLY_PHASE
#define ONLY_PHASE -1
#endif
#define PH(k) (ONLY_PHASE < 0 || ONLY_PHASE == (k))
constexpr int NPHASE = 20;
constexpr int LDS_BYTES = 131072;
__device__ __forceinline__ void grid_barrier(unsigned* ctr, unsigned target, int wave) {
    __builtin_amdgcn_fence(__ATOMIC_RELEASE, "agent");
    __syncthreads();
    if (wave == 0 && lane_id() == 0) {
        __hip_atomic_fetch_add(ctr, 1u, __ATOMIC_RELEASE, __HIP_MEMORY_SCOPE_AGENT);
        while (__hip_atomic_load(ctr, __ATOMIC_ACQUIRE, __HIP_MEMORY_SCOPE_AGENT) < target) __builtin_amdgcn_s_sleep(2);
    }
    __syncthreads();
    __builtin_amdgcn_fence(__ATOMIC_ACQUIRE, "agent");
}
__global__ void __launch_bounds__(512, 2) fwd_megakernel(Args a) {
    extern __shared__ __attribute__((aligned(16))) unsigned char lds_raw[];
    LAS unsigned char* L = (LAS unsigned char*)lds_raw;
    unsigned char* ws = a.ws;
    bf16_t* W_IN = (bf16_t*)(ws + WS_W_IN); bf16_t* W_GU = (bf16_t*)(ws + WS_W_GU); bf16_t* W_D = (bf16_t*)(ws + WS_W_D); bf16_t* W_SO = (bf16_t*)(ws + WS_W_SO);
    bf16_t* W_UQ = (bf16_t*)(ws + WS_W_UQ); bf16_t* W_K = (bf16_t*)(ws + WS_W_K); bf16_t* W_V = (bf16_t*)(ws + WS_W_V); bf16_t* W_MO = (bf16_t*)(ws + WS_W_MO); bf16_t* W_MIX = (bf16_t*)(ws + WS_W_MIX);
    float* hmeta = (float*)(ws + WS_HMETA);
    const RowMap rm{a.out, hmeta, a.in[I_XP], a.in[I_XS], a.in[I_META]};
    const int wave = __builtin_amdgcn_readfirstlane((int)threadIdx.x >> 6);
    unsigned* bar = (unsigned*)(ws + WS_BAR);
    if (a.ph_hi > 1000) { cg::grid_group grid = cg::this_grid(); grid.sync(); }
    const int lo = a.ph_lo, hi = a.ph_hi;
    __builtin_amdgcn_fence(__ATOMIC_ACQUIRE, "agent");
#define TIDS const int lane = lane_id(); int tid = wave * 64 + lane; asm volatile("" : "+v"(tid)); tid &= 511; const int gw = blockIdx.x * 8 + wave, NGW = gridDim.x * 8; (void)tid; (void)lane; (void)gw; (void)NGW;
#define IN(k) (PH(k) && lo <= (k) && (k) < hi)
#define SEAM(k) do { if ((k) + 1 < hi) grid_barrier(bar, (unsigned)((k) + 1 - lo) * gridDim.x, wave); } while (0)
    {
        {
        if (IN(0)) { { TIDS
            LAS float* scr = (LAS float*)L;
            xpose_matrix(a.in[I_F1GU], 1024, 2 * FFN, W_GU, 2 * FFN, 1, scr, tid);
            xpose_matrix(a.in[I_F1D], FFN, 1024, W_D, 1024, 0, scr, tid);
            xpose_matrix(a.in[I_WIN], 1024, 7872, W_IN, 7936, 2, scr, tid);
            xpose_matrix(a.in[I_WSO], 2048, 1024, W_SO, 1024, 0, scr, tid);
            xpose_matrix(a.in[I_WUQ], 384, 1536, W_UQ, 1536, 3, scr, tid);
            xpose_matrix(a.in[I_WUKV], 256, 2048, W_K, 1024, 4, scr, tid);
            xpose_matrix(a.in[I_WUKV], 256, 2048, W_V, 1024, 5, scr, tid);
            xpose_matrix(a.in[I_WMO], 1024, 1024, W_MO, 1024, 0, scr, tid);
            xpose_matrix(a.in[I_WMIX], 1024, 1024, W_MIX, 1024, 0, scr, tid);
            __syncthreads();
            bf16_t* xn = (bf16_t*)(ws + WS_U);
            for (int row = gw; row < R1; row += NGW) norm_row_bf16(xrow(rm, row), a.in[I_F1N], xn + (size_t)row * D, lane);
            float* rope = (float*)(ws + WS_ROPE);
            for (int e = blockIdx.x * 512 + tid; e < 16400 * 16; e += gridDim.x * 512) { const int i = e & 15, pos = (e >> 4) - 16;
                const float inv = __builtin_amdgcn_exp2f(-(float)i * 0.83048202372184058f); const float ang = (float)pos * inv;
                double rev = (double)ang * 0.15915494309189535; rev -= __builtin_rint(rev); const float r = (float)rev;
                rope[2 * e] = __builtin_amdgcn_cosf(r); rope[2 * e + 1] = __builtin_amdgcn_sinf(r); }
        } SEAM(0); }
        if (IN(1)) { { EpiSwiglu E{(bf16_t*)(ws + WS_ACT)}; run_gemm(L, (const bf16_t*)(ws + WS_U), W_GU, R1, 2 * FFN, 1024, E, wave); } SEAM(1); }
        if (IN(2)) { { EpiResid E{rm, 0.5f, 0}; run_gemm(L, (const bf16_t*)(ws + WS_ACT), W_D, R1, 1024, FFN, E, wave); } SEAM(2); }
        if (IN(3)) { { TIDS
            bf16_t* un = (bf16_t*)(ws + WS_U);
            for (int row = gw; row < R1; row += NGW) norm_row_bf16(hrow(rm, row), a.in[I_MIXN], un + (size_t)row * D, lane);
            LAS float* scr = (LAS float*)L;
            xpose_matrix(a.in[I_F2GU], 1024, 2 * FFN, W_GU, 2 * FFN, 1, scr, tid);
            xpose_matrix(a.in[I_F2D], FFN, 1024, W_D, 1024, 0, scr, tid);
            __syncthreads();
        } SEAM(3); }
        if (IN(4)) { { EpiProj E{(bf16_t*)(ws + WS_Z), (bf16_t*)(ws + WS_X), (bf16_t*)(ws + WS_MISC), (bf16_t*)(ws + WS_HALO), a.out};
                  run_gemm(L, (const bf16_t*)(ws + WS_U), W_IN, R1, 5888, 1024, E, wave); } SEAM(4); }
        if (IN(5)) { p5_phase(a, wave); SEAM(5); }
        if (IN(6)) { p6_phase(a, L, wave); SEAM(6); }
        if (IN(7)) { p7_phase(a, wave); SEAM(7); }
        if (IN(8)) { p8_phase(a, L, wave); SEAM(8); }
        if (IN(9)) { { EpiBf16 E{(bf16_t*)(ws + WS_YS), 1024, 1.0f}; run_gemm(L, (const bf16_t*)(ws + WS_Z), W_SO, R2, 1024, 2048, E, wave); } SEAM(9); }
        if (IN(10)) { {
            for (int gi = 0; gi < 3; ++gi) {
                const bf16_t* A = gi == 0 ? (const bf16_t*)(ws + WS_CQN) : (gi == 1 ? (const bf16_t*)(ws + WS_CKVB) : W_V);
                const bf16_t* B = gi == 0 ? W_UQ : (gi == 1 ? W_K : (const bf16_t*)(ws + WS_CKVB));
                const int M = gi == 0 ? R2 : (gi == 1 ? RK : 1024), N = gi == 0 ? 1536 : (gi == 1 ? 1024 : RK), K = gi == 0 ? 384 : 256;
                EpiBf16 E{gi == 0 ? (bf16_t*)(ws + WS_Q) : (gi == 1 ? (bf16_t*)(ws + WS_KN) : (bf16_t*)(ws + WS_VT)), N, gi == 0 ? QSCALE : 1.0f};
                run_gemm(L, A, B, M, N, K, E, wave);
            }
        } SEAM(10); }
        if (IN(11)) { p11_phase(a, L, wave); SEAM(11); }
        if (IN(12)) { { TIDS bf16_t* un = (bf16_t*)(ws + WS_Z); for (int row = gw; row < R2; row += NGW) norm_row_bf16(hrow(rm, row), a.in[I_MIXN], un + (size_t)row * D, lane); } SEAM(12); }
        if (IN(13)) { { EpiGate E{(bf16_t*)(ws + WS_G), a.in[I_GBIAS]}; run_gemm(L, (const bf16_t*)(ws + WS_Z), W_IN + (size_t)5888 * 1024, R2, 2048, 1024, E, wave); } SEAM(13); }
        if (IN(14)) { { EpiMerge E{(const bf16_t*)(ws + WS_G), (bf16_t*)(ws + WS_YS)}; run_gemm(L, (const bf16_t*)(ws + WS_O), W_MO, R2, 1024, 1024, E, wave); } SEAM(14); }
        if (IN(15)) { { EpiResid E{rm, 1.0f, 1}; run_gemm(L, (const bf16_t*)(ws + WS_YS), W_MIX, R2, 1024, 1024, E, wave); } SEAM(15); }
        if (IN(16)) { { TIDS bf16_t* hn = (bf16_t*)(ws + WS_Z); for (int row = gw; row < R2; row += NGW) norm_row_bf16(hrow(rm, row), a.in[I_F2N], hn + (size_t)row * D, lane); } SEAM(16); }
        if (IN(17)) { { EpiSwiglu E{(bf16_t*)(ws + WS_ACT)}; run_gemm(L, (const bf16_t*)(ws + WS_Z), W_GU, R2, 2 * FFN, 1024, E, wave); } SEAM(17); }
        if (IN(18)) { { EpiResid E{rm, 0.5f, 1}; run_gemm(L, (const bf16_t*)(ws + WS_ACT), W_D, R2, 1024, FFN, E, wave); } SEAM(18); }
        if (IN(19)) { { TIDS
            for (int row = gw; row < R2; row += NGW) { float* hp = a.out + (size_t)row * D; f32x4 v[4]; float s = 0.f;
#pragma unroll
                for (int j = 0; j < 4; ++j) { v[j] = ((const f32x4*)hp)[lane + 64 * j]; s += v[j][0] * v[j][0] + v[j][1] * v[j][1] + v[j][2] * v[j][2] + v[j][3] * v[j][3]; }
                const float rs = rsqrtf(wave_sum(s) * (1.f / 1024.f) + EPS);
#pragma unroll
                for (int j = 0; j < 4; ++j) { const f32x4 g = ((const f32x4*)a.in[I_FINN])[lane + 64 * j]; ((f32x4*)hp)[lane + 64 * j] = v[j] * rs * g; } }
        } SEAM(19); }
        }
    }
    __builtin_amdgcn_fence(__ATOMIC_RELEASE, "agent");
}

#ifndef N_LAUNCH_MODE
#define N_LAUNCH_MODE 1
#endif
extern "C" void kernel_launch(void* const* d_in, const int* in_sizes, int n_in, void* d_out, int out_size, void* d_ws, size_t ws_size, hipStream_t stream) {
    static int grid = 0;
    if (grid == 0) {
        if (n_in != 30 || ws_size < WS_END) { fprintf(stderr, "kernel_launch: unexpected n_in %d / ws_size %zu (need %zu)\n", n_in, ws_size, (size_t)WS_END); grid = -1; return; }
        int dev = 0, cus = 0, per_cu = 0;
        hipGetDevice(&dev); hipDeviceGetAttribute(&cus, hipDeviceAttributeMultiprocessorCount, dev);
        if (hipFuncSetAttribute((const void*)fwd_megakernel, hipFuncAttributeMaxDynamicSharedMemorySize, LDS_BYTES) != hipSuccess) { fprintf(stderr, "kernel_launch: hipFuncSetAttribute failed\n"); grid = -1; return; }
        if (hipOccupancyMaxActiveBlocksPerMultiprocessor(&per_cu, (const void*)fwd_megakernel, 512, LDS_BYTES) != hipSuccess || per_cu < 1) per_cu = 1;
        (void)hipGetLastError();
        grid = cus * 1;
        if (grid <= 0) grid = 256;
    }
    if (grid < 0) return;
    Args a{};
    for (int i = 0; i < 30; ++i) a.in[i] = (const float*)d_in[i];
    a.out = (float*)d_out; a.ws = (unsigned char*)d_ws;
#if N_LAUNCH_MODE == 1
    a.ph_lo = 0; a.ph_hi = NPHASE;
    if (hipMemsetAsync((unsigned char*)d_ws + WS_BAR, 0, 256, stream) != hipSuccess) { fprintf(stderr, "memset failed\n"); return; }
    void* args[] = {&a};
    hipError_t e = hipLaunchCooperativeKernel((const void*)fwd_megakernel, dim3(grid), dim3(512), args, LDS_BYTES, stream);
    if (e != hipSuccess) fprintf(stderr, "cooperative launch failed: %s (grid %d)\n", hipGetErrorString(e), grid);
#else
    for (int ph = 0; ph < NPHASE; ++ph) { a.ph_lo = ph; a.ph_hi = ph + 1; hipLaunchKernelGGL(fwd_megakernel, dim3(grid), dim3(512), LDS_BYTES, stream, a); }
#endif
}
```

```cpp
#include <hip/hip_runtime.h>
#include <hip/hip_cooperative_groups.h>
#include <cstdio>
#include <cstdint>
namespace cg = cooperative_groups;
namespace pg8 {
#define PG8_LAS __attribute__((address_space(3)))
typedef unsigned short bf16_t;
typedef short bf16x8 __attribute__((ext_vector_type(8)));
typedef float f32x4 __attribute__((ext_vector_type(4)));
typedef unsigned u32x4 __attribute__((ext_vector_type(4)));
constexpr int BM = 256, BK = 64, HALF = 128, HTB = HALF * BK * 2  , STAGE_BYTES = 8 * HTB, NXCD = 8, WGM = 8;

__host__ __device__ __forceinline__ int lds_byte(int r, int c) { const int st = (r >> 4) * 2 + (c >> 5), rr = r & 15, cc = c & 31, ob = rr * 64 + cc * 2; return st * 1024 + (ob ^ (((ob >> 9) & 1) << 5)); }
__host__ __device__ __forceinline__ void stage_rc(int b, int& R, int& C) { const int st = b / 1024, sb = b % 1024, swz = sb ^ (((sb >> 9) & 1) << 5); R = (st >> 1) * 16 + swz / 64; C = (st & 1) * 32 + (swz % 64) / 2; }
__host__ __device__ __forceinline__ int perm32(int rho) { const int n = rho >> 4, i = rho & 15; return 8 * (i >> 2) + 4 * n + (i & 3); }

struct Unit { int pm, pn; };
struct Gemm { const bf16_t* A; const bf16_t* Bt; int M, N, K; };

struct StaticOrder {
    int nM, nN, nwg, G, c;
    __host__ __device__ void init(int M, int N, int G_, int c_) { nM = M / BM; nN = N / BM; nwg = nM * nN; G = G_; c = c_; }
    __host__ __device__ bool next(int i, Unit& u) const {
        const long L = (long)i * G + c; if (L >= nwg) return false;
        int wgid = (int)L; { const int q = nwg / NXCD, r = nwg % NXCD, xcd = wgid % NXCD, off = wgid / NXCD; wgid = (xcd < r ? xcd * (q + 1) : r * (q + 1) + (xcd - r) * q) + off; }
        const int nig = WGM * nN, gid = wgid / nig, fm = gid * WGM, gsz = (nM - fm) < WGM ? (nM - fm) : WGM;
        u.pm = fm + ((wgid % nig) % gsz); u.pn = (wgid % nig) / gsz; return true;
    }
    __device__ __forceinline__ void a_ready(const Unit&) const {}
    __device__ __forceinline__ void done(const Unit&) const {}
};
template <class Epi, class Sched, bool ALIGN_EPI = false, bool SP2 = false>
__device__ __forceinline__ void gemm_phase(PG8_LAS unsigned char* lds, const Gemm g, const Sched& S, const Epi& E, const int wid) {
    const int lane = (int)(__builtin_amdgcn_mbcnt_hi(~0u, __builtin_amdgcn_mbcnt_lo(~0u, 0u)) & 63u), tid = wid * 64 + lane, wr = wid >> 2, wc = wid & 3, fr = lane & 15, fq = lane >> 4;
    const int K = g.K, nt = K / BK;
    unsigned voffA[2], voffB[2];
#pragma unroll
    for (int i = 0; i < 2; ++i) { int R, C; stage_rc(tid * 16 + i * 8192, R, C); const int Rb = Epi::PERM ? ((R & ~31) + perm32(R & 31)) : R;
        voffA[i] = (unsigned)(R * K + C) * 2u; voffB[i] = (unsigned)(Rb * K + C) * 2u; }
    const size_t kstep = (size_t)(BK * 2);
    const size_t hstep = (size_t)HALF * K * 2;
    const size_t tstep = 2 * hstep;
    const unsigned ldsw = (unsigned)wid * 1024u;
    const int aoff = lds_byte(wr * 64 + fr, fq * 8), boff = lds_byte(wc * 32 + fr, fq * 8);
#define PG8_SA(b, h) (((b) * 2 + (h)) * HTB)
#define PG8_SB(b, h) ((4 + (b) * 2 + (h)) * HTB)
#define PG8_STAGE(bufoff, gbase, voff) do { _Pragma("unroll") for (int _i = 0; _i < 2; ++_i) \
        __builtin_amdgcn_global_load_lds((const unsigned*)((const char*)(gbase) + (voff)[_i]), (PG8_LAS unsigned*)(lds + (bufoff) + ldsw + _i * 8192), 16, 0, 0); } while (0)
#define PG8_LDA(dst, b, h) do { _Pragma("unroll") for (int m = 0; m < 4; ++m) _Pragma("unroll") for (int k = 0; k < 2; ++k) dst[m][k] = *(const PG8_LAS bf16x8*)(lds + PG8_SA(b, h) + aoff + m * 2048 + k * 1024); } while (0)
#define PG8_LDB(dst, b, h) do { _Pragma("unroll") for (int n = 0; n < 2; ++n) _Pragma("unroll") for (int k = 0; k < 2; ++k) dst[n][k] = *(const PG8_LAS bf16x8*)(lds + PG8_SB(b, h) + boff + n * 2048 + k * 1024); } while (0)
#define PG8_MMA(ai, bj, At, Bt) do { __builtin_amdgcn_s_setprio(1); _Pragma("unroll") for (int m = 0; m < 4; ++m) _Pragma("unroll") for (int n = 0; n < 2; ++n) _Pragma("unroll") for (int k = 0; k < 2; ++k) \
        acc[ai][bj][m][n] = __builtin_amdgcn_mfma_f32_16x16x32_bf16(Bt[n][k], At[m][k], acc[ai][bj][m][n], 0, 0, 0); __builtin_amdgcn_s_setprio(0); } while (0)
#define PG8_WAIT_V(n) asm volatile("s_waitcnt vmcnt(" #n ")" ::: "memory")
#define PG8_WAIT_L(n) asm volatile("s_waitcnt lgkmcnt(" #n ")" ::: "memory")
#define PG8_BAR __builtin_amdgcn_s_barrier()
#define PG8_SCHED __builtin_amdgcn_sched_barrier(0)
    Unit cur, nxt; int ui = 0;
    if (!S.next(0, cur)) return;
    f32x4 acc[2][2][4][2];
#pragma unroll
    for (int a = 0; a < 2; ++a)
#pragma unroll
        for (int b = 0; b < 2; ++b)
#pragma unroll
            for (int m = 0; m < 4; ++m)
#pragma unroll
                for (int n = 0; n < 2; ++n) acc[a][b][m][n] = (f32x4){0.f, 0.f, 0.f, 0.f};
    bf16x8 At[4][2], B0[2][2], B1[2][2];
    const char* cA = (const char*)g.A + (size_t)cur.pm * tstep; const char* cB = (const char*)g.Bt + (size_t)cur.pn * tstep;
    S.a_ready(cur);
    if constexpr (SP2) {
        PG8_STAGE(PG8_SB(0, 0), cB, voffB); PG8_STAGE(PG8_SB(0, 1), cB + hstep, voffB); PG8_STAGE(PG8_SA(0, 0), cA, voffA); PG8_STAGE(PG8_SA(0, 1), cA + hstep, voffA);
        if (wr == 1) PG8_BAR;
        PG8_WAIT_V(2); PG8_BAR;
        PG8_STAGE(PG8_SB(1, 0), cB + kstep, voffB); PG8_STAGE(PG8_SA(1, 0), cA + kstep, voffA); PG8_STAGE(PG8_SB(1, 1), cB + hstep + kstep, voffB);
        PG8_WAIT_V(6); PG8_BAR;
    } else {
        PG8_STAGE(PG8_SB(0, 0), cB, voffB); PG8_STAGE(PG8_SA(0, 0), cA, voffA); PG8_STAGE(PG8_SB(0, 1), cB + hstep, voffB); PG8_STAGE(PG8_SA(0, 1), cA + hstep, voffA);
        if (wr == 1) PG8_BAR;
        PG8_WAIT_V(4); PG8_BAR;
        PG8_STAGE(PG8_SB(1, 0), cB + kstep, voffB); PG8_STAGE(PG8_SA(1, 0), cA + kstep, voffA); PG8_STAGE(PG8_SB(1, 1), cB + hstep + kstep, voffB);
        PG8_WAIT_V(6); PG8_BAR;
    }
    for (;;) {
        const bool has_next = S.next(ui + 1, nxt);
        const char* nA = has_next ? (const char*)g.A + (size_t)nxt.pm * tstep : cA; const char* nB = has_next ? (const char*)g.Bt + (size_t)nxt.pn * tstep : cB;
        for (int t = 0; t < nt; t += 2) {
            const bool last = (t == nt - 2);
            const char* a1 = cA + (size_t)(t + 1) * kstep;
            const char* a2 = last ? nA : cA + (size_t)(t + 2) * kstep; const char* b2 = last ? nB : cB + (size_t)(t + 2) * kstep;
            const char* a3 = a2 + kstep; const char* b3 = b2 + kstep;
            if (last && has_next) S.a_ready(nxt);
            if constexpr (SP2) {
            PG8_LDB(B0, 0, 0); PG8_LDB(B1, 0, 1); PG8_SCHED; PG8_LDA(At, 0, 0); PG8_STAGE(PG8_SA(1, 1), a1 + hstep, voffA);
            PG8_WAIT_V(8); PG8_WAIT_L(0); PG8_BAR; PG8_MMA(0, 0, At, B0); PG8_MMA(0, 1, At, B1); PG8_BAR; PG8_SCHED;
            PG8_LDA(At, 0, 1); PG8_STAGE(PG8_SB(0, 0), b2, voffB); PG8_STAGE(PG8_SB(0, 1), b2 + hstep, voffB); PG8_STAGE(PG8_SA(0, 0), a2, voffA);
            PG8_WAIT_V(8); PG8_WAIT_L(0); PG8_BAR; PG8_MMA(1, 0, At, B0); PG8_MMA(1, 1, At, B1); PG8_BAR; PG8_SCHED;
            PG8_LDB(B0, 1, 0); PG8_LDB(B1, 1, 1); PG8_SCHED; PG8_LDA(At, 1, 0); PG8_STAGE(PG8_SA(0, 1), a2 + hstep, voffA);
            PG8_WAIT_V(8); PG8_WAIT_L(0); PG8_BAR; PG8_MMA(0, 0, At, B0); PG8_MMA(0, 1, At, B1); PG8_BAR; PG8_SCHED;
            PG8_LDA(At, 1, 1); PG8_STAGE(PG8_SB(1, 0), b3, voffB); PG8_STAGE(PG8_SB(1, 1), b3 + hstep, voffB); PG8_STAGE(PG8_SA(1, 0), a3, voffA);
            PG8_WAIT_V(8); PG8_WAIT_L(0); PG8_BAR; PG8_MMA(1, 0, At, B0); PG8_MMA(1, 1, At, B1); PG8_BAR; PG8_SCHED;
            } else {
            PG8_LDB(B0, 0, 0); PG8_SCHED; PG8_LDA(At, 0, 0); PG8_STAGE(PG8_SA(1, 1), a1 + hstep, voffA);
            PG8_WAIT_L(8); PG8_BAR; PG8_WAIT_L(0); PG8_MMA(0, 0, At, B0); PG8_BAR; PG8_SCHED;
            PG8_LDB(B1, 0, 1); PG8_STAGE(PG8_SB(0, 0), b2, voffB);
            PG8_BAR; PG8_WAIT_L(0); PG8_MMA(0, 1, At, B1); PG8_BAR;
            PG8_LDA(At, 0, 1); PG8_STAGE(PG8_SA(0, 0), a2, voffA);
            PG8_BAR; PG8_WAIT_L(0); PG8_MMA(1, 0, At, B0); PG8_BAR; PG8_SCHED;
            PG8_STAGE(PG8_SB(0, 1), b2 + hstep, voffB);
            PG8_WAIT_V(6); PG8_BAR; PG8_MMA(1, 1, At, B1); PG8_BAR;
            PG8_LDB(B0, 1, 0); PG8_SCHED; PG8_LDA(At, 1, 0); PG8_STAGE(PG8_SA(0, 1), a2 + hstep, voffA);
            PG8_WAIT_L(8); PG8_BAR; PG8_WAIT_L(0); PG8_MMA(0, 0, At, B0); PG8_BAR; PG8_SCHED;
            PG8_LDB(B1, 1, 1); PG8_STAGE(PG8_SB(1, 0), b3, voffB);
            PG8_BAR; PG8_WAIT_L(0); PG8_MMA(0, 1, At, B1); PG8_BAR;
            PG8_LDA(At, 1, 1); PG8_STAGE(PG8_SA(1, 0), a3, voffA);
            PG8_BAR; PG8_WAIT_L(0); PG8_MMA(1, 0, At, B0); PG8_BAR; PG8_SCHED;
            PG8_STAGE(PG8_SB(1, 1), b3 + hstep, voffB);
            PG8_WAIT_V(6); PG8_BAR; PG8_MMA(1, 1, At, B1); PG8_BAR;
            }
        }
        if constexpr (ALIGN_EPI) { if (wr == 0) PG8_BAR; }
        if constexpr (!Epi::AFTER_DRAIN) { E(acc, cur, wr, wc, fr, fq); S.done(cur); }
        if (!has_next) break;
#pragma unroll
        for (int a = 0; a < 2; ++a)
#pragma unroll
            for (int b = 0; b < 2; ++b)
#pragma unroll
                for (int m = 0; m < 4; ++m)
#pragma unroll
                    for (int n = 0; n < 2; ++n) acc[a][b][m][n] = (f32x4){0.f, 0.f, 0.f, 0.f};
        cur = nxt; cA = nA; cB = nB; ++ui;
        if constexpr (ALIGN_EPI) { if (wr == 1) PG8_BAR; }
    }
    PG8_WAIT_V(0);
    if constexpr (!ALIGN_EPI) { if (wr == 0) PG8_BAR; }
    PG8_BAR;
    if constexpr (Epi::AFTER_DRAIN) { E.fused(acc, cur, wr, wc, fr, fq, lds, wid, lane); S.done(cur); }
#undef PG8_SA
#undef PG8_SB
#undef PG8_STAGE
#undef PG8_LDA
#undef PG8_LDB
#undef PG8_MMA
#undef PG8_WAIT_V
#undef PG8_WAIT_L
#undef PG8_BAR
#undef PG8_SCHED
}
}
using namespace pg8;
#define LAS __attribute__((address_space(3)))
typedef short v4i16_t __attribute__((ext_vector_type(4)));
typedef unsigned u32x2 __attribute__((ext_vector_type(2)));
typedef float f32x2 __attribute__((ext_vector_type(2)));

constexpr int D = 1024, FFN = 2816;
constexpr int R_S0 = 32768;
constexpr int R_M0 = 33280;
constexpr int R_ACT = 33296;
constexpr int R1 = 33536;
constexpr int R2 = 33280;
constexpr int RK = 49920;
constexpr int R_C0 = 33536;
constexpr int NCHUNK = 146;
constexpr float EPS = 1e-6f;
constexpr float QSCALE = 0.14724448f;

constexpr size_t MiB = 1048576;
constexpr size_t WS_W_IN = 0, WS_W_GU = 16252928, WS_W_D = 27787264, WS_W_SO = 33554432, WS_W_UQ = 37748736, WS_W_K = 38928384, WS_W_V = 39452672,
                 WS_W_MO = 39976960, WS_W_MIX = 42074112, WS_ROPE = 44171264, WS_HMETA = 46270464, WS_KRB = 47319040, WS_TOT = 50513920, WS_BAR = 50540544;
constexpr size_t WS_Z = 49 * MiB, WS_X = 180 * MiB, WS_U = 376 * MiB + MiB / 2, WS_MISC = 442 * MiB, WS_HALO = WS_MISC + (size_t)R1 * 768 * 2;
constexpr size_t WS_DT = WS_U, WS_ACS = WS_U + 4292608, WS_CQN = WS_U + 8585216, WS_CKVB = WS_U + 34144256, WS_S = WS_U + 57 * MiB;
constexpr size_t WS_YS = 447 * MiB, WS_Q = WS_Z, WS_KN = WS_X, WS_VT = WS_X + 102236160, WS_O = WS_U, WS_G = WS_X, WS_ACT = WS_X;
constexpr size_t WS_END = 512 * MiB;
static_assert(WS_S + (size_t)NCHUNK * 32 * 8192 * 2 <= WS_END && WS_O + (size_t)R2 * 1024 * 2 <= WS_YS && WS_YS + (size_t)R2 * 1024 * 2 <= WS_END, "ws map 4");
static_assert(WS_END <= 512 * MiB, "ws map");
static_assert(WS_CKVB + (size_t)RK * 256 * 2 <= WS_S, "ws map 2");
static_assert(WS_HALO + 514 * 3 * 3072 * 2 <= 512 * MiB, "ws map 3");

constexpr size_t OUT_YP = 0, OUT_YS = 33554432, OUT_CKVP = 34078720, OUT_KRP = 42475520, OUT_SSMP = 43525120, OUT_CONVP = 44049408,
                 OUT_CKVS = 44067840, OUT_KRS = 44198912, OUT_SSMS = 44215296, OUT_CONVS = 48409600;

enum { I_XP = 0, I_XS, I_CCKV, I_CKR, I_SSSM, I_SCONV, I_META, I_F1N, I_F1GU, I_F1D, I_MIXN, I_WIN, I_GBIAS, I_CONVW, I_CONVB, I_DTB, I_ALOG, I_SSMD,
       I_SSMN, I_WSO, I_QN, I_WUQ, I_KVN, I_WUKV, I_WMO, I_WMIX, I_F2N, I_F2GU, I_F2D, I_FINN };

struct Args { const float* in[30]; float* out; unsigned char* ws; int ph_lo, ph_hi; };

__device__ __forceinline__ unsigned f2bf(float f) { unsigned u = __builtin_bit_cast(unsigned, f); return (u + 0x7fffu + ((u >> 16) & 1u)) >> 16; }
typedef float f32x2_t __attribute__((ext_vector_type(2))); typedef __bf16 bf16x2_t __attribute__((ext_vector_type(2)));
__device__ __forceinline__ unsigned cvtpk(float lo, float hi) { f32x2_t v = {lo, hi}; bf16x2_t b = __builtin_convertvector(v, bf16x2_t); return __builtin_bit_cast(unsigned, b); }
__device__ __forceinline__ float bflo(unsigned u) { return __builtin_bit_cast(float, u << 16); }
__device__ __forceinline__ float bfhi(unsigned u) { return __builtin_bit_cast(float, u & 0xffff0000u); }
__device__ __forceinline__ float bf2f(bf16_t b) { return __builtin_bit_cast(float, (unsigned)b << 16); }
__device__ __forceinline__ float wave_sum(float v) {
#pragma unroll
    for (int o = 1; o < 64; o <<= 1) v += __shfl_xor(v, o);
    return v;
}
__device__ __forceinline__ float silu_f(float x) { return x * __builtin_amdgcn_rcpf(1.f + __expf(-x)); }
__device__ __forceinline__ float sigmoid_f(float x) { return __builtin_amdgcn_rcpf(1.f + __expf(-x)); }
__device__ __forceinline__ float softplus_f(float x) { return x > 20.f ? x : log1pf(__expf(x)); }
__device__ __forceinline__ int pos_idx(int row) {
    if (row < R_S0) return (row & 16383) + 16;
    if (row < R_M0) return 1024 + ((row - R_S0) & 31) + 16;
    return row - R_M0;
}
__device__ __forceinline__ void chunk_info(int ci, int& row0, int& ntok) {
    if (ci < 130) { const int b = ci / 65, k = ci - b * 65; if (k == 0) { row0 = R_M0; ntok = 16; } else { row0 = b * 16384 + 256 * (k - 1); ntok = 256; } }
    else { row0 = R_S0 + 32 * (ci - 130); ntok = 32; }
}
__device__ __forceinline__ v4i16_t ldtr(const LAS bf16_t* p) { return __builtin_amdgcn_ds_read_tr16_b64_v4i16((LAS v4i16_t*)p); }
__device__ __forceinline__ bf16x8 cat8(v4i16_t a, v4i16_t b) { return __builtin_shufflevector(a, b, 0, 1, 2, 3, 4, 5, 6, 7); }
__device__ __forceinline__ bf16x8 cat8u(u32x2 a, u32x2 b) { u32x4 t = {a.x, a.y, b.x, b.y}; return __builtin_bit_cast(bf16x8, t); }
#define MFMA16(a, b, c) __builtin_amdgcn_mfma_f32_16x16x32_bf16((a), (b), (c), 0, 0, 0)

struct EpiSwiglu {
    static constexpr bool PERM = true, AFTER_DRAIN = false; bf16_t* O;
    __device__ __forceinline__ void operator()(const f32x4 (&acc)[2][2][4][2], const Unit& u, int wr, int wc, int fr, int fq) const {
        const int row0 = u.pm * 256 + wr * 64 + fr, col0 = u.pn * 128 + wc * 32 + 8 * fq;
#pragma unroll
        for (int ai = 0; ai < 2; ++ai)
#pragma unroll
            for (int m = 0; m < 4; ++m) {
                const f32x4 g0 = acc[ai][0][m][0], g1 = acc[ai][0][m][1], u0 = acc[ai][1][m][0], u1 = acc[ai][1][m][1];
                u32x4 w; w.x = cvtpk(silu_f(g0[0]) * u0[0], silu_f(g0[1]) * u0[1]); w.y = cvtpk(silu_f(g0[2]) * u0[2], silu_f(g0[3]) * u0[3]);
                w.z = cvtpk(silu_f(g1[0]) * u1[0], silu_f(g1[1]) * u1[1]); w.w = cvtpk(silu_f(g1[2]) * u1[2], silu_f(g1[3]) * u1[3]);
                *(u32x4*)(O + (size_t)(row0 + ai * 128 + m * 16) * FFN + col0) = w;
            }
    }
};
struct RowMap { float* out; float* hmeta; const float* xp; const float* xs; const float* meta; };
__device__ __forceinline__ float* hrow(const RowMap& a, int row) { return row < R2 ? a.out + (size_t)row * D : a.hmeta + (size_t)(row - R2) * D; }
__device__ __forceinline__ const float* xrow(const RowMap& a, int row) {
    if (row < R_S0) return a.xp + (size_t)row * D;
    if (row < R_M0) return a.xs + (size_t)(row - R_S0) * D;
    if (row < R_ACT) return a.meta + (size_t)(row - R_M0) * D;
    return nullptr;
}
struct EpiResid {
    static constexpr bool PERM = true, AFTER_DRAIN = false; RowMap a; float s; int mode;
    __device__ __forceinline__ void operator()(const f32x4 (&acc)[2][2][4][2], const Unit& u, int wr, int wc, int fr, int fq) const {
        const int row0 = u.pm * 256 + wr * 64 + fr, col0 = u.pn * 256 + wc * 32 + 8 * fq;
#pragma unroll
        for (int ai = 0; ai < 2; ++ai)
#pragma unroll
            for (int m = 0; m < 4; ++m) {
                const int row = row0 + ai * 128 + m * 16; float* hp = hrow(a, row); const float* bp = mode ? hp : xrow(a, row);
#pragma unroll
                for (int bj = 0; bj < 2; ++bj) {
                    const int c = col0 + bj * 128; f32x4 b0 = {0.f, 0.f, 0.f, 0.f}, b1 = b0;
                    if (bp) { b0 = *(const f32x4*)(bp + c); b1 = *(const f32x4*)(bp + c + 4); }
                    *(f32x4*)(hp + c) = b0 + acc[ai][bj][m][0] * s; *(f32x4*)(hp + c + 4) = b1 + acc[ai][bj][m][1] * s;
                }
            }
    }
};
struct EpiProj {
    static constexpr bool PERM = true, AFTER_DRAIN = false; bf16_t *Z, *X, *MISC, *HALO; float* out;
    __device__ __forceinline__ void operator()(const f32x4 (&acc)[2][2][4][2], const Unit& u, int wr, int wc, int fr, int fq) const {
        const int row0 = u.pm * 256 + wr * 64 + fr; const int pn = u.pn;
#pragma unroll
        for (int ai = 0; ai < 2; ++ai)
#pragma unroll
            for (int m = 0; m < 4; ++m) {
                const int row = row0 + ai * 128 + m * 16;
#pragma unroll
                for (int bj = 0; bj < 2; ++bj) {
                    const f32x4 v0 = acc[ai][bj][m][0], v1 = acc[ai][bj][m][1];
                    u32x4 w; w.x = cvtpk(v0[0], v0[1]); w.y = cvtpk(v0[2], v0[3]); w.z = cvtpk(v1[0], v1[1]); w.w = cvtpk(v1[2], v1[3]);
                    const int ct = bj * 128 + wc * 32 + 8 * fq;
                    if (pn < 8) { *(u32x4*)(Z + (size_t)row * 2048 + pn * 256 + ct) = w; }
                    else if (pn < 20) {
                        const int cx = (pn - 8) * 256 + ct;
                        *(u32x4*)(X + (size_t)row * 3072 + cx) = w;
                        if (row < R_S0) {
                            const int r6 = row & 63;
                            if (r6 >= 61) { const int T = (row >> 6) + 1; if (T & 255) *(u32x4*)(HALO + ((size_t)T * 3 + (r6 - 61)) * 3072 + cx) = w; }
                            const int t = row & 16383;
                            if (t >= 16381) { float* o = out + OUT_CONVP + ((size_t)(row >> 14) * 3 + (t - 16381)) * 3072 + cx; *(f32x4*)o = v0; *(f32x4*)(o + 4) = v1; }
                        } else if (row < R_M0) {
                            const int t = (row - R_S0) & 31, db = (row - R_S0) >> 5;
                            if (t >= 29) { float* o = out + OUT_CONVS + ((size_t)db * 3 + (t - 29)) * 3072 + cx; *(f32x4*)o = v0; *(f32x4*)(o + 4) = v1; }
                        } else if (row >= R_M0 + 13 && row < R_ACT) {
                            const int sl = row - R_M0 - 13;
                            *(u32x4*)(HALO + ((size_t)0 * 3 + sl) * 3072 + cx) = w; *(u32x4*)(HALO + ((size_t)256 * 3 + sl) * 3072 + cx) = w;
                        }
                    } else { *(u32x4*)(MISC + (size_t)row * 768 + (pn - 20) * 256 + ct) = w; }
                }
            }
    }
};
struct EpiBf16 {
    static constexpr bool PERM = true, AFTER_DRAIN = false; bf16_t* O; int ldc; float sc;
    __device__ __forceinline__ void operator()(const f32x4 (&acc)[2][2][4][2], const Unit& u, int wr, int wc, int fr, int fq) const {
        const int row0 = u.pm * 256 + wr * 64 + fr, col0 = u.pn * 256 + wc * 32 + 8 * fq;
#pragma unroll
        for (int ai = 0; ai < 2; ++ai)
#pragma unroll
            for (int m = 0; m < 4; ++m)
#pragma unroll
                for (int bj = 0; bj < 2; ++bj) {
                    const f32x4 v0 = acc[ai][bj][m][0] * sc, v1 = acc[ai][bj][m][1] * sc;
                    u32x4 w; w.x = cvtpk(v0[0], v0[1]); w.y = cvtpk(v0[2], v0[3]); w.z = cvtpk(v1[0], v1[1]); w.w = cvtpk(v1[2], v1[3]);
                    *(u32x4*)(O + (size_t)(row0 + ai * 128 + m * 16) * ldc + col0 + bj * 128) = w;
                }
    }
};
struct EpiGate {
    static constexpr bool PERM = true, AFTER_DRAIN = false; bf16_t* G; const float* bias;
    __device__ __forceinline__ void operator()(const f32x4 (&acc)[2][2][4][2], const Unit& u, int wr, int wc, int fr, int fq) const {
        const int row0 = u.pm * 256 + wr * 64 + fr, col0 = u.pn * 256 + wc * 32 + 8 * fq;
#pragma unroll
        for (int bj = 0; bj < 2; ++bj) {
            const int c = col0 + bj * 128; const f32x4 b0 = *(const f32x4*)(bias + c), b1 = *(const f32x4*)(bias + c + 4);
#pragma unroll
            for (int ai = 0; ai < 2; ++ai)
#pragma unroll
                for (int m = 0; m < 4; ++m) {
                    const f32x4 v0 = acc[ai][bj][m][0] + b0, v1 = acc[ai][bj][m][1] + b1;
                    u32x4 w; w.x = cvtpk(sigmoid_f(v0[0]), sigmoid_f(v0[1])); w.y = cvtpk(sigmoid_f(v0[2]), sigmoid_f(v0[3]));
                    w.z = cvtpk(sigmoid_f(v1[0]), sigmoid_f(v1[1])); w.w = cvtpk(sigmoid_f(v1[2]), sigmoid_f(v1[3]));
                    *(u32x4*)(G + (size_t)(row0 + ai * 128 + m * 16) * 2048 + c) = w;
                }
        }
    }
};
struct EpiMerge {
    static constexpr bool PERM = true, AFTER_DRAIN = false; const bf16_t* G; bf16_t* YS;
    __device__ __forceinline__ void operator()(const f32x4 (&acc)[2][2][4][2], const Unit& u, int wr, int wc, int fr, int fq) const {
        const int row0 = u.pm * 256 + wr * 64 + fr, col0 = u.pn * 256 + wc * 32 + 8 * fq;
#pragma unroll
        for (int ai = 0; ai < 2; ++ai)
#pragma unroll
            for (int m = 0; m < 4; ++m)
#pragma unroll
                for (int bj = 0; bj < 2; ++bj) {
                    const int row = row0 + ai * 128 + m * 16, c = col0 + bj * 128;
                    const u32x4 gs = *(const u32x4*)(G + (size_t)row * 2048 + c), gm = *(const u32x4*)(G + (size_t)row * 2048 + 1024 + c), ys = *(const u32x4*)(YS + (size_t)row * 1024 + c);
                    const f32x4 v0 = acc[ai][bj][m][0], v1 = acc[ai][bj][m][1];
                    u32x4 w;
                    w.x = cvtpk(bflo(gs.x) * bflo(ys.x) + bflo(gm.x) * v0[0], bfhi(gs.x) * bfhi(ys.x) + bfhi(gm.x) * v0[1]);
                    w.y = cvtpk(bflo(gs.y) * bflo(ys.y) + bflo(gm.y) * v0[2], bfhi(gs.y) * bfhi(ys.y) + bfhi(gm.y) * v0[3]);
                    w.z = cvtpk(bflo(gs.z) * bflo(ys.z) + bflo(gm.z) * v1[0], bfhi(gs.z) * bfhi(ys.z) + bfhi(gm.z) * v1[1]);
                    w.w = cvtpk(bflo(gs.w) * bflo(ys.w) + bflo(gm.w) * v1[2], bfhi(gs.w) * bfhi(ys.w) + bfhi(gm.w) * v1[3]);
                    *(u32x4*)(YS + (size_t)row * 1024 + c) = w;
                }
    }
};
__device__ __forceinline__ int lane_id() { return (int)(__builtin_amdgcn_mbcnt_hi(~0u, __builtin_amdgcn_mbcnt_lo(~0u, 0u)) & 63u); }
template <class Epi> __device__ __forceinline__ void run_gemm(LAS unsigned char* lds, const bf16_t* A, const bf16_t* Bt, int M, int N, int K, const Epi& E, int wave) {
    Gemm g{A, Bt, M, N, K}; StaticOrder S; S.init(M, N, (int)gridDim.x, (int)blockIdx.x);
    gemm_phase<Epi, StaticOrder, false, true>(lds, g, S, E, wave);
    __syncthreads();
}

__device__ __forceinline__ int srccol(int mapid, int n) {
    switch (mapid) {
        case 0: return n;
        case 1: { const int pn = n >> 8, bj = (n >> 7) & 1, i = n & 127; return (bj ? FFN : 0) + pn * 128 + i; }
        case 2: return n < 5824 ? n : (n < 5888 ? -1 : n - 64);
        case 3: return n < 1024 ? (n >> 6) * 96 + (n & 63) : ((n - 1024) >> 5) * 96 + 64 + ((n - 1024) & 31);
        case 4: return (n >> 6) * 128 + (n & 63);
        default: return (n >> 6) * 128 + 64 + (n & 63);
    }
}
__device__ __forceinline__ void xpose_matrix(const float* __restrict__ src, int K, int Nsrc, bf16_t* dst, int Ndst, int mapid, LAS float* scr, int tid) {
    const int nblk = Ndst >> 6, nitems = (K >> 6) * nblk;
    for (int item = blockIdx.x; item < nitems; item += gridDim.x) {
        const int kb = item / nblk, nb = item - kb * nblk, k0 = kb * 64, n0 = nb * 64;
        __syncthreads();
#pragma unroll
        for (int i = 0; i < 8; ++i) { const int idx = tid + 512 * i, kk = idx >> 6, nn = idx & 63; const int sc = srccol(mapid, n0 + nn);
            scr[nn * 65 + kk] = sc >= 0 ? src[(size_t)(k0 + kk) * Nsrc + sc] : 0.f; }
        __syncthreads();
        { const int nn = tid >> 3, c = tid & 7; const LAS float* s = scr + nn * 65 + 8 * c;
          u32x4 o; o.x = cvtpk(s[0], s[1]); o.y = cvtpk(s[2], s[3]); o.z = cvtpk(s[4], s[5]); o.w = cvtpk(s[6], s[7]);
          *(u32x4*)(dst + (size_t)(n0 + nn) * K + k0 + 8 * c) = o; }
    }
}
__device__ __forceinline__ void norm_row_bf16(const float* src, const float* gain, bf16_t* dst, int lane) {
    f32x4 v[4]; float s = 0.f;
#pragma unroll
    for (int j = 0; j < 4; ++j) { v[j] = src ? ((const f32x4*)src)[lane + 64 * j] : (f32x4){0.f, 0.f, 0.f, 0.f}; s += v[j][0] * v[j][0] + v[j][1] * v[j][1] + v[j][2] * v[j][2] + v[j][3] * v[j][3]; }
    const float rs = rsqrtf(wave_sum(s) * (1.f / 1024.f) + EPS);
#pragma unroll
    for (int j = 0; j < 4; ++j) { const f32x4 g = ((const f32x4*)gain)[lane + 64 * j];
        u32x2 o = {cvtpk(v[j][0] * rs * g[0], v[j][1] * rs * g[1]), cvtpk(v[j][2] * rs * g[2], v[j][3] * rs * g[3])}; ((u32x2*)dst)[lane + 64 * j] = o; }
}

__device__ __forceinline__ void p5_phase(const Args& a, const int wave) {
    const int lane = lane_id(); int tid = wave * 64 + lane; asm volatile("" : "+v"(tid)); tid &= 511; const int gw = blockIdx.x * 8 + wave, NGW = gridDim.x * 8;
    unsigned char* ws = a.ws;
    const bf16_t* misc = (const bf16_t*)(ws + WS_MISC); float* dt = (float*)(ws + WS_DT); float* acs = (float*)(ws + WS_ACS); float* tot = (float*)(ws + WS_TOT);
    bf16_t* cqn = (bf16_t*)(ws + WS_CQN); bf16_t* ckvb = (bf16_t*)(ws + WS_CKVB); bf16_t* krb = (bf16_t*)(ws + WS_KRB); bf16_t* xc = (bf16_t*)(ws + WS_X);
    const bf16_t* halo = (const bf16_t*)(ws + WS_HALO); const float* rope = (const float*)(ws + WS_ROPE);
    { const int idx = blockIdx.x * 512 + tid;
      if (idx < NCHUNK * 32) { const int ci = idx >> 5, h = idx & 31; int row0, ntok; chunk_info(ci, row0, ntok);
          const float A = -__expf(a.in[I_ALOG][h]), bias = a.in[I_DTB][h]; float accv = 0.f;
          for (int t = 0; t < ntok; t += 8) { float v[8];
#pragma unroll
              for (int k = 0; k < 8; ++k) v[k] = bf2f(misc[(size_t)(row0 + t + k) * 768 + h]);
#pragma unroll
              for (int k = 0; k < 8; ++k) { accv += softplus_f(v[k] + bias) * A; acs[(size_t)(row0 + t + k) * 32 + h] = accv; } }
          tot[ci * 32 + h] = accv; } }
    for (int row = gw; row < R_ACT; row += NGW) {
        const bf16_t* mr = misc + (size_t)row * 768;
        if (lane < 32) dt[(size_t)row * 32 + lane] = softplus_f(bf2f(mr[lane]) + a.in[I_DTB][lane]);
        { const unsigned* cp = (const unsigned*)(mr + 32) + 3 * lane; const unsigned c0 = cp[0], c1 = cp[1], c2 = cp[2];
          float q[6] = {bflo(c0), bfhi(c0), bflo(c1), bfhi(c1), bflo(c2), bfhi(c2)}; float ss = 0.f;
#pragma unroll
          for (int e = 0; e < 6; ++e) ss += q[e] * q[e];
          const float rs = rsqrtf(wave_sum(ss) * (1.f / 384.f) + EPS);
          if (row < R2) { const float* gq = a.in[I_QN] + 6 * lane; unsigned* op = (unsigned*)(cqn + (size_t)row * 384) + 3 * lane;
              op[0] = cvtpk(q[0] * rs * gq[0], q[1] * rs * gq[1]); op[1] = cvtpk(q[2] * rs * gq[2], q[3] * rs * gq[3]); op[2] = cvtpk(q[4] * rs * gq[4], q[5] * rs * gq[5]); } }
        { const u32x2 kv = *(const u32x2*)(mr + 416 + 4 * lane); float v[4] = {bflo(kv.x), bfhi(kv.x), bflo(kv.y), bfhi(kv.y)};
          const float rs = rsqrtf(wave_sum(v[0] * v[0] + v[1] * v[1] + v[2] * v[2] + v[3] * v[3]) * (1.f / 256.f) + EPS);
          const f32x4 g = *(const f32x4*)(a.in[I_KVN] + 4 * lane); const f32x4 o = {v[0] * rs * g[0], v[1] * rs * g[1], v[2] * rs * g[2], v[3] * rs * g[3]};
          if (row < R_S0) *(f32x4*)(a.out + OUT_CKVP + ((size_t)(row >> 14) * 16400 + 16 + (row & 16383)) * 256 + 4 * lane) = o;
          else if (row < R_M0) *(f32x4*)(a.out + OUT_CKVS + (size_t)(row - R_S0) * 256 + 4 * lane) = o;
          else { *(f32x4*)(a.out + OUT_CKVP + (size_t)(row - R_M0) * 256 + 4 * lane) = o; *(f32x4*)(a.out + OUT_CKVP + (size_t)(16400 + row - R_M0) * 256 + 4 * lane) = o; }
          u32x2 ob = {cvtpk(o[0], o[1]), cvtpk(o[2], o[3])}; *(u32x2*)(ckvb + (size_t)row * 256 + 4 * lane) = ob; }
        if (lane < 16) { const float x1 = bf2f(mr[672 + lane]), x2 = bf2f(mr[688 + lane]); const f32x2 cs = *(const f32x2*)(rope + ((size_t)pos_idx(row) * 16 + lane) * 2);
          const float o1 = x1 * cs[0] - x2 * cs[1], o2 = x1 * cs[1] + x2 * cs[0];
          if (row < R_S0) { float* p = a.out + OUT_KRP + ((size_t)(row >> 14) * 16400 + 16 + (row & 16383)) * 32; p[lane] = o1; p[16 + lane] = o2; }
          else if (row < R_M0) { float* p = a.out + OUT_KRS + (size_t)(row - R_S0) * 32; p[lane] = o1; p[16 + lane] = o2; }
          else { float* p = a.out + OUT_KRP + (size_t)(row - R_M0) * 32; p[lane] = o1; p[16 + lane] = o2; p += (size_t)16400 * 32; p[lane] = o1; p[16 + lane] = o2; }
          krb[(size_t)row * 32 + lane] = (bf16_t)f2bf(o1); krb[(size_t)row * 32 + 16 + lane] = (bf16_t)f2bf(o2); }
    }
    for (int row = R_ACT + gw; row < R1; row += NGW) { u32x2 z = {0u, 0u}; *(u32x2*)(ckvb + (size_t)row * 256 + 4 * lane) = z; if (lane < 16) ((unsigned*)(krb + (size_t)row * 32))[lane] = 0u; }
    for (int r = gw; r < 16384; r += NGW) {
        const f32x4 v = *(const f32x4*)(a.in[I_CCKV] + (size_t)r * 256 + 4 * lane); u32x2 o = {cvtpk(v[0], v[1]), cvtpk(v[2], v[3])}; *(u32x2*)(ckvb + (size_t)(R_C0 + r) * 256 + 4 * lane) = o;
        if (lane < 8) { const f32x4 k = *(const f32x4*)(a.in[I_CKR] + (size_t)r * 32 + 4 * lane); u32x2 ok = {cvtpk(k[0], k[1]), cvtpk(k[2], k[3])}; *(u32x2*)(krb + (size_t)(R_C0 + r) * 32 + 4 * lane) = ok; }
    }
    for (int item = gw; item < 529 * 6; item += NGW) {
        const int T = item / 6, cc = item - T * 6, c0 = cc * 512 + lane * 8;
        int row0, nrows; float p0[8], p1[8], p2[8];
        if (T < 512) { row0 = T * 64; nrows = 64; const bf16_t* hp = halo + (size_t)T * 3 * 3072 + c0;
            const u32x4 h0 = *(const u32x4*)hp, h1 = *(const u32x4*)(hp + 3072), h2 = *(const u32x4*)(hp + 6144);
#pragma unroll
            for (int e = 0; e < 4; ++e) { p0[2 * e] = bflo(h0[e]); p0[2 * e + 1] = bfhi(h0[e]); p1[2 * e] = bflo(h1[e]); p1[2 * e + 1] = bfhi(h1[e]); p2[2 * e] = bflo(h2[e]); p2[2 * e + 1] = bfhi(h2[e]); } }
        else if (T == 512) { row0 = R_M0; nrows = 16;
#pragma unroll
            for (int e = 0; e < 8; ++e) { p0[e] = 0.f; p1[e] = 0.f; p2[e] = 0.f; } }
        else { const int db = T - 513; row0 = R_S0 + 32 * db; nrows = 32; const float* sp = a.in[I_SCONV] + (size_t)db * 3 * 3072 + c0;
#pragma unroll
            for (int e = 0; e < 8; ++e) { p0[e] = sp[e]; p1[e] = sp[3072 + e]; p2[e] = sp[6144 + e]; } }
        float w0[8], w1[8], w2[8], w3[8], bb[8];
#pragma unroll
        for (int e = 0; e < 8; ++e) { w0[e] = a.in[I_CONVW][c0 + e]; w1[e] = a.in[I_CONVW][3072 + c0 + e]; w2[e] = a.in[I_CONVW][6144 + c0 + e]; w3[e] = a.in[I_CONVW][9216 + c0 + e]; bb[e] = a.in[I_CONVB][c0 + e]; }
        for (int t0 = 0; t0 < nrows; t0 += 4) {
            u32x4 raw[4];
#pragma unroll
            for (int k = 0; k < 4; ++k) raw[k] = *(const u32x4*)(xc + (size_t)(row0 + t0 + k) * 3072 + c0);
#pragma unroll
            for (int k = 0; k < 4; ++k) { float x[8], y[8];
#pragma unroll
                for (int e = 0; e < 4; ++e) { x[2 * e] = bflo(raw[k][e]); x[2 * e + 1] = bfhi(raw[k][e]); }
#pragma unroll
                for (int e = 0; e < 8; ++e) { y[e] = silu_f(bb[e] + w0[e] * p0[e] + w1[e] * p1[e] + w2[e] * p2[e] + w3[e] * x[e]); p0[e] = p1[e]; p1[e] = p2[e]; p2[e] = x[e]; }
                u32x4 o; o.x = cvtpk(y[0], y[1]); o.y = cvtpk(y[2], y[3]); o.z = cvtpk(y[4], y[5]); o.w = cvtpk(y[6], y[7]);
                *(u32x4*)(xc + (size_t)(row0 + t0 + k) * 3072 + c0) = o; }
        }
    }
}

__device__ __forceinline__ void p6_phase(const Args& a, LAS unsigned char* L, const int wave) {
    const int lane = lane_id(); int tid = wave * 64 + lane; asm volatile("" : "+v"(tid)); tid &= 511;
    unsigned char* ws = a.ws; const bf16_t* xc = (const bf16_t*)(ws + WS_X); const float* dt = (const float*)(ws + WS_DT); const float* acs = (const float*)(ws + WS_ACS);
    const float* tot = (const float*)(ws + WS_TOT); bf16_t* S = (bf16_t*)(ws + WS_S);
    LAS bf16_t* Bs = (LAS bf16_t*)L; LAS bf16_t* Xs = (LAS bf16_t*)(L + 18432); LAS float* scs = (LAS float*)(L + 86016);
    const int li = lane & 15, quad = lane >> 4;
    const unsigned voffB = (unsigned)((tid >> 4) * 3072 + (tid & 15) * 8), voffX = (unsigned)((tid >> 6) * 3072 + (tid & 63) * 8);
    for (int unit = blockIdx.x; unit < NCHUNK * 4; unit += gridDim.x) {
        const int ci = unit >> 2, g = unit & 3, h = 8 * g + wave; int row0, ntok; chunk_info(ci, row0, ntok);
        f32x4 acc[8][4];
#pragma unroll
        for (int nb = 0; nb < 8; ++nb)
#pragma unroll
            for (int pb = 0; pb < 4; ++pb) acc[nb][pb] = (f32x4){0.f, 0.f, 0.f, 0.f};
        const int nsub = (ntok + 63) >> 6;
        for (int jb = 0; jb < nsub; ++jb) {
            const int rj = row0 + 64 * jb;
            __syncthreads();
            { const int hh = tid >> 6, t = tid & 63; const size_t r = (size_t)(rj + t) * 32 + 8 * g + hh; float v = 0.f;
              if (64 * jb + t < ntok) v = __expf(tot[ci * 32 + 8 * g + hh] - acs[r]) * dt[r];
              scs[hh * 64 + t] = v; }
#pragma unroll
            for (int i = 0; i < 2; ++i) { const bf16_t* gb = xc + (size_t)(rj + 32 * i) * 3072 + 2048 + 128 * g;
                *(LAS u32x4*)(Bs + ((tid >> 4) + 32 * i) * 144 + (tid & 15) * 8) = *(const u32x4*)(gb + voffB); }
            __syncthreads();
#pragma unroll
            for (int i = 0; i < 8; ++i) { const int t = (tid >> 6) + 8 * i, c = tid & 63; const bf16_t* gb = xc + (size_t)(rj + 8 * i) * 3072 + 512 * g;
                const u32x4 v = *(const u32x4*)(gb + voffX); const float s = scs[(c >> 3) * 64 + t];
                u32x4 o; o.x = cvtpk(bflo(v.x) * s, bfhi(v.x) * s); o.y = cvtpk(bflo(v.y) * s, bfhi(v.y) * s); o.z = cvtpk(bflo(v.z) * s, bfhi(v.z) * s); o.w = cvtpk(bflo(v.w) * s, bfhi(v.w) * s);
                *(LAS u32x4*)(Xs + t * 528 + c * 8) = o; }
            __syncthreads();
#pragma unroll
            for (int s2 = 0; s2 < 2; ++s2) {
                const int tok0 = 32 * s2 + 4 * quad + (li >> 2), cq4 = 4 * (li & 3);
                bf16x8 Bf[4];
#pragma unroll
                for (int pb = 0; pb < 4; ++pb) Bf[pb] = cat8(ldtr(Xs + tok0 * 528 + 64 * wave + 16 * pb + cq4), ldtr(Xs + (tok0 + 16) * 528 + 64 * wave + 16 * pb + cq4));
#pragma unroll
                for (int nb = 0; nb < 8; ++nb) { const bf16x8 Af = cat8(ldtr(Bs + tok0 * 144 + 16 * nb + cq4), ldtr(Bs + (tok0 + 16) * 144 + 16 * nb + cq4));
#pragma unroll
                    for (int pb = 0; pb < 4; ++pb) acc[nb][pb] = MFMA16(Af, Bf[pb], acc[nb][pb]); }
            }
        }
        bf16_t* Sp = S + ((size_t)(ci * 32 + h) * 64) * 128;
#pragma unroll
        for (int nb = 0; nb < 8; ++nb)
#pragma unroll
            for (int pb = 0; pb < 4; ++pb) { u32x2 o = {cvtpk(acc[nb][pb][0], acc[nb][pb][1]), cvtpk(acc[nb][pb][2], acc[nb][pb][3])};
                *(u32x2*)(Sp + (size_t)(16 * pb + li) * 128 + 16 * nb + 4 * quad) = o; }
    }
}

__device__ __forceinline__ void p7_phase(const Args& a, const int wave) {
    int tid = wave * 64 + lane_id(); asm volatile("" : "+v"(tid)); tid &= 511;
    unsigned char* ws = a.ws; bf16_t* S = (bf16_t*)(ws + WS_S); const float* tot = (const float*)(ws + WS_TOT);
    const int gt = blockIdx.x * 512 + tid, NT = gridDim.x * 512;
    for (int e = gt; e < 131072; e += NT) {
        const int b = e >> 16, rem = e & 65535, h = rem >> 11; f32x4 st = {0.f, 0.f, 0.f, 0.f};
        for (int k0 = 0; k0 < 65; k0 += 5) { u32x2 v[5]; float dec[5];
#pragma unroll
            for (int k = 0; k < 5; ++k) { const int ci = b * 65 + k0 + k; v[k] = *(const u32x2*)(S + (size_t)ci * 262144 + rem * 4); dec[k] = __expf(tot[ci * 32 + h]); }
#pragma unroll
            for (int k = 0; k < 5; ++k) { const int ci = b * 65 + k0 + k; u32x2 o = {cvtpk(st[0], st[1]), cvtpk(st[2], st[3])}; *(u32x2*)(S + (size_t)ci * 262144 + rem * 4) = o;
                st[0] = st[0] * dec[k] + bflo(v[k].x); st[1] = st[1] * dec[k] + bfhi(v[k].x); st[2] = st[2] * dec[k] + bflo(v[k].y); st[3] = st[3] * dec[k] + bfhi(v[k].y); } }
        *(f32x4*)(a.out + OUT_SSMP + (size_t)b * 262144 + rem * 4) = st;
    }
    for (int e = gt; e < 16 * 65536; e += NT) {
        const int db = e >> 16, rem = e & 65535, h = rem >> 11, ci = 130 + db;
        const f32x4 s0 = *(const f32x4*)(a.in[I_SSSM] + (size_t)db * 262144 + rem * 4); const u32x2 v = *(const u32x2*)(S + (size_t)ci * 262144 + rem * 4); const float dec = __expf(tot[ci * 32 + h]);
        u32x2 o = {cvtpk(s0[0], s0[1]), cvtpk(s0[2], s0[3])}; *(u32x2*)(S + (size_t)ci * 262144 + rem * 4) = o;
        const f32x4 r = {s0[0] * dec + bflo(v.x), s0[1] * dec + bfhi(v.x), s0[2] * dec + bflo(v.y), s0[3] * dec + bfhi(v.y)};
        *(f32x4*)(a.out + OUT_SSMS + (size_t)db * 262144 + rem * 4) = r;
    }
}

__device__ __forceinline__ void p8_phase(const Args& a, LAS unsigned char* L, const int wave) {
    const int lane = lane_id(); int tid = wave * 64 + lane; asm volatile("" : "+v"(tid)); tid &= 511;
    unsigned char* ws = a.ws; const bf16_t* xc = (const bf16_t*)(ws + WS_X); const float* dt = (const float*)(ws + WS_DT); const float* acs = (const float*)(ws + WS_ACS);
    const bf16_t* S = (const bf16_t*)(ws + WS_S); bf16_t* zb = (bf16_t*)(ws + WS_Z);
    LAS bf16_t* Cs = (LAS bf16_t*)L; LAS bf16_t* Bs = (LAS bf16_t*)(L + 18432); LAS bf16_t* Xs = (LAS bf16_t*)(L + 36864);
    LAS float* aj = (LAS float*)(L + 104448); LAS float* dj = (LAS float*)(L + 106496); LAS float* red = (LAS float*)(L + 108544);
    const int li = lane & 15, quad = lane >> 4;
    const unsigned voffB = (unsigned)((tid >> 4) * 3072 + (tid & 15) * 8), voffX = (unsigned)((tid >> 6) * 3072 + (tid & 63) * 8);
    for (int u = blockIdx.x; u < 2120; u += gridDim.x) {
        int ci, i, g;
        if (u < 2048) { i = 3 - (u >> 9); const int rest = u & 511; ci = (rest >> 8) * 65 + 1 + ((rest & 255) >> 2); g = rest & 3; }
        else { int v = u - 2048; i = 0; g = v & 3; if (v < 8) ci = (v >> 2) * 65; else ci = 130 + ((v - 8) >> 2); }
        int row0, ntok; chunk_info(ci, row0, ntok);
        const int rb = row0 + 64 * i, nti = (ntok - 64 * i) < 64 ? (ntok - 64 * i) : 64, h = 8 * g + wave;
        __syncthreads();
#pragma unroll
        for (int i2 = 0; i2 < 2; ++i2) { const bf16_t* gb = xc + (size_t)(rb + 32 * i2) * 3072 + 2560 + 128 * g;
            *(LAS u32x4*)(Cs + ((tid >> 4) + 32 * i2) * 144 + (tid & 15) * 8) = *(const u32x4*)(gb + voffB); }
        __syncthreads();
        const bf16_t* Sp = S + ((size_t)(ci * 32 + h) * 64) * 128;
        const float Dh = a.in[I_SSMD][h];
        { constexpr int ih = 0;
        f32x4 acc[4][4];
#pragma unroll
        for (int pb = 0; pb < 4; ++pb)
#pragma unroll
            for (int ib = 0; ib < 4; ++ib) acc[pb][ib] = (f32x4){0.f, 0.f, 0.f, 0.f};
#pragma unroll
        for (int ks = 0; ks < 4; ++ks) { bf16x8 Af[4], Bf[4];
#pragma unroll
            for (int pb = 0; pb < 4; ++pb) Af[pb] = *(const bf16x8*)(Sp + (size_t)(16 * pb + li) * 128 + 32 * ks + 8 * quad);
#pragma unroll
            for (int ib = 0; ib < 4; ++ib) Bf[ib] = *(const LAS bf16x8*)(Cs + (32 * ih + 16 * ib + li) * 144 + 32 * ks + 8 * quad);
#pragma unroll
            for (int pb = 0; pb < 4; ++pb)
#pragma unroll
                for (int ib = 0; ib < 4; ++ib) acc[pb][ib] = MFMA16(Af[pb], Bf[ib], acc[pb][ib]);
            __builtin_amdgcn_sched_barrier(0); }
        float ai[4];
#pragma unroll
        for (int ib = 0; ib < 4; ++ib) { ai[ib] = acs[(size_t)(rb + 32 * ih + 16 * ib + li) * 32 + h]; const float e = __expf(ai[ib]);
#pragma unroll
            for (int pb = 0; pb < 4; ++pb) acc[pb][ib] = acc[pb][ib] * e; }
        for (int j = 0; j <= i; ++j) {
            const int rj = row0 + 64 * j;
            __syncthreads();
#pragma unroll
            for (int i2 = 0; i2 < 2; ++i2) { const bf16_t* gb = xc + (size_t)(rj + 32 * i2) * 3072 + 2048 + 128 * g;
                *(LAS u32x4*)(Bs + ((tid >> 4) + 32 * i2) * 144 + (tid & 15) * 8) = *(const u32x4*)(gb + voffB); }
#pragma unroll
            for (int i2 = 0; i2 < 8; ++i2) { const bf16_t* gb = xc + (size_t)(rj + 8 * i2) * 3072 + 512 * g;
                *(LAS u32x4*)(Xs + ((tid >> 6) + 8 * i2) * 528 + (tid & 63) * 8) = *(const u32x4*)(gb + voffX); }
            { const int hh = tid >> 6, t = tid & 63; const size_t r = (size_t)(rj + t) * 32 + 8 * g + hh; aj[hh * 64 + t] = acs[r]; dj[hh * 64 + t] = dt[r]; }
            __syncthreads();
#pragma unroll
            for (int ib = 0; ib < 4; ++ib) {
                f32x4 cb[4];
#pragma unroll
                for (int jb = 0; jb < 4; ++jb) cb[jb] = (f32x4){0.f, 0.f, 0.f, 0.f};
#pragma unroll
                for (int ks = 0; ks < 4; ++ks) { const bf16x8 Bc = *(const LAS bf16x8*)(Cs + (32 * ih + 16 * ib + li) * 144 + 32 * ks + 8 * quad);
#pragma unroll
                    for (int jb = 0; jb < 4; ++jb) { const bf16x8 Ab = *(const LAS bf16x8*)(Bs + (16 * jb + li) * 144 + 32 * ks + 8 * quad); cb[jb] = MFMA16(Ab, Bc, cb[jb]); } }
                const int ti = 32 * ih + 16 * ib + li;
#pragma unroll
                for (int jb = 0; jb < 4; ++jb) { const f32x4 a4 = *(const LAS f32x4*)(aj + wave * 64 + 16 * jb + 4 * quad), d4 = *(const LAS f32x4*)(dj + wave * 64 + 16 * jb + 4 * quad);
#pragma unroll
                    for (int jj = 0; jj < 4; ++jj) { const int tj = 16 * jb + 4 * quad + jj; float val = cb[jb][jj] * __expf(fminf(ai[ib] - a4[jj], 0.f)) * d4[jj];
                        if (j == i && tj > ti) val = 0.f; cb[jb][jj] = val; } }
#pragma unroll
                for (int s2 = 0; s2 < 2; ++s2) { u32x4 pk = {cvtpk(cb[2 * s2][0], cb[2 * s2][1]), cvtpk(cb[2 * s2][2], cb[2 * s2][3]), cvtpk(cb[2 * s2 + 1][0], cb[2 * s2 + 1][1]), cvtpk(cb[2 * s2 + 1][2], cb[2 * s2 + 1][3])};
                    const bf16x8 P = __builtin_bit_cast(bf16x8, pk); const LAS bf16_t* xp = Xs + (32 * s2 + 4 * quad + (li >> 2)) * 528 + 64 * wave + 4 * (li & 3);
#pragma unroll
                    for (int pb = 0; pb < 4; ++pb) { const bf16x8 XAf = cat8(ldtr(xp + 16 * pb), ldtr(xp + 16 * 528 + 16 * pb)); acc[pb][ib] = MFMA16(XAf, P, acc[pb][ib]); } }
                __builtin_amdgcn_sched_barrier(0);
            }
        }
        float ss[4];
#pragma unroll
        for (int ib = 0; ib < 4; ++ib) { ss[ib] = 0.f; const int ti = 32 * ih + 16 * ib + li;
#pragma unroll
            for (int pb = 0; pb < 4; ++pb) { const int p0 = 16 * pb + 4 * quad; const u32x2 xr = *(const LAS u32x2*)(Xs + ti * 528 + 64 * wave + p0);
                const u32x2 zr = *(const u32x2*)(zb + (size_t)(rb + ti) * 2048 + 64 * h + p0);
                const float x4[4] = {bflo(xr.x), bfhi(xr.x), bflo(xr.y), bfhi(xr.y)}, z4[4] = {bflo(zr.x), bfhi(zr.x), bflo(zr.y), bfhi(zr.y)};
#pragma unroll
                for (int jj = 0; jj < 4; ++jj) { const float y = (acc[pb][ib][jj] + Dh * x4[jj]) * silu_f(z4[jj]); acc[pb][ib][jj] = y; ss[ib] += y * y; } }
            ss[ib] += __shfl_xor(ss[ib], 16); ss[ib] += __shfl_xor(ss[ib], 32);
            if (quad == 0) red[wave * 64 + ti] = ss[ib]; }
        __syncthreads();
#pragma unroll
        for (int ib = 0; ib < 4; ++ib) { const int ti = 32 * ih + 16 * ib + li; float t8 = 0.f;
#pragma unroll
            for (int w = 0; w < 8; ++w) t8 += red[w * 64 + ti];
            const float rs = rsqrtf(t8 * (1.f / 512.f) + EPS);
            if (ti < nti) {
#pragma unroll
                for (int pb = 0; pb < 4; ++pb) { const int p0 = 16 * pb + 4 * quad; const f32x4 gn = *(const f32x4*)(a.in[I_SSMN] + 64 * h + p0);
                    u32x2 o = {cvtpk(acc[pb][ib][0] * rs * gn[0], acc[pb][ib][1] * rs * gn[1]), cvtpk(acc[pb][ib][2] * rs * gn[2], acc[pb][ib][3] * rs * gn[3])};
                    *(u32x2*)(zb + (size_t)(rb + ti) * 2048 + 64 * h + p0) = o; } } }
        }
    }
}

__device__ __forceinline__ void attn_tile(bool prompt, int b_or_db, int tt, int& row0, int& nv) {
    if (tt == 0) { row0 = R_M0; nv = 16; return; }
    if (prompt) { row0 = b_or_db * 16384 + 64 * (tt - 1); nv = 64; }
    else if (tt <= 16) { row0 = R_C0 + 1024 * b_or_db + 64 * (tt - 1); nv = 64; }
    else { row0 = R_S0 + 32 * b_or_db; nv = 32; }
}
__device__ __forceinline__ void p11_phase(const Args& a, LAS unsigned char* L, const int wave) {
    const int lane = lane_id(); int tid = wave * 64 + lane; asm volatile("" : "+v"(tid)); tid &= 511;
    unsigned char* ws = a.ws; const bf16_t* Q = (const bf16_t*)(ws + WS_Q); const bf16_t* Kn = (const bf16_t*)(ws + WS_KN); const bf16_t* Vt = (const bf16_t*)(ws + WS_VT);
    const bf16_t* krb = (const bf16_t*)(ws + WS_KRB); bf16_t* O = (bf16_t*)(ws + WS_O); const float* rope = (const float*)(ws + WS_ROPE);
    LAS bf16_t* Ks = (LAS bf16_t*)L; LAS bf16_t* Vs = (LAS bf16_t*)(L + 13312);
    const int li = lane & 15, quad = lane >> 4;
    for (int u = blockIdx.x; u < 2304; u += gridDim.x) {
        bool prompt, active; int bq, hd, qr0, ntiles, limit;
        if (u < 2048) { const int k = u >> 8, c32 = (u & 255) >> 5, qblk = 63 - 8 * k - ((k & 1) ? 7 - c32 : c32); prompt = true; bq = (u & 31) >> 4; hd = u & 15;
            qr0 = bq * 16384 + 256 * qblk; ntiles = 4 * qblk + 5; limit = 4 * qblk + (wave >> 1) + 1; active = true; }
        else { const int v = u - 2048; prompt = false; bq = v >> 4; hd = v & 15; qr0 = R_S0 + 32 * bq; ntiles = 18; limit = 17; active = (wave == 0); }
        const int qrow = qr0 + 32 * wave;
        bf16x8 qf[2][3];
#pragma unroll
        for (int qb = 0; qb < 2; ++qb) {
            const int r = active ? qrow + 16 * qb + li : 0; const bf16_t* qp = Q + (size_t)r * 1536;
            qf[qb][0] = *(const bf16x8*)(qp + hd * 64 + 8 * quad); qf[qb][1] = *(const bf16x8*)(qp + hd * 64 + 32 + 8 * quad);
            const u32x4 x1 = *(const u32x4*)(qp + 1024 + hd * 32 + 8 * (quad & 1)), x2 = *(const u32x4*)(qp + 1024 + hd * 32 + 16 + 8 * (quad & 1));
            const float* rp = rope + ((size_t)pos_idx(r) * 16 + 8 * (quad & 1)) * 2; float ov[8];
#pragma unroll
            for (int e = 0; e < 4; ++e) { const f32x4 cs = *(const f32x4*)(rp + 4 * e);
                const float a0 = bflo(x1[e]), a1 = bfhi(x1[e]), b0 = bflo(x2[e]), b1 = bfhi(x2[e]);
                ov[2 * e] = quad < 2 ? a0 * cs[0] - b0 * cs[1] : a0 * cs[1] + b0 * cs[0]; ov[2 * e + 1] = quad < 2 ? a1 * cs[2] - b1 * cs[3] : a1 * cs[3] + b1 * cs[2]; }
            u32x4 pkq = {cvtpk(ov[0], ov[1]), cvtpk(ov[2], ov[3]), cvtpk(ov[4], ov[5]), cvtpk(ov[6], ov[7])}; qf[qb][2] = __builtin_bit_cast(bf16x8, pkq);
        }
        float mrun[2] = {-INFINITY, -INFINITY}, lrun[2] = {0.f, 0.f}; f32x4 o[4][2];
#pragma unroll
        for (int db = 0; db < 4; ++db) { o[db][0] = (f32x4){0.f, 0.f, 0.f, 0.f}; o[db][1] = o[db][0]; }
        int row0, nv; attn_tile(prompt, bq, 0, row0, nv);
        u32x4 pkn = *(const u32x4*)(Kn + (size_t)(row0 + (tid >> 3)) * 1024 + hd * 64 + (tid & 7) * 8);
        u32x4 pkr = *(const u32x4*)(krb + (size_t)(row0 + ((tid & 255) >> 2)) * 32 + (tid & 3) * 8);
        u32x4 pvt = *(const u32x4*)(Vt + (size_t)(hd * 64 + (tid >> 3)) * RK + row0 + (tid & 7) * 8);
        for (int tt = 0; tt < ntiles; ++tt) {
            const int nvc = nv;
            __syncthreads();
            *(LAS u32x4*)(Ks + (tid >> 3) * 104 + (tid & 7) * 8) = pkn;
            if (tid < 256) *(LAS u32x4*)(Ks + (tid >> 2) * 104 + 64 + (tid & 3) * 8) = pkr;
            *(LAS u32x4*)(Vs + (tid >> 3) * 72 + (tid & 7) * 8) = pvt;
            __syncthreads();
            if (tt + 1 < ntiles) { attn_tile(prompt, bq, tt + 1, row0, nv);
                pkn = *(const u32x4*)(Kn + (size_t)(row0 + (tid >> 3)) * 1024 + hd * 64 + (tid & 7) * 8);
                pkr = *(const u32x4*)(krb + (size_t)(row0 + ((tid & 255) >> 2)) * 32 + (tid & 3) * 8);
                pvt = *(const u32x4*)(Vt + (size_t)(hd * 64 + (tid >> 3)) * RK + row0 + (tid & 7) * 8); }
            if (active && tt <= limit) {
                f32x4 s[4][2];
#pragma unroll
                for (int kb = 0; kb < 4; ++kb) { s[kb][0] = (f32x4){0.f, 0.f, 0.f, 0.f}; s[kb][1] = s[kb][0]; }
#pragma unroll
                for (int ks = 0; ks < 3; ++ks)
#pragma unroll
                    for (int kb = 0; kb < 4; ++kb) { const bf16x8 kf = *(const LAS bf16x8*)(Ks + (16 * kb + li) * 104 + 32 * ks + 8 * quad);
                        s[kb][0] = MFMA16(kf, qf[0][ks], s[kb][0]); s[kb][1] = MFMA16(kf, qf[1][ks], s[kb][1]); }
                if (nvc < 64) {
#pragma unroll
                    for (int kb = 0; kb < 4; ++kb)
#pragma unroll
                        for (int jj = 0; jj < 4; ++jj) if (16 * kb + 4 * quad + jj >= nvc) { s[kb][0][jj] = -INFINITY; s[kb][1][jj] = -INFINITY; } }
                bf16x8 P[2][2];
#pragma unroll
                for (int qb = 0; qb < 2; ++qb) {
                    float mx = -INFINITY;
#pragma unroll
                    for (int kb = 0; kb < 4; ++kb) mx = fmaxf(mx, fmaxf(fmaxf(s[kb][qb][0], s[kb][qb][1]), fmaxf(s[kb][qb][2], s[kb][qb][3])));
                    mx = fmaxf(mx, __shfl_xor(mx, 16)); mx = fmaxf(mx, __shfl_xor(mx, 32));
                    const float mn = fmaxf(mrun[qb], mx), alpha = __builtin_amdgcn_exp2f(mrun[qb] - mn); mrun[qb] = mn;
                    float rsum = 0.f;
#pragma unroll
                    for (int kb = 0; kb < 4; ++kb)
#pragma unroll
                        for (int jj = 0; jj < 4; ++jj) { const float p = __builtin_amdgcn_exp2f(s[kb][qb][jj] - mn); s[kb][qb][jj] = p; rsum += p; }
                    lrun[qb] = lrun[qb] * alpha + rsum;
#pragma unroll
                    for (int db = 0; db < 4; ++db) o[db][qb] = o[db][qb] * alpha;
#pragma unroll
                    for (int s2 = 0; s2 < 2; ++s2) { u32x4 pk = {cvtpk(s[2 * s2][qb][0], s[2 * s2][qb][1]), cvtpk(s[2 * s2][qb][2], s[2 * s2][qb][3]), cvtpk(s[2 * s2 + 1][qb][0], s[2 * s2 + 1][qb][1]), cvtpk(s[2 * s2 + 1][qb][2], s[2 * s2 + 1][qb][3])};
                        P[qb][s2] = __builtin_bit_cast(bf16x8, pk); }
                }
#pragma unroll
                for (int s2 = 0; s2 < 2; ++s2)
#pragma unroll
                    for (int db = 0; db < 4; ++db) { const LAS bf16_t* vp = Vs + (16 * db + li) * 72 + 32 * s2 + 4 * quad;
                        const bf16x8 vf = cat8u(*(const LAS u32x2*)vp, *(const LAS u32x2*)(vp + 16));
                        o[db][0] = MFMA16(vf, P[0][s2], o[db][0]); o[db][1] = MFMA16(vf, P[1][s2], o[db][1]); }
            }
        }
        if (active) {
#pragma unroll
            for (int qb = 0; qb < 2; ++qb) { float l = lrun[qb]; l += __shfl_xor(l, 16); l += __shfl_xor(l, 32); const float inv = 1.f / l;
#pragma unroll
                for (int db = 0; db < 4; ++db) { u32x2 w = {cvtpk(o[db][qb][0] * inv, o[db][qb][1] * inv), cvtpk(o[db][qb][2] * inv, o[db][qb][3] * inv)};
                    *(u32x2*)(O + (size_t)(qrow + 16 * qb + li) * 1024 + hd * 64 + 16 * db + 4 * quad) = w; } }
        }
    }
}

#ifndef ONLY_PHASE
#define ONLY_PHASE -1
#endif
#define PH(k) (ONLY_PHASE < 0 || ONLY_PHASE == (k))
constexpr int NPHASE = 20;
constexpr int LDS_BYTES = 131072;
__device__ __forceinline__ void grid_barrier(unsigned* ctr, unsigned target, int wave) {
    __syncthreads();
    if (wave == 0) {
        __builtin_amdgcn_fence(__ATOMIC_RELEASE, "agent");
        if (lane_id() == 0) {
            __hip_atomic_fetch_add(ctr, 1u, __ATOMIC_RELAXED, __HIP_MEMORY_SCOPE_AGENT);
            while (__hip_atomic_load(ctr, __ATOMIC_RELAXED, __HIP_MEMORY_SCOPE_AGENT) < target) __builtin_amdgcn_s_sleep(1);
        }
        __builtin_amdgcn_fence(__ATOMIC_ACQUIRE, "agent");
    }
    __syncthreads();
}
__global__ void __launch_bounds__(512, 2) fwd_megakernel(Args a) {
    extern __shared__ __attribute__((aligned(16))) unsigned char lds_raw[];
    LAS unsigned char* L = (LAS unsigned char*)lds_raw;
    unsigned char* ws = a.ws;
    bf16_t* W_IN = (bf16_t*)(ws + WS_W_IN); bf16_t* W_GU = (bf16_t*)(ws + WS_W_GU); bf16_t* W_D = (bf16_t*)(ws + WS_W_D); bf16_t* W_SO = (bf16_t*)(ws + WS_W_SO);
    bf16_t* W_UQ = (bf16_t*)(ws + WS_W_UQ); bf16_t* W_K = (bf16_t*)(ws + WS_W_K); bf16_t* W_V = (bf16_t*)(ws + WS_W_V); bf16_t* W_MO = (bf16_t*)(ws + WS_W_MO); bf16_t* W_MIX = (bf16_t*)(ws + WS_W_MIX);
    float* hmeta = (float*)(ws + WS_HMETA);
    const RowMap rm{a.out, hmeta, a.in[I_XP], a.in[I_XS], a.in[I_META]};
    const int wave = __builtin_amdgcn_readfirstlane((int)threadIdx.x >> 6);
    unsigned* bar = (unsigned*)(ws + WS_BAR);
    if (a.ph_hi > 1000) { cg::grid_group grid = cg::this_grid(); grid.sync(); }
    const int lo = a.ph_lo, hi = a.ph_hi;
    __builtin_amdgcn_fence(__ATOMIC_ACQUIRE, "agent");
#define TIDS const int lane = lane_id(); int tid = wave * 64 + lane; asm volatile("" : "+v"(tid)); tid &= 511; const int gw = blockIdx.x * 8 + wave, NGW = gridDim.x * 8; (void)tid; (void)lane; (void)gw; (void)NGW;
#define IN(k) (PH(k) && lo <= (k) && (k) < hi)
#define SEAM(k) do { if ((k) + 1 < hi) grid_barrier(bar, (unsigned)((k) + 1 - lo) * gridDim.x, wave); } while (0)
    {
        {
        if (IN(0)) { { TIDS
            LAS float* scr = (LAS float*)L;
            xpose_matrix(a.in[I_F1GU], 1024, 2 * FFN, W_GU, 2 * FFN, 1, scr, tid);
            xpose_matrix(a.in[I_F1D], FFN, 1024, W_D, 1024, 0, scr, tid);
            xpose_matrix(a.in[I_WIN], 1024, 7872, W_IN, 7936, 2, scr, tid);
            xpose_matrix(a.in[I_WSO], 2048, 1024, W_SO, 1024, 0, scr, tid);
            xpose_matrix(a.in[I_WUQ], 384, 1536, W_UQ, 1536, 3, scr, tid);
            xpose_matrix(a.in[I_WUKV], 256, 2048, W_K, 1024, 4, scr, tid);
            xpose_matrix(a.in[I_WUKV], 256, 2048, W_V, 1024, 5, scr, tid);
            xpose_matrix(a.in[I_WMO], 1024, 1024, W_MO, 1024, 0, scr, tid);
            xpose_matrix(a.in[I_WMIX], 1024, 1024, W_MIX, 1024, 0, scr, tid);
            __syncthreads();
            bf16_t* xn = (bf16_t*)(ws + WS_U);
            for (int row = gw; row < R1; row += NGW) norm_row_bf16(xrow(rm, row), a.in[I_F1N], xn + (size_t)row * D, lane);
            float* rope = (float*)(ws + WS_ROPE);
            for (int e = blockIdx.x * 512 + tid; e < 16400 * 16; e += gridDim.x * 512) { const int i = e & 15, pos = (e >> 4) - 16;
                const float inv = __builtin_amdgcn_exp2f(-(float)i * 0.83048202372184058f); const float ang = (float)pos * inv;
                double rev = (double)ang * 0.15915494309189535; rev -= __builtin_rint(rev); const float r = (float)rev;
                rope[2 * e] = __builtin_amdgcn_cosf(r); rope[2 * e + 1] = __builtin_amdgcn_sinf(r); }
        } SEAM(0); }
        if (IN(1)) { { EpiSwiglu E{(bf16_t*)(ws + WS_ACT)}; run_gemm(L, (const bf16_t*)(ws + WS_U), W_GU, R1, 2 * FFN, 1024, E, wave); } SEAM(1); }
        if (IN(2)) { { EpiResid E{rm, 0.5f, 0}; run_gemm(L, (const bf16_t*)(ws + WS_ACT), W_D, R1, 1024, FFN, E, wave); } SEAM(2); }
        if (IN(3)) { { TIDS
            bf16_t* un = (bf16_t*)(ws + WS_U);
            for (int row = gw; row < R1; row += NGW) norm_row_bf16(hrow(rm, row), a.in[I_MIXN], un + (size_t)row * D, lane);
            LAS float* scr = (LAS float*)L;
            xpose_matrix(a.in[I_F2GU], 1024, 2 * FFN, W_GU, 2 * FFN, 1, scr, tid);
            xpose_matrix(a.in[I_F2D], FFN, 1024, W_D, 1024, 0, scr, tid);
            __syncthreads();
        } SEAM(3); }
        if (IN(4)) { { EpiProj E{(bf16_t*)(ws + WS_Z), (bf16_t*)(ws + WS_X), (bf16_t*)(ws + WS_MISC), (bf16_t*)(ws + WS_HALO), a.out};
                  run_gemm(L, (const bf16_t*)(ws + WS_U), W_IN, R1, 5888, 1024, E, wave); } SEAM(4); }
        if (IN(5)) { p5_phase(a, wave); SEAM(5); }
        if (IN(6)) { p6_phase(a, L, wave); SEAM(6); }
        if (IN(7)) { p7_phase(a, wave); SEAM(7); }
        if (IN(8)) { p8_phase(a, L, wave); SEAM(8); }
        if (IN(9)) { { EpiBf16 E{(bf16_t*)(ws + WS_YS), 1024, 1.0f}; run_gemm(L, (const bf16_t*)(ws + WS_Z), W_SO, R2, 1024, 2048, E, wave); } SEAM(9); }
        if (IN(10)) { {
            for (int gi = 0; gi < 3; ++gi) {
                const bf16_t* A = gi == 0 ? (const bf16_t*)(ws + WS_CQN) : (gi == 1 ? (const bf16_t*)(ws + WS_CKVB) : W_V);
                const bf16_t* B = gi == 0 ? W_UQ : (gi == 1 ? W_K : (const bf16_t*)(ws + WS_CKVB));
                const int M = gi == 0 ? R2 : (gi == 1 ? RK : 1024), N = gi == 0 ? 1536 : (gi == 1 ? 1024 : RK), K = gi == 0 ? 384 : 256;
                EpiBf16 E{gi == 0 ? (bf16_t*)(ws + WS_Q) : (gi == 1 ? (bf16_t*)(ws + WS_KN) : (bf16_t*)(ws + WS_VT)), N, gi == 0 ? QSCALE : 1.0f};
                run_gemm(L, A, B, M, N, K, E, wave);
            }
        } SEAM(10); }
        if (IN(11)) { p11_phase(a, L, wave); SEAM(11); }
        if (IN(12)) { { TIDS bf16_t* un = (bf16_t*)(ws + WS_Z); for (int row = gw; row < R2; row += NGW) norm_row_bf16(hrow(rm, row), a.in[I_MIXN], un + (size_t)row * D, lane); } SEAM(12); }
        if (IN(13)) { { EpiGate E{(bf16_t*)(ws + WS_G), a.in[I_GBIAS]}; run_gemm(L, (const bf16_t*)(ws + WS_Z), W_IN + (size_t)5888 * 1024, R2, 2048, 1024, E, wave); } SEAM(13); }
        if (IN(14)) { { EpiMerge E{(const bf16_t*)(ws + WS_G), (bf16_t*)(ws + WS_YS)}; run_gemm(L, (const bf16_t*)(ws + WS_O), W_MO, R2, 1024, 1024, E, wave); } SEAM(14); }
        if (IN(15)) { { EpiResid E{rm, 1.0f, 1}; run_gemm(L, (const bf16_t*)(ws + WS_YS), W_MIX, R2, 1024, 1024, E, wave); } SEAM(15); }
        if (IN(16)) { { TIDS bf16_t* hn = (bf16_t*)(ws + WS_Z); for (int row = gw; row < R2; row += NGW) norm_row_bf16(hrow(rm, row), a.in[I_F2N], hn + (size_t)row * D, lane); } SEAM(16); }
        if (IN(17)) { { EpiSwiglu E{(bf16_t*)(ws + WS_ACT)}; run_gemm(L, (const bf16_t*)(ws + WS_Z), W_GU, R2, 2 * FFN, 1024, E, wave); } SEAM(17); }
        if (IN(18)) { { EpiResid E{rm, 0.5f, 1}; run_gemm(L, (const bf16_t*)(ws + WS_ACT), W_D, R2, 1024, FFN, E, wave); } SEAM(18); }
        if (IN(19)) { { TIDS
            for (int row = gw; row < R2; row += NGW) { float* hp = a.out + (size_t)row * D; f32x4 v[4]; float s = 0.f;
#pragma unroll
                for (int j = 0; j < 4; ++j) { v[j] = ((const f32x4*)hp)[lane + 64 * j]; s += v[j][0] * v[j][0] + v[j][1] * v[j][1] + v[j][2] * v[j][2] + v[j][3] * v[j][3]; }
                const float rs = rsqrtf(wave_sum(s) * (1.f / 1024.f) + EPS);
#pragma unroll
                for (int j = 0; j < 4; ++j) { const f32x4 g = ((const f32x4*)a.in[I_FINN])[lane + 64 * j]; ((f32x4*)hp)[lane + 64 * j] = v[j] * rs * g; } }
        } SEAM(19); }
        }
    }
    __builtin_amdgcn_fence(__ATOMIC_RELEASE, "agent");
}

#ifndef N_LAUNCH_MODE
#define N_LAUNCH_MODE 1
#endif
extern "C" void kernel_launch(void* const* d_in, const int* in_sizes, int n_in, void* d_out, int out_size, void* d_ws, size_t ws_size, hipStream_t stream) {
    static int grid = 0;
    if (grid == 0) {
        if (n_in != 30 || ws_size < WS_END) { fprintf(stderr, "kernel_launch: unexpected n_in %d / ws_size %zu (need %zu)\n", n_in, ws_size, (size_t)WS_END); grid = -1; return; }
        int dev = 0, cus = 0, per_cu = 0;
        hipGetDevice(&dev); hipDeviceGetAttribute(&cus, hipDeviceAttributeMultiprocessorCount, dev);
        if (hipFuncSetAttribute((const void*)fwd_megakernel, hipFuncAttributeMaxDynamicSharedMemorySize, LDS_BYTES) != hipSuccess) { fprintf(stderr, "kernel_launch: hipFuncSetAttribute failed\n"); grid = -1; return; }
        if (hipOccupancyMaxActiveBlocksPerMultiprocessor(&per_cu, (const void*)fwd_megakernel, 512, LDS_BYTES) != hipSuccess || per_cu < 1) per_cu = 1;
        (void)hipGetLastError();
        grid = cus * 1;
        if (grid <= 0) grid = 256;
    }
    if (grid < 0) return;
    Args a{};
    for (int i = 0; i < 30; ++i) a.in[i] = (const float*)d_in[i];
    a.out = (float*)d_out; a.ws = (unsigned char*)d_ws;
#if N_LAUNCH_MODE == 1
    a.ph_lo = 0; a.ph_hi = NPHASE;
    if (hipMemsetAsync((unsigned char*)d_ws + WS_BAR, 0, 256, stream) != hipSuccess) { fprintf(stderr, "memset failed\n"); return; }
    void* args[] = {&a};
    hipError_t e = hipLaunchCooperativeKernel((const void*)fwd_megakernel, dim3(grid), dim3(512), args, LDS_BYTES, stream);
    if (e != hipSuccess) fprintf(stderr, "cooperative launch failed: %s (grid %d)\n", hipGetErrorString(e), grid);
#else
    for (int ph = 0; ph < NPHASE; ++ph) { a.ph_lo = ph; a.ph_hi = ph + 1; hipLaunchKernelGGL(fwd_megakernel, dim3(grid), dim3(512), LDS_BYTES, stream, a); }
#endif
}
```

```cpp
#include <hip/hip_runtime.h>
#include <hip/hip_cooperative_groups.h>
#include <cstdio>
#include <cstdint>
namespace cg = cooperative_groups;
namespace pg8 {
#define PG8_LAS __attribute__((address_space(3)))
typedef unsigned short bf16_t;
typedef short bf16x8 __attribute__((ext_vector_type(8)));
typedef float f32x4 __attribute__((ext_vector_type(4)));
typedef unsigned u32x4 __attribute__((ext_vector_type(4)));
constexpr int BM = 256, BK = 64, HALF = 128, HTB = HALF * BK * 2  , STAGE_BYTES = 8 * HTB, NXCD = 8, WGM = 8;

__host__ __device__ __forceinline__ int lds_byte(int r, int c) { const int st = (r >> 4) * 2 + (c >> 5), rr = r & 15, cc = c & 31, ob = rr * 64 + cc * 2; return st * 1024 + (ob ^ (((ob >> 9) & 1) << 5)); }
__host__ __device__ __forceinline__ void stage_rc(int b, int& R, int& C) { const int st = b / 1024, sb = b % 1024, swz = sb ^ (((sb >> 9) & 1) << 5); R = (st >> 1) * 16 + swz / 64; C = (st & 1) * 32 + (swz % 64) / 2; }
__host__ __device__ __forceinline__ int perm32(int rho) { const int n = rho >> 4, i = rho & 15; return 8 * (i >> 2) + 4 * n + (i & 3); }

struct Unit { int pm, pn; };
struct Gemm { const bf16_t* A; const bf16_t* Bt; int M, N, K; };

struct StaticOrder {
    int nM, nN, nwg, G, c;
    __host__ __device__ void init(int M, int N, int G_, int c_) { nM = M / BM; nN = N / BM; nwg = nM * nN; G = G_; c = c_; }
    __host__ __device__ bool next(int i, Unit& u) const {
        const long L = (long)i * G + c; if (L >= nwg) return false;
        int wgid = (int)L; { const int q = nwg / NXCD, r = nwg % NXCD, xcd = wgid % NXCD, off = wgid / NXCD; wgid = (xcd < r ? xcd * (q + 1) : r * (q + 1) + (xcd - r) * q) + off; }
        const int nig = WGM * nN, gid = wgid / nig, fm = gid * WGM, gsz = (nM - fm) < WGM ? (nM - fm) : WGM;
        u.pm = fm + ((wgid % nig) % gsz); u.pn = (wgid % nig) / gsz; return true;
    }
    __device__ __forceinline__ void a_ready(const Unit&) const {}
    __device__ __forceinline__ void done(const Unit&) const {}
};
template <class Epi, class Sched, bool ALIGN_EPI = false, bool SP2 = false>
__device__ __forceinline__ void gemm_phase(PG8_LAS unsigned char* lds, const Gemm g, const Sched& S, const Epi& E, const int wid) {
    const int lane = (int)(__builtin_amdgcn_mbcnt_hi(~0u, __builtin_amdgcn_mbcnt_lo(~0u, 0u)) & 63u), tid = wid * 64 + lane, wr = wid >> 2, wc = wid & 3, fr = lane & 15, fq = lane >> 4;
    const int K = g.K, nt = K / BK;
    unsigned voffA[2], voffB[2];
#pragma unroll
    for (int i = 0; i < 2; ++i) { int R, C; stage_rc(tid * 16 + i * 8192, R, C); const int Rb = Epi::PERM ? ((R & ~31) + perm32(R & 31)) : R;
        voffA[i] = (unsigned)(R * K + C) * 2u; voffB[i] = (unsigned)(Rb * K + C) * 2u; }
    const size_t kstep = (size_t)(BK * 2);
    const size_t hstep = (size_t)HALF * K * 2;
    const size_t tstep = 2 * hstep;
    const unsigned ldsw = (unsigned)wid * 1024u;
    const int aoff = lds_byte(wr * 64 + fr, fq * 8), boff = lds_byte(wc * 32 + fr, fq * 8);
#define PG8_SA(b, h) (((b) * 2 + (h)) * HTB)
#define PG8_SB(b, h) ((4 + (b) * 2 + (h)) * HTB)
#define PG8_STAGE(bufoff, gbase, voff) do { _Pragma("unroll") for (int _i = 0; _i < 2; ++_i) \
        __builtin_amdgcn_global_load_lds((const unsigned*)((const char*)(gbase) + (voff)[_i]), (PG8_LAS unsigned*)(lds + (bufoff) + ldsw + _i * 8192), 16, 0, 0); } while (0)
#define PG8_LDA(dst, b, h) do { _Pragma("unroll") for (int m = 0; m < 4; ++m) _Pragma("unroll") for (int k = 0; k < 2; ++k) dst[m][k] = *(const PG8_LAS bf16x8*)(lds + PG8_SA(b, h) + aoff + m * 2048 + k * 1024); } while (0)
#define PG8_LDB(dst, b, h) do { _Pragma("unroll") for (int n = 0; n < 2; ++n) _Pragma("unroll") for (int k = 0; k < 2; ++k) dst[n][k] = *(const PG8_LAS bf16x8*)(lds + PG8_SB(b, h) + boff + n * 2048 + k * 1024); } while (0)
#define PG8_MMA(ai, bj, At, Bt) do { __builtin_amdgcn_s_setprio(1); _Pragma("unroll") for (int m = 0; m < 4; ++m) _Pragma("unroll") for (int n = 0; n < 2; ++n) _Pragma("unroll") for (int k = 0; k < 2; ++k) \
        acc[ai][bj][m][n] = __builtin_amdgcn_mfma_f32_16x16x32_bf16(Bt[n][k], At[m][k], acc[ai][bj][m][n], 0, 0, 0); __builtin_amdgcn_s_setprio(0); } while (0)
#define PG8_WAIT_V(n) asm volatile("s_waitcnt vmcnt(" #n ")" ::: "memory")
#define PG8_WAIT_L(n) asm volatile("s_waitcnt lgkmcnt(" #n ")" ::: "memory")
#define PG8_BAR __builtin_amdgcn_s_barrier()
#define PG8_SCHED __builtin_amdgcn_sched_barrier(0)
    Unit cur, nxt; int ui = 0;
    if (!S.next(0, cur)) return;
    f32x4 acc[2][2][4][2];
#pragma unroll
    for (int a = 0; a < 2; ++a)
#pragma unroll
        for (int b = 0; b < 2; ++b)
#pragma unroll
            for (int m = 0; m < 4; ++m)
#pragma unroll
                for (int n = 0; n < 2; ++n) acc[a][b][m][n] = (f32x4){0.f, 0.f, 0.f, 0.f};
    bf16x8 At[4][2], B0[2][2], B1[2][2];
    const char* cA = (const char*)g.A + (size_t)cur.pm * tstep; const char* cB = (const char*)g.Bt + (size_t)cur.pn * tstep;
    S.a_ready(cur);
    if constexpr (SP2) {
        PG8_STAGE(PG8_SB(0, 0), cB, voffB); PG8_STAGE(PG8_SB(0, 1), cB + hstep, voffB); PG8_STAGE(PG8_SA(0, 0), cA, voffA); PG8_STAGE(PG8_SA(0, 1), cA + hstep, voffA);
        if (wr == 1) PG8_BAR;
        PG8_WAIT_V(2); PG8_BAR;
        PG8_STAGE(PG8_SB(1, 0), cB + kstep, voffB); PG8_STAGE(PG8_SA(1, 0), cA + kstep, voffA); PG8_STAGE(PG8_SB(1, 1), cB + hstep + kstep, voffB);
        PG8_WAIT_V(6); PG8_BAR;
    } else {
        PG8_STAGE(PG8_SB(0, 0), cB, voffB); PG8_STAGE(PG8_SA(0, 0), cA, voffA); PG8_STAGE(PG8_SB(0, 1), cB + hstep, voffB); PG8_STAGE(PG8_SA(0, 1), cA + hstep, voffA);
        if (wr == 1) PG8_BAR;
        PG8_WAIT_V(4); PG8_BAR;
        PG8_STAGE(PG8_SB(1, 0), cB + kstep, voffB); PG8_STAGE(PG8_SA(1, 0), cA + kstep, voffA); PG8_STAGE(PG8_SB(1, 1), cB + hstep + kstep, voffB);
        PG8_WAIT_V(6); PG8_BAR;
    }
    for (;;) {
        const bool has_next = S.next(ui + 1, nxt);
        const char* nA = has_next ? (const char*)g.A + (size_t)nxt.pm * tstep : cA; const char* nB = has_next ? (const char*)g.Bt + (size_t)nxt.pn * tstep : cB;
        for (int t = 0; t < nt; t += 2) {
            const bool last = (t == nt - 2);
            const char* a1 = cA + (size_t)(t + 1) * kstep;
            const char* a2 = last ? nA : cA + (size_t)(t + 2) * kstep; const char* b2 = last ? nB : cB + (size_t)(t + 2) * kstep;
            const char* a3 = a2 + kstep; const char* b3 = b2 + kstep;
            if (last && has_next) S.a_ready(nxt);
            if constexpr (SP2) {
            PG8_LDB(B0, 0, 0); PG8_LDB(B1, 0, 1); PG8_SCHED; PG8_LDA(At, 0, 0); PG8_STAGE(PG8_SA(1, 1), a1 + hstep, voffA);
            PG8_WAIT_V(8); PG8_WAIT_L(0); PG8_BAR; PG8_MMA(0, 0, At, B0); PG8_MMA(0, 1, At, B1); PG8_BAR; PG8_SCHED;
            PG8_LDA(At, 0, 1); PG8_STAGE(PG8_SB(0, 0), b2, voffB); PG8_STAGE(PG8_SB(0, 1), b2 + hstep, voffB); PG8_STAGE(PG8_SA(0, 0), a2, voffA);
            PG8_WAIT_V(8); PG8_WAIT_L(0); PG8_BAR; PG8_MMA(1, 0, At, B0); PG8_MMA(1, 1, At, B1); PG8_BAR; PG8_SCHED;
            PG8_LDB(B0, 1, 0); PG8_LDB(B1, 1, 1); PG8_SCHED; PG8_LDA(At, 1, 0); PG8_STAGE(PG8_SA(0, 1), a2 + hstep, voffA);
            PG8_WAIT_V(8); PG8_WAIT_L(0); PG8_BAR; PG8_MMA(0, 0, At, B0); PG8_MMA(0, 1, At, B1); PG8_BAR; PG8_SCHED;
            PG8_LDA(At, 1, 1); PG8_STAGE(PG8_SB(1, 0), b3, voffB); PG8_STAGE(PG8_SB(1, 1), b3 + hstep, voffB); PG8_STAGE(PG8_SA(1, 0), a3, voffA);
            PG8_WAIT_V(8); PG8_WAIT_L(0); PG8_BAR; PG8_MMA(1, 0, At, B0); PG8_MMA(1, 1, At, B1); PG8_BAR; PG8_SCHED;
            } else {
            PG8_LDB(B0, 0, 0); PG8_SCHED; PG8_LDA(At, 0, 0); PG8_STAGE(PG8_SA(1, 1), a1 + hstep, voffA);
            PG8_WAIT_L(8); PG8_BAR; PG8_WAIT_L(0); PG8_MMA(0, 0, At, B0); PG8_BAR; PG8_SCHED;
            PG8_LDB(B1, 0, 1); PG8_STAGE(PG8_SB(0, 0), b2, voffB);
            PG8_BAR; PG8_WAIT_L(0); PG8_MMA(0, 1, At, B1); PG8_BAR;
            PG8_LDA(At, 0, 1); PG8_STAGE(PG8_SA(0, 0), a2, voffA);
            PG8_BAR; PG8_WAIT_L(0); PG8_MMA(1, 0, At, B0); PG8_BAR; PG8_SCHED;
            PG8_STAGE(PG8_SB(0, 1), b2 + hstep, voffB);
            PG8_WAIT_V(6); PG8_BAR; PG8_MMA(1, 1, At, B1); PG8_BAR;
            PG8_LDB(B0, 1, 0); PG8_SCHED; PG8_LDA(At, 1, 0); PG8_STAGE(PG8_SA(0, 1), a2 + hstep, voffA);
            PG8_WAIT_L(8); PG8_BAR; PG8_WAIT_L(0); PG8_MMA(0, 0, At, B0); PG8_BAR; PG8_SCHED;
            PG8_LDB(B1, 1, 1); PG8_STAGE(PG8_SB(1, 0), b3, voffB);
            PG8_BAR; PG8_WAIT_L(0); PG8_MMA(0, 1, At, B1); PG8_BAR;
            PG8_LDA(At, 1, 1); PG8_STAGE(PG8_SA(1, 0), a3, voffA);
            PG8_BAR; PG8_WAIT_L(0); PG8_MMA(1, 0, At, B0); PG8_BAR; PG8_SCHED;
            PG8_STAGE(PG8_SB(1, 1), b3 + hstep, voffB);
            PG8_WAIT_V(6); PG8_BAR; PG8_MMA(1, 1, At, B1); PG8_BAR;
            }
        }
        if constexpr (ALIGN_EPI) { if (wr == 0) PG8_BAR; }
        if constexpr (!Epi::AFTER_DRAIN) { E(acc, cur, wr, wc, fr, fq); S.done(cur); }
        if (!has_next) break;
#pragma unroll
        for (int a = 0; a < 2; ++a)
#pragma unroll
            for (int b = 0; b < 2; ++b)
#pragma unroll
                for (int m = 0; m < 4; ++m)
#pragma unroll
                    for (int n = 0; n < 2; ++n) acc[a][b][m][n] = (f32x4){0.f, 0.f, 0.f, 0.f};
        cur = nxt; cA = nA; cB = nB; ++ui;
        if constexpr (ALIGN_EPI) { if (wr == 1) PG8_BAR; }
    }
    PG8_WAIT_V(0);
    if constexpr (!ALIGN_EPI) { if (wr == 0) PG8_BAR; }
    PG8_BAR;
    if constexpr (Epi::AFTER_DRAIN) { E.fused(acc, cur, wr, wc, fr, fq, lds, wid, lane); S.done(cur); }
#undef PG8_SA
#undef PG8_SB
#undef PG8_STAGE
#undef PG8_LDA
#undef PG8_LDB
#undef PG8_MMA
#undef PG8_WAIT_V
#undef PG8_WAIT_L
#undef PG8_BAR
#undef PG8_SCHED
}
}
using namespace pg8;
#define LAS __attribute__((address_space(3)))
typedef short v4i16_t __attribute__((ext_vector_type(4)));
typedef unsigned u32x2 __attribute__((ext_vector_type(2)));
typedef float f32x2 __attribute__((ext_vector_type(2)));

constexpr int D = 1024, FFN = 2816;
constexpr int R_S0 = 32768;
constexpr int R_M0 = 33280;
constexpr int R_ACT = 33296;
constexpr int R1 = 33536;
constexpr int R2 = 33280;
constexpr int RK = 49920;
constexpr int R_C0 = 33536;
constexpr int NCHUNK = 146;
constexpr float EPS = 1e-6f;
constexpr float QSCALE = 0.14724448f;

constexpr size_t MiB = 1048576;
constexpr size_t WS_W_IN = 0, WS_W_GU = 16252928, WS_W_D = 27787264, WS_W_SO = 33554432, WS_W_UQ = 37748736, WS_W_K = 38928384, WS_W_V = 39452672,
                 WS_W_MO = 39976960, WS_W_MIX = 42074112, WS_ROPE = 44171264, WS_HMETA = 46270464, WS_KRB = 47319040, WS_TOT = 50513920, WS_BAR = 50540544;
constexpr size_t WS_Z = 49 * MiB, WS_X = 180 * MiB, WS_U = 376 * MiB + MiB / 2, WS_MISC = 442 * MiB, WS_HALO = WS_MISC + (size_t)R1 * 768 * 2;
constexpr size_t WS_DT = WS_U, WS_ACS = WS_U + 4292608, WS_CQN = WS_U + 8585216, WS_CKVB = WS_U + 34144256, WS_S = WS_U + 57 * MiB;
constexpr size_t WS_YS = 447 * MiB, WS_Q = WS_Z, WS_KN = WS_X, WS_VT = WS_X + 102236160, WS_O = WS_U, WS_G = WS_X, WS_ACT = WS_X;
constexpr size_t WS_END = 512 * MiB;
static_assert(WS_S + (size_t)NCHUNK * 32 * 8192 * 2 <= WS_END && WS_O + (size_t)R2 * 1024 * 2 <= WS_YS && WS_YS + (size_t)R2 * 1024 * 2 <= WS_END, "ws map 4");
static_assert(WS_END <= 512 * MiB, "ws map");
static_assert(WS_CKVB + (size_t)RK * 256 * 2 <= WS_S, "ws map 2");
static_assert(WS_HALO + 514 * 3 * 3072 * 2 <= 512 * MiB, "ws map 3");

constexpr size_t OUT_YP = 0, OUT_YS = 33554432, OUT_CKVP = 34078720, OUT_KRP = 42475520, OUT_SSMP = 43525120, OUT_CONVP = 44049408,
                 OUT_CKVS = 44067840, OUT_KRS = 44198912, OUT_SSMS = 44215296, OUT_CONVS = 48409600;

enum { I_XP = 0, I_XS, I_CCKV, I_CKR, I_SSSM, I_SCONV, I_META, I_F1N, I_F1GU, I_F1D, I_MIXN, I_WIN, I_GBIAS, I_CONVW, I_CONVB, I_DTB, I_ALOG, I_SSMD,
       I_SSMN, I_WSO, I_QN, I_WUQ, I_KVN, I_WUKV, I_WMO, I_WMIX, I_F2N, I_F2GU, I_F2D, I_FINN };

struct Args { const float* in[30]; float* out; unsigned char* ws; int ph_lo, ph_hi; };

__device__ __forceinline__ unsigned f2bf(float f) { unsigned u = __builtin_bit_cast(unsigned, f); return (u + 0x7fffu + ((u >> 16) & 1u)) >> 16; }
typedef float f32x2_t __attribute__((ext_vector_type(2))); typedef __bf16 bf16x2_t __attribute__((ext_vector_type(2)));
__device__ __forceinline__ unsigned cvtpk(float lo, float hi) { f32x2_t v = {lo, hi}; bf16x2_t b = __builtin_convertvector(v, bf16x2_t); return __builtin_bit_cast(unsigned, b); }
__device__ __forceinline__ float bflo(unsigned u) { return __builtin_bit_cast(float, u << 16); }
__device__ __forceinline__ float bfhi(unsigned u) { return __builtin_bit_cast(float, u & 0xffff0000u); }
__device__ __forceinline__ float bf2f(bf16_t b) { return __builtin_bit_cast(float, (unsigned)b << 16); }
__device__ __forceinline__ float wave_sum(float v) {
#pragma unroll
    for (int o = 1; o < 64; o <<= 1) v += __shfl_xor(v, o);
    return v;
}
__device__ __forceinline__ float silu_f(float x) { return x * __builtin_amdgcn_rcpf(1.f + __expf(-x)); }
__device__ __forceinline__ float sigmoid_f(float x) { return __builtin_amdgcn_rcpf(1.f + __expf(-x)); }
__device__ __forceinline__ float softplus_f(float x) {
    const float e = __expf(x);
    const float sp = e < 0.02f ? e * (1.f - e * (0.5f - e * (0.33333334f - 0.25f * e))) : __logf(1.f + e);
    return x > 15.f ? x : sp;
}
__device__ __forceinline__ int pos_idx(int row) {
    if (row < R_S0) return (row & 16383) + 16;
    if (row < R_M0) return 1024 + ((row - R_S0) & 31) + 16;
    return row - R_M0;
}
__device__ __forceinline__ void chunk_info(int ci, int& row0, int& ntok) {
    if (ci < 130) { const int b = ci / 65, k = ci - b * 65; if (k == 0) { row0 = R_M0; ntok = 16; } else { row0 = b * 16384 + 256 * (k - 1); ntok = 256; } }
    else { row0 = R_S0 + 32 * (ci - 130); ntok = 32; }
}
__device__ __forceinline__ v4i16_t ldtr(const LAS bf16_t* p) { return __builtin_amdgcn_ds_read_tr16_b64_v4i16((LAS v4i16_t*)p); }
__device__ __forceinline__ bf16x8 cat8(v4i16_t a, v4i16_t b) { return __builtin_shufflevector(a, b, 0, 1, 2, 3, 4, 5, 6, 7); }
__device__ __forceinline__ bf16x8 cat8u(u32x2 a, u32x2 b) { u32x4 t = {a.x, a.y, b.x, b.y}; return __builtin_bit_cast(bf16x8, t); }
#define MFMA16(a, b, c) __builtin_amdgcn_mfma_f32_16x16x32_bf16((a), (b), (c), 0, 0, 0)

struct EpiSwiglu {
    static constexpr bool PERM = true, AFTER_DRAIN = false; bf16_t* O;
    __device__ __forceinline__ void operator()(const f32x4 (&acc)[2][2][4][2], const Unit& u, int wr, int wc, int fr, int fq) const {
        const int row0 = u.pm * 256 + wr * 64 + fr, col0 = u.pn * 128 + wc * 32 + 8 * fq;
#pragma unroll
        for (int ai = 0; ai < 2; ++ai)
#pragma unroll
            for (int m = 0; m < 4; ++m) {
                const f32x4 g0 = acc[ai][0][m][0], g1 = acc[ai][0][m][1], u0 = acc[ai][1][m][0], u1 = acc[ai][1][m][1];
                u32x4 w; w.x = cvtpk(silu_f(g0[0]) * u0[0], silu_f(g0[1]) * u0[1]); w.y = cvtpk(silu_f(g0[2]) * u0[2], silu_f(g0[3]) * u0[3]);
                w.z = cvtpk(silu_f(g1[0]) * u1[0], silu_f(g1[1]) * u1[1]); w.w = cvtpk(silu_f(g1[2]) * u1[2], silu_f(g1[3]) * u1[3]);
                *(u32x4*)(O + (size_t)(row0 + ai * 128 + m * 16) * FFN + col0) = w;
            }
    }
};
struct RowMap { float* out; float* hmeta; const float* xp; const float* xs; const float* meta; };
__device__ __forceinline__ float* hrow(const RowMap& a, int row) { return row < R2 ? a.out + (size_t)row * D : a.hmeta + (size_t)(row - R2) * D; }
__device__ __forceinline__ const float* xrow(const RowMap& a, int row) {
    if (row < R_S0) return a.xp + (size_t)row * D;
    if (row < R_M0) return a.xs + (size_t)(row - R_S0) * D;
    if (row < R_ACT) return a.meta + (size_t)(row - R_M0) * D;
    return nullptr;
}
struct EpiResid {
    static constexpr bool PERM = true, AFTER_DRAIN = false; RowMap a; float s; int mode;
    __device__ __forceinline__ void operator()(const f32x4 (&acc)[2][2][4][2], const Unit& u, int wr, int wc, int fr, int fq) const {
        const int row0 = u.pm * 256 + wr * 64 + fr, col0 = u.pn * 256 + wc * 32 + 8 * fq;
#pragma unroll
        for (int ai = 0; ai < 2; ++ai)
#pragma unroll
            for (int m = 0; m < 4; ++m) {
                const int row = row0 + ai * 128 + m * 16; float* hp = hrow(a, row); const float* bp = mode ? hp : xrow(a, row);
#pragma unroll
                for (int bj = 0; bj < 2; ++bj) {
                    const int c = col0 + bj * 128; f32x4 b0 = {0.f, 0.f, 0.f, 0.f}, b1 = b0;
                    if (bp) { b0 = *(const f32x4*)(bp + c); b1 = *(const f32x4*)(bp + c + 4); }
                    *(f32x4*)(hp + c) = b0 + acc[ai][bj][m][0] * s; *(f32x4*)(hp + c + 4) = b1 + acc[ai][bj][m][1] * s;
                }
            }
    }
};
struct EpiProj {
    static constexpr bool PERM = true, AFTER_DRAIN = false; bf16_t *Z, *X, *MISC, *HALO; float* out;
    __device__ __forceinline__ void operator()(const f32x4 (&acc)[2][2][4][2], const Unit& u, int wr, int wc, int fr, int fq) const {
        const int row0 = u.pm * 256 + wr * 64 + fr; const int pn = u.pn;
#pragma unroll
        for (int ai = 0; ai < 2; ++ai)
#pragma unroll
            for (int m = 0; m < 4; ++m) {
                const int row = row0 + ai * 128 + m * 16;
#pragma unroll
                for (int bj = 0; bj < 2; ++bj) {
                    const f32x4 v0 = acc[ai][bj][m][0], v1 = acc[ai][bj][m][1];
                    u32x4 w; w.x = cvtpk(v0[0], v0[1]); w.y = cvtpk(v0[2], v0[3]); w.z = cvtpk(v1[0], v1[1]); w.w = cvtpk(v1[2], v1[3]);
                    const int ct = bj * 128 + wc * 32 + 8 * fq;
                    if (pn < 8) { *(u32x4*)(Z + (size_t)row * 2048 + pn * 256 + ct) = w; }
                    else if (pn < 20) {
                        const int cx = (pn - 8) * 256 + ct;
                        *(u32x4*)(X + (size_t)row * 3072 + cx) = w;
                        if (row < R_S0) {
                            const int r6 = row & 63;
                            if (r6 >= 61) { const int T = (row >> 6) + 1; if (T & 255) *(u32x4*)(HALO + ((size_t)T * 3 + (r6 - 61)) * 3072 + cx) = w; }
                            const int t = row & 16383;
                            if (t >= 16381) { float* o = out + OUT_CONVP + ((size_t)(row >> 14) * 3 + (t - 16381)) * 3072 + cx; *(f32x4*)o = v0; *(f32x4*)(o + 4) = v1; }
                        } else if (row < R_M0) {
                            const int t = (row - R_S0) & 31, db = (row - R_S0) >> 5;
                            if (t >= 29) { float* o = out + OUT_CONVS + ((size_t)db * 3 + (t - 29)) * 3072 + cx; *(f32x4*)o = v0; *(f32x4*)(o + 4) = v1; }
                        } else if (row >= R_M0 + 13 && row < R_ACT) {
                            const int sl = row - R_M0 - 13;
                            *(u32x4*)(HALO + ((size_t)0 * 3 + sl) * 3072 + cx) = w; *(u32x4*)(HALO + ((size_t)256 * 3 + sl) * 3072 + cx) = w;
                        }
                    } else { *(u32x4*)(MISC + (size_t)row * 768 + (pn - 20) * 256 + ct) = w; }
                }
            }
    }
};
struct EpiBf16 {
    static constexpr bool PERM = true, AFTER_DRAIN = false; bf16_t* O; int ldc; float sc;
    __device__ __forceinline__ void operator()(const f32x4 (&acc)[2][2][4][2], const Unit& u, int wr, int wc, int fr, int fq) const {
        const int row0 = u.pm * 256 + wr * 64 + fr, col0 = u.pn * 256 + wc * 32 + 8 * fq;
#pragma unroll
        for (int ai = 0; ai < 2; ++ai)
#pragma unroll
            for (int m = 0; m < 4; ++m)
#pragma unroll
                for (int bj = 0; bj < 2; ++bj) {
                    const f32x4 v0 = acc[ai][bj][m][0] * sc, v1 = acc[ai][bj][m][1] * sc;
                    u32x4 w; w.x = cvtpk(v0[0], v0[1]); w.y = cvtpk(v0[2], v0[3]); w.z = cvtpk(v1[0], v1[1]); w.w = cvtpk(v1[2], v1[3]);
                    *(u32x4*)(O + (size_t)(row0 + ai * 128 + m * 16) * ldc + col0 + bj * 128) = w;
                }
    }
};
struct EpiGate {
    static constexpr bool PERM = true, AFTER_DRAIN = false; bf16_t* G; const float* bias;
    __device__ __forceinline__ void operator()(const f32x4 (&acc)[2][2][4][2], const Unit& u, int wr, int wc, int fr, int fq) const {
        const int row0 = u.pm * 256 + wr * 64 + fr, col0 = u.pn * 256 + wc * 32 + 8 * fq;
#pragma unroll
        for (int bj = 0; bj < 2; ++bj) {
            const int c = col0 + bj * 128; const f32x4 b0 = *(const f32x4*)(bias + c), b1 = *(const f32x4*)(bias + c + 4);
#pragma unroll
            for (int ai = 0; ai < 2; ++ai)
#pragma unroll
                for (int m = 0; m < 4; ++m) {
                    const f32x4 v0 = acc[ai][bj][m][0] + b0, v1 = acc[ai][bj][m][1] + b1;
                    u32x4 w; w.x = cvtpk(sigmoid_f(v0[0]), sigmoid_f(v0[1])); w.y = cvtpk(sigmoid_f(v0[2]), sigmoid_f(v0[3]));
                    w.z = cvtpk(sigmoid_f(v1[0]), sigmoid_f(v1[1])); w.w = cvtpk(sigmoid_f(v1[2]), sigmoid_f(v1[3]));
                    *(u32x4*)(G + (size_t)(row0 + ai * 128 + m * 16) * 2048 + c) = w;
                }
        }
    }
};
struct EpiMerge {
    static constexpr bool PERM = true, AFTER_DRAIN = false; const bf16_t* G; bf16_t* YS;
    __device__ __forceinline__ void operator()(const f32x4 (&acc)[2][2][4][2], const Unit& u, int wr, int wc, int fr, int fq) const {
        const int row0 = u.pm * 256 + wr * 64 + fr, col0 = u.pn * 256 + wc * 32 + 8 * fq;
#pragma unroll
        for (int ai = 0; ai < 2; ++ai)
#pragma unroll
            for (int m = 0; m < 4; ++m)
#pragma unroll
                for (int bj = 0; bj < 2; ++bj) {
                    const int row = row0 + ai * 128 + m * 16, c = col0 + bj * 128;
                    const u32x4 gs = *(const u32x4*)(G + (size_t)row * 2048 + c), gm = *(const u32x4*)(G + (size_t)row * 2048 + 1024 + c), ys = *(const u32x4*)(YS + (size_t)row * 1024 + c);
                    const f32x4 v0 = acc[ai][bj][m][0], v1 = acc[ai][bj][m][1];
                    u32x4 w;
                    w.x = cvtpk(bflo(gs.x) * bflo(ys.x) + bflo(gm.x) * v0[0], bfhi(gs.x) * bfhi(ys.x) + bfhi(gm.x) * v0[1]);
                    w.y = cvtpk(bflo(gs.y) * bflo(ys.y) + bflo(gm.y) * v0[2], bfhi(gs.y) * bfhi(ys.y) + bfhi(gm.y) * v0[3]);
                    w.z = cvtpk(bflo(gs.z) * bflo(ys.z) + bflo(gm.z) * v1[0], bfhi(gs.z) * bfhi(ys.z) + bfhi(gm.z) * v1[1]);
                    w.w = cvtpk(bflo(gs.w) * bflo(ys.w) + bflo(gm.w) * v1[2], bfhi(gs.w) * bfhi(ys.w) + bfhi(gm.w) * v1[3]);
                    *(u32x4*)(YS + (size_t)row * 1024 + c) = w;
                }
    }
};
__device__ __forceinline__ int lane_id() { return (int)(__builtin_amdgcn_mbcnt_hi(~0u, __builtin_amdgcn_mbcnt_lo(~0u, 0u)) & 63u); }
template <class Epi> __device__ __forceinline__ void run_gemm(LAS unsigned char* lds, const bf16_t* A, const bf16_t* Bt, int M, int N, int K, const Epi& E, int wave) {
    Gemm g{A, Bt, M, N, K}; StaticOrder S; S.init(M, N, (int)gridDim.x, (int)blockIdx.x);
    gemm_phase<Epi, StaticOrder, false, true>(lds, g, S, E, wave);
    __syncthreads();
}

struct ElResid { RowMap a; float s; int mode; __device__ __forceinline__ void operator()(int row, int col, float v) const {
    float* hp = hrow(a, row) + col; float b = 0.f; if (mode) b = *hp; else { const float* xp = xrow(a, row); if (xp) b = xp[col]; } *hp = b + s * v; } };
struct ElBf16 { bf16_t* O; int ldc; __device__ __forceinline__ void operator()(int row, int col, float v) const { O[(size_t)row * ldc + col] = (bf16_t)(cvtpk(v, 0.f) & 0xffffu); } };
struct ElMerge { const bf16_t* G; bf16_t* YS; __device__ __forceinline__ void operator()(int row, int col, float v) const {
    const float gs = bf2f(G[(size_t)row * 2048 + col]), gm = bf2f(G[(size_t)row * 2048 + 1024 + col]); bf16_t* p = YS + (size_t)row * 1024 + col; *p = (bf16_t)(cvtpk(gs * bf2f(*p) + gm * v, 0.f) & 0xffffu); } };
template <class El> __device__ __forceinline__ void tail_gemm(const bf16_t* A, const bf16_t* Bt, int K, int row_begin, int row_end, const El& E, int wave) {
    const int lane = lane_id(), li = lane & 15, quad = lane >> 4; const int gw = blockIdx.x * 8 + wave, NGW = gridDim.x * 8;
    const int total = ((row_end - row_begin) >> 4) * 64;
    for (int blk = gw; blk < total; blk += NGW) {
        const int rb = blk >> 6, cb = blk & 63;
        const bf16_t* ap = A + (size_t)(row_begin + 16 * rb + li) * K + 8 * quad; const bf16_t* bp = Bt + (size_t)(16 * cb + li) * K + 8 * quad;
        f32x4 acc = {0.f, 0.f, 0.f, 0.f};
        for (int k = 0; k < K; k += 256) { bf16x8 af[8], bf[8];
#pragma unroll
            for (int e = 0; e < 8; ++e) { af[e] = *(const bf16x8*)(ap + k + 32 * e); bf[e] = *(const bf16x8*)(bp + k + 32 * e); }
#pragma unroll
            for (int e = 0; e < 8; ++e) acc = MFMA16(af[e], bf[e], acc); }
#pragma unroll
        for (int j = 0; j < 4; ++j) E(row_begin + 16 * rb + 4 * quad + j, 16 * cb + li, acc[j]);
    }
}

__device__ __forceinline__ int srccol(int mapid, int n) {
    switch (mapid) {
        case 0: return n;
        case 1: { const int pn = n >> 8, bj = (n >> 7) & 1, i = n & 127; return (bj ? FFN : 0) + pn * 128 + i; }
        case 2: return n < 5824 ? n : (n < 5888 ? -1 : n - 64);
        case 3: return n < 1024 ? (n >> 6) * 96 + (n & 63) : ((n - 1024) >> 5) * 96 + 64 + ((n - 1024) & 31);
        case 4: return (n >> 6) * 128 + (n & 63);
        default: return (n >> 6) * 128 + 64 + (n & 63);
    }
}
__device__ __forceinline__ void xpose_matrix(const float* __restrict__ src, int K, int Nsrc, bf16_t* dst, int Ndst, int mapid, LAS float* scr, int tid) {
    const int nblk = Ndst >> 6, nitems = (K >> 6) * nblk;
    for (int item = blockIdx.x; item < nitems; item += gridDim.x) {
        const int kb = item / nblk, nb = item - kb * nblk, k0 = kb * 64, n0 = nb * 64;
        __syncthreads();
#pragma unroll
        for (int i = 0; i < 8; ++i) { const int idx = tid + 512 * i, kk = idx >> 6, nn = idx & 63; const int sc = srccol(mapid, n0 + nn);
            scr[nn * 65 + kk] = sc >= 0 ? src[(size_t)(k0 + kk) * Nsrc + sc] : 0.f; }
        __syncthreads();
        { const int nn = tid >> 3, c = tid & 7; const LAS float* s = scr + nn * 65 + 8 * c;
          u32x4 o; o.x = cvtpk(s[0], s[1]); o.y = cvtpk(s[2], s[3]); o.z = cvtpk(s[4], s[5]); o.w = cvtpk(s[6], s[7]);
          *(u32x4*)(dst + (size_t)(n0 + nn) * K + k0 + 8 * c) = o; }
    }
}
__device__ __forceinline__ void norm_row_bf16(const float* src, const float* gain, bf16_t* dst, int lane) {
    f32x4 v[4]; float s = 0.f;
#pragma unroll
    for (int j = 0; j < 4; ++j) { v[j] = src ? ((const f32x4*)src)[lane + 64 * j] : (f32x4){0.f, 0.f, 0.f, 0.f}; s += v[j][0] * v[j][0] + v[j][1] * v[j][1] + v[j][2] * v[j][2] + v[j][3] * v[j][3]; }
    const float rs = rsqrtf(wave_sum(s) * (1.f / 1024.f) + EPS);
#pragma unroll
    for (int j = 0; j < 4; ++j) { const f32x4 g = ((const f32x4*)gain)[lane + 64 * j];
        u32x2 o = {cvtpk(v[j][0] * rs * g[0], v[j][1] * rs * g[1]), cvtpk(v[j][2] * rs * g[2], v[j][3] * rs * g[3])}; ((u32x2*)dst)[lane + 64 * j] = o; }
}

__device__ __forceinline__ void norm_row2_bf16(const float* s0, const float* s1, const float* gain, bf16_t* d0, bf16_t* d1, int lane) {
    f32x4 v[4], w[4]; float a = 0.f, b = 0.f;
#pragma unroll
    for (int j = 0; j < 4; ++j) { v[j] = s0 ? ((const f32x4*)s0)[lane + 64 * j] : (f32x4){0.f, 0.f, 0.f, 0.f}; w[j] = s1 ? ((const f32x4*)s1)[lane + 64 * j] : (f32x4){0.f, 0.f, 0.f, 0.f}; }
#pragma unroll
    for (int j = 0; j < 4; ++j) { a += v[j][0] * v[j][0] + v[j][1] * v[j][1] + v[j][2] * v[j][2] + v[j][3] * v[j][3]; b += w[j][0] * w[j][0] + w[j][1] * w[j][1] + w[j][2] * w[j][2] + w[j][3] * w[j][3]; }
    const float ra = rsqrtf(wave_sum(a) * (1.f / 1024.f) + EPS), rb = rsqrtf(wave_sum(b) * (1.f / 1024.f) + EPS);
#pragma unroll
    for (int j = 0; j < 4; ++j) { const f32x4 g = ((const f32x4*)gain)[lane + 64 * j];
        u32x2 o = {cvtpk(v[j][0] * ra * g[0], v[j][1] * ra * g[1]), cvtpk(v[j][2] * ra * g[2], v[j][3] * ra * g[3])}; ((u32x2*)d0)[lane + 64 * j] = o;
        u32x2 p = {cvtpk(w[j][0] * rb * g[0], w[j][1] * rb * g[1]), cvtpk(w[j][2] * rb * g[2], w[j][3] * rb * g[3])}; ((u32x2*)d1)[lane + 64 * j] = p; }
}

__device__ __forceinline__ void p5_phase(const Args& a, const int wave) {
    const int lane = lane_id(); int tid = wave * 64 + lane; asm volatile("" : "+v"(tid)); tid &= 511; const int gw = blockIdx.x * 8 + wave, NGW = gridDim.x * 8;
    unsigned char* ws = a.ws;
    const bf16_t* misc = (const bf16_t*)(ws + WS_MISC); float* dt = (float*)(ws + WS_DT); float* acs = (float*)(ws + WS_ACS); float* tot = (float*)(ws + WS_TOT);
    bf16_t* cqn = (bf16_t*)(ws + WS_CQN); bf16_t* ckvb = (bf16_t*)(ws + WS_CKVB); bf16_t* krb = (bf16_t*)(ws + WS_KRB); bf16_t* xc = (bf16_t*)(ws + WS_X);
    const bf16_t* halo = (const bf16_t*)(ws + WS_HALO); const float* rope = (const float*)(ws + WS_ROPE);
    for (int item = gw; item < NCHUNK * 32; item += NGW) {
        const int ci = item >> 5, h = item & 31; int row0, ntok; chunk_info(ci, row0, ntok);
        const int per = ntok > 64 ? 4 : 1;
        const float A = -__expf(a.in[I_ALOG][h]), bias = a.in[I_DTB][h]; float v[4], run = 0.f;
#pragma unroll
        for (int k = 0; k < 4; ++k) { const int t = lane * per + k; float x = 0.f;
            if (k < per && t < ntok) x = softplus_f(bf2f(misc[(size_t)(row0 + t) * 768 + h]) + bias) * A;
            run += x; v[k] = run; }
        float incl = run;
#pragma unroll
        for (int o = 1; o < 64; o <<= 1) { const float y = __shfl_up(incl, o); if (lane >= o) incl += y; }
        const float excl = incl - run;
#pragma unroll
        for (int k = 0; k < 4; ++k) { const int t = lane * per + k; if (k < per && t < ntok) acs[(size_t)(row0 + t) * 32 + h] = excl + v[k]; }
        if (lane == 63) tot[ci * 32 + h] = incl;
    }
    for (int row = gw; row < R_ACT; row += NGW) {
        const bf16_t* mr = misc + (size_t)row * 768;
        if (lane < 32) dt[(size_t)row * 32 + lane] = softplus_f(bf2f(mr[lane]) + a.in[I_DTB][lane]);
        { const unsigned* cp = (const unsigned*)(mr + 32) + 3 * lane; const unsigned c0 = cp[0], c1 = cp[1], c2 = cp[2];
          float q[6] = {bflo(c0), bfhi(c0), bflo(c1), bfhi(c1), bflo(c2), bfhi(c2)}; float ss = 0.f;
#pragma unroll
          for (int e = 0; e < 6; ++e) ss += q[e] * q[e];
          const float rs = rsqrtf(wave_sum(ss) * (1.f / 384.f) + EPS);
          if (row < R2) { const float* gq = a.in[I_QN] + 6 * lane; unsigned* op = (unsigned*)(cqn + (size_t)row * 384) + 3 * lane;
              op[0] = cvtpk(q[0] * rs * gq[0], q[1] * rs * gq[1]); op[1] = cvtpk(q[2] * rs * gq[2], q[3] * rs * gq[3]); op[2] = cvtpk(q[4] * rs * gq[4], q[5] * rs * gq[5]); } }
        { const u32x2 kv = *(const u32x2*)(mr + 416 + 4 * lane); float v[4] = {bflo(kv.x), bfhi(kv.x), bflo(kv.y), bfhi(kv.y)};
          const float rs = rsqrtf(wave_sum(v[0] * v[0] + v[1] * v[1] + v[2] * v[2] + v[3] * v[3]) * (1.f / 256.f) + EPS);
          const f32x4 g = *(const f32x4*)(a.in[I_KVN] + 4 * lane); const f32x4 o = {v[0] * rs * g[0], v[1] * rs * g[1], v[2] * rs * g[2], v[3] * rs * g[3]};
          if (row < R_S0) *(f32x4*)(a.out + OUT_CKVP + ((size_t)(row >> 14) * 16400 + 16 + (row & 16383)) * 256 + 4 * lane) = o;
          else if (row < R_M0) *(f32x4*)(a.out + OUT_CKVS + (size_t)(row - R_S0) * 256 + 4 * lane) = o;
          else { *(f32x4*)(a.out + OUT_CKVP + (size_t)(row - R_M0) * 256 + 4 * lane) = o; *(f32x4*)(a.out + OUT_CKVP + (size_t)(16400 + row - R_M0) * 256 + 4 * lane) = o; }
          u32x2 ob = {cvtpk(o[0], o[1]), cvtpk(o[2], o[3])}; *(u32x2*)(ckvb + (size_t)row * 256 + 4 * lane) = ob; }
        if (lane < 16) { const float x1 = bf2f(mr[672 + lane]), x2 = bf2f(mr[688 + lane]); const f32x2 cs = *(const f32x2*)(rope + ((size_t)pos_idx(row) * 16 + lane) * 2);
          const float o1 = x1 * cs[0] - x2 * cs[1], o2 = x1 * cs[1] + x2 * cs[0];
          if (row < R_S0) { float* p = a.out + OUT_KRP + ((size_t)(row >> 14) * 16400 + 16 + (row & 16383)) * 32; p[lane] = o1; p[16 + lane] = o2; }
          else if (row < R_M0) { float* p = a.out + OUT_KRS + (size_t)(row - R_S0) * 32; p[lane] = o1; p[16 + lane] = o2; }
          else { float* p = a.out + OUT_KRP + (size_t)(row - R_M0) * 32; p[lane] = o1; p[16 + lane] = o2; p += (size_t)16400 * 32; p[lane] = o1; p[16 + lane] = o2; }
          krb[(size_t)row * 32 + lane] = (bf16_t)f2bf(o1); krb[(size_t)row * 32 + 16 + lane] = (bf16_t)f2bf(o2); }
    }
    for (int row = R_ACT + gw; row < R1; row += NGW) { u32x2 z = {0u, 0u}; *(u32x2*)(ckvb + (size_t)row * 256 + 4 * lane) = z; if (lane < 16) ((unsigned*)(krb + (size_t)row * 32))[lane] = 0u; }
    for (int r = gw; r < 16384; r += NGW) {
        const f32x4 v = *(const f32x4*)(a.in[I_CCKV] + (size_t)r * 256 + 4 * lane); u32x2 o = {cvtpk(v[0], v[1]), cvtpk(v[2], v[3])}; *(u32x2*)(ckvb + (size_t)(R_C0 + r) * 256 + 4 * lane) = o;
        if (lane < 8) { const f32x4 k = *(const f32x4*)(a.in[I_CKR] + (size_t)r * 32 + 4 * lane); u32x2 ok = {cvtpk(k[0], k[1]), cvtpk(k[2], k[3])}; *(u32x2*)(krb + (size_t)(R_C0 + r) * 32 + 4 * lane) = ok; }
    }
    for (int item = NGW - 1 - gw; item < 529 * 6; item += NGW) {
        const int T = item / 6, cc = item - T * 6, c0 = cc * 512 + lane * 8;
        int row0, nrows; float p0[8], p1[8], p2[8];
        if (T < 512) { row0 = T * 64; nrows = 64; const bf16_t* hp = halo + (size_t)T * 3 * 3072 + c0;
            const u32x4 h0 = *(const u32x4*)hp, h1 = *(const u32x4*)(hp + 3072), h2 = *(const u32x4*)(hp + 6144);
#pragma unroll
            for (int e = 0; e < 4; ++e) { p0[2 * e] = bflo(h0[e]); p0[2 * e + 1] = bfhi(h0[e]); p1[2 * e] = bflo(h1[e]); p1[2 * e + 1] = bfhi(h1[e]); p2[2 * e] = bflo(h2[e]); p2[2 * e + 1] = bfhi(h2[e]); } }
        else if (T == 512) { row0 = R_M0; nrows = 16;
#pragma unroll
            for (int e = 0; e < 8; ++e) { p0[e] = 0.f; p1[e] = 0.f; p2[e] = 0.f; } }
        else { const int db = T - 513; row0 = R_S0 + 32 * db; nrows = 32; const float* sp = a.in[I_SCONV] + (size_t)db * 3 * 3072 + c0;
#pragma unroll
            for (int e = 0; e < 8; ++e) { p0[e] = sp[e]; p1[e] = sp[3072 + e]; p2[e] = sp[6144 + e]; } }
        float w0[8], w1[8], w2[8], w3[8], bb[8];
#pragma unroll
        for (int e = 0; e < 8; ++e) { w0[e] = a.in[I_CONVW][c0 + e]; w1[e] = a.in[I_CONVW][3072 + c0 + e]; w2[e] = a.in[I_CONVW][6144 + c0 + e]; w3[e] = a.in[I_CONVW][9216 + c0 + e]; bb[e] = a.in[I_CONVB][c0 + e]; }
        for (int t0 = 0; t0 < nrows; t0 += 8) {
            u32x4 raw[8];
#pragma unroll
            for (int k = 0; k < 8; ++k) raw[k] = *(const u32x4*)(xc + (size_t)(row0 + t0 + k) * 3072 + c0);
#pragma unroll
            for (int k = 0; k < 8; ++k) { float x[8], y[8];
#pragma unroll
                for (int e = 0; e < 4; ++e) { x[2 * e] = bflo(raw[k][e]); x[2 * e + 1] = bfhi(raw[k][e]); }
#pragma unroll
                for (int e = 0; e < 8; ++e) { y[e] = silu_f(bb[e] + w0[e] * p0[e] + w1[e] * p1[e] + w2[e] * p2[e] + w3[e] * x[e]); p0[e] = p1[e]; p1[e] = p2[e]; p2[e] = x[e]; }
                u32x4 o; o.x = cvtpk(y[0], y[1]); o.y = cvtpk(y[2], y[3]); o.z = cvtpk(y[4], y[5]); o.w = cvtpk(y[6], y[7]);
                *(u32x4*)(xc + (size_t)(row0 + t0 + k) * 3072 + c0) = o; }
        }
    }
}

__device__ __forceinline__ void p6_phase(const Args& a, LAS unsigned char* L, const int wave) {
    const int lane = lane_id(); int tid = wave * 64 + lane; asm volatile("" : "+v"(tid)); tid &= 511;
    unsigned char* ws = a.ws; const bf16_t* xc = (const bf16_t*)(ws + WS_X); const float* dt = (const float*)(ws + WS_DT); const float* acs = (const float*)(ws + WS_ACS);
    const float* tot = (const float*)(ws + WS_TOT); bf16_t* S = (bf16_t*)(ws + WS_S);
    LAS bf16_t* Bs = (LAS bf16_t*)L; LAS bf16_t* Xs = (LAS bf16_t*)(L + 18432); LAS float* scs = (LAS float*)(L + 86016);
    const int li = lane & 15, quad = lane >> 4;
    const unsigned voffB = (unsigned)((tid >> 4) * 3072 + (tid & 15) * 8), voffX = (unsigned)((tid >> 6) * 3072 + (tid & 63) * 8);
    for (int unit = blockIdx.x; unit < NCHUNK * 4; unit += gridDim.x) {
        const int ci = unit >> 2, g = unit & 3, h = 8 * g + wave; int row0, ntok; chunk_info(ci, row0, ntok);
        f32x4 acc[8][4];
#pragma unroll
        for (int nb = 0; nb < 8; ++nb)
#pragma unroll
            for (int pb = 0; pb < 4; ++pb) acc[nb][pb] = (f32x4){0.f, 0.f, 0.f, 0.f};
        const int nsub = (ntok + 63) >> 6;
        for (int jb = 0; jb < nsub; ++jb) {
            const int rj = row0 + 64 * jb;
            __syncthreads();
            { const int hh = tid >> 6, t = tid & 63; const size_t r = (size_t)(rj + t) * 32 + 8 * g + hh; float v = 0.f;
              if (64 * jb + t < ntok) v = __expf(tot[ci * 32 + 8 * g + hh] - acs[r]) * dt[r];
              scs[hh * 64 + t] = v; }
#pragma unroll
            for (int i = 0; i < 2; ++i) { const bf16_t* gb = xc + (size_t)(rj + 32 * i) * 3072 + 2048 + 128 * g;
                *(LAS u32x4*)(Bs + ((tid >> 4) + 32 * i) * 144 + (tid & 15) * 8) = *(const u32x4*)(gb + voffB); }
            __syncthreads();
#pragma unroll
            for (int i = 0; i < 8; ++i) { const int t = (tid >> 6) + 8 * i, c = tid & 63; const bf16_t* gb = xc + (size_t)(rj + 8 * i) * 3072 + 512 * g;
                const u32x4 v = *(const u32x4*)(gb + voffX); const float s = scs[(c >> 3) * 64 + t];
                u32x4 o; o.x = cvtpk(bflo(v.x) * s, bfhi(v.x) * s); o.y = cvtpk(bflo(v.y) * s, bfhi(v.y) * s); o.z = cvtpk(bflo(v.z) * s, bfhi(v.z) * s); o.w = cvtpk(bflo(v.w) * s, bfhi(v.w) * s);
                *(LAS u32x4*)(Xs + t * 528 + c * 8) = o; }
            __syncthreads();
#pragma unroll
            for (int s2 = 0; s2 < 2; ++s2) {
                const int tok0 = 32 * s2 + 4 * quad + (li >> 2), cq4 = 4 * (li & 3);
                bf16x8 Bf[4];
#pragma unroll
                for (int pb = 0; pb < 4; ++pb) Bf[pb] = cat8(ldtr(Xs + tok0 * 528 + 64 * wave + 16 * pb + cq4), ldtr(Xs + (tok0 + 16) * 528 + 64 * wave + 16 * pb + cq4));
#pragma unroll
                for (int nb = 0; nb < 8; ++nb) { const bf16x8 Af = cat8(ldtr(Bs + tok0 * 144 + 16 * nb + cq4), ldtr(Bs + (tok0 + 16) * 144 + 16 * nb + cq4));
#pragma unroll
                    for (int pb = 0; pb < 4; ++pb) acc[nb][pb] = MFMA16(Af, Bf[pb], acc[nb][pb]); }
            }
        }
        bf16_t* Sp = S + ((size_t)(ci * 32 + h) * 64) * 128;
#pragma unroll
        for (int nb = 0; nb < 8; ++nb)
#pragma unroll
            for (int pb = 0; pb < 4; ++pb) { u32x2 o = {cvtpk(acc[nb][pb][0], acc[nb][pb][1]), cvtpk(acc[nb][pb][2], acc[nb][pb][3])};
                *(u32x2*)(Sp + (size_t)(16 * pb + li) * 128 + 16 * nb + 4 * quad) = o; }
    }
}

__device__ __forceinline__ void p7_phase(const Args& a, const int wave) {
    int tid = wave * 64 + lane_id(); asm volatile("" : "+v"(tid)); tid &= 511;
    unsigned char* ws = a.ws; bf16_t* S = (bf16_t*)(ws + WS_S); const float* tot = (const float*)(ws + WS_TOT);
    const int gt = blockIdx.x * 512 + tid, NT = gridDim.x * 512;
    for (int e = gt; e < 131072; e += NT) {
        const int b = e >> 16, rem = e & 65535, h = rem >> 11; f32x4 st = {0.f, 0.f, 0.f, 0.f};
        for (int k0 = 0; k0 < 65; k0 += 5) { u32x2 v[5]; float dec[5];
#pragma unroll
            for (int k = 0; k < 5; ++k) { const int ci = b * 65 + k0 + k; v[k] = *(const u32x2*)(S + (size_t)ci * 262144 + rem * 4); dec[k] = __expf(tot[ci * 32 + h]); }
#pragma unroll
            for (int k = 0; k < 5; ++k) { const int ci = b * 65 + k0 + k; u32x2 o = {cvtpk(st[0], st[1]), cvtpk(st[2], st[3])}; *(u32x2*)(S + (size_t)ci * 262144 + rem * 4) = o;
                st[0] = st[0] * dec[k] + bflo(v[k].x); st[1] = st[1] * dec[k] + bfhi(v[k].x); st[2] = st[2] * dec[k] + bflo(v[k].y); st[3] = st[3] * dec[k] + bfhi(v[k].y); } }
        *(f32x4*)(a.out + OUT_SSMP + (size_t)b * 262144 + rem * 4) = st;
    }
    for (int e = gt; e < 16 * 65536; e += NT) {
        const int db = e >> 16, rem = e & 65535, h = rem >> 11, ci = 130 + db;
        const f32x4 s0 = *(const f32x4*)(a.in[I_SSSM] + (size_t)db * 262144 + rem * 4); const u32x2 v = *(const u32x2*)(S + (size_t)ci * 262144 + rem * 4); const float dec = __expf(tot[ci * 32 + h]);
        u32x2 o = {cvtpk(s0[0], s0[1]), cvtpk(s0[2], s0[3])}; *(u32x2*)(S + (size_t)ci * 262144 + rem * 4) = o;
        const f32x4 r = {s0[0] * dec + bflo(v.x), s0[1] * dec + bfhi(v.x), s0[2] * dec + bflo(v.y), s0[3] * dec + bfhi(v.y)};
        *(f32x4*)(a.out + OUT_SSMS + (size_t)db * 262144 + rem * 4) = r;
    }
}

__device__ __forceinline__ void p8_phase(const Args& a, LAS unsigned char* L, const int wave) {
    const int lane = lane_id(); int tid = wave * 64 + lane; asm volatile("" : "+v"(tid)); tid &= 511;
    unsigned char* ws = a.ws; const bf16_t* xc = (const bf16_t*)(ws + WS_X); const float* dt = (const float*)(ws + WS_DT); const float* acs = (const float*)(ws + WS_ACS);
    const bf16_t* S = (const bf16_t*)(ws + WS_S); bf16_t* zb = (bf16_t*)(ws + WS_Z);
    LAS bf16_t* Cs = (LAS bf16_t*)L; LAS bf16_t* Bs = (LAS bf16_t*)(L + 18432); LAS bf16_t* Xs = (LAS bf16_t*)(L + 36864);
    LAS float* aj = (LAS float*)(L + 104448); LAS float* dj = (LAS float*)(L + 106496); LAS float* red = (LAS float*)(L + 108544);
    const int li = lane & 15, quad = lane >> 4;
    const unsigned voffB = (unsigned)((tid >> 4) * 3072 + (tid & 15) * 8), voffX = (unsigned)((tid >> 6) * 3072 + (tid & 63) * 8);
    for (int u = blockIdx.x; u < 2120; u += gridDim.x) {
        int ci, i, g;
        if (u < 2048) { i = 3 - (u >> 9); const int rest = u & 511; ci = (rest >> 8) * 65 + 1 + ((rest & 255) >> 2); g = rest & 3; }
        else { int v = u - 2048; i = 0; g = v & 3; if (v < 8) ci = (v >> 2) * 65; else ci = 130 + ((v - 8) >> 2); }
        int row0, ntok; chunk_info(ci, row0, ntok);
        const int rb = row0 + 64 * i, nti = (ntok - 64 * i) < 64 ? (ntok - 64 * i) : 64, h = 8 * g + wave;
        __syncthreads();
#pragma unroll
        for (int i2 = 0; i2 < 2; ++i2) { const bf16_t* gb = xc + (size_t)(rb + 32 * i2) * 3072 + 2560 + 128 * g;
            *(LAS u32x4*)(Cs + ((tid >> 4) + 32 * i2) * 144 + (tid & 15) * 8) = *(const u32x4*)(gb + voffB); }
        __syncthreads();
        const bf16_t* Sp = S + ((size_t)(ci * 32 + h) * 64) * 128;
        const float Dh = a.in[I_SSMD][h];
        { constexpr int ih = 0;
        f32x4 acc[4][4];
#pragma unroll
        for (int pb = 0; pb < 4; ++pb)
#pragma unroll
            for (int ib = 0; ib < 4; ++ib) acc[pb][ib] = (f32x4){0.f, 0.f, 0.f, 0.f};
        float ai[4];
#pragma unroll
        for (int ib = 0; ib < 4; ++ib) ai[ib] = acs[(size_t)(rb + 32 * ih + 16 * ib + li) * 32 + h];
        { bf16x8 Af[4][4];
#pragma unroll
          for (int ks = 0; ks < 4; ++ks)
#pragma unroll
            for (int pb = 0; pb < 4; ++pb) Af[ks][pb] = *(const bf16x8*)(Sp + (size_t)(16 * pb + li) * 128 + 32 * ks + 8 * quad);
#pragma unroll
          for (int ks = 0; ks < 4; ++ks) { bf16x8 Bf[4];
#pragma unroll
            for (int ib = 0; ib < 4; ++ib) Bf[ib] = *(const LAS bf16x8*)(Cs + (32 * ih + 16 * ib + li) * 144 + 32 * ks + 8 * quad);
#pragma unroll
            for (int pb = 0; pb < 4; ++pb)
#pragma unroll
                for (int ib = 0; ib < 4; ++ib) acc[pb][ib] = MFMA16(Af[ks][pb], Bf[ib], acc[pb][ib]);
            __builtin_amdgcn_sched_barrier(0); } }
#pragma unroll
        for (int ib = 0; ib < 4; ++ib) { const float e = __expf(ai[ib]);
#pragma unroll
            for (int pb = 0; pb < 4; ++pb) acc[pb][ib] = acc[pb][ib] * e; }
        for (int j = 0; j <= i; ++j) {
            const int rj = row0 + 64 * j;
            __syncthreads();
#pragma unroll
            for (int i2 = 0; i2 < 2; ++i2) { const bf16_t* gb = xc + (size_t)(rj + 32 * i2) * 3072 + 2048 + 128 * g;
                *(LAS u32x4*)(Bs + ((tid >> 4) + 32 * i2) * 144 + (tid & 15) * 8) = *(const u32x4*)(gb + voffB); }
#pragma unroll
            for (int i2 = 0; i2 < 8; ++i2) { const bf16_t* gb = xc + (size_t)(rj + 8 * i2) * 3072 + 512 * g;
                *(LAS u32x4*)(Xs + ((tid >> 6) + 8 * i2) * 528 + (tid & 63) * 8) = *(const u32x4*)(gb + voffX); }
            { const int hh = tid >> 6, t = tid & 63; const size_t r = (size_t)(rj + t) * 32 + 8 * g + hh; aj[hh * 64 + t] = acs[r]; dj[hh * 64 + t] = dt[r]; }
            __syncthreads();
            bf16x8 XA[4][2]; f32x4 a4v[4], d4v[4];
#pragma unroll
            for (int s2 = 0; s2 < 2; ++s2) { const LAS bf16_t* xp = Xs + (32 * s2 + 4 * quad + (li >> 2)) * 528 + 64 * wave + 4 * (li & 3);
#pragma unroll
                for (int pb = 0; pb < 4; ++pb) XA[pb][s2] = cat8(ldtr(xp + 16 * pb), ldtr(xp + 16 * 528 + 16 * pb)); }
#pragma unroll
            for (int jb = 0; jb < 4; ++jb) { a4v[jb] = *(const LAS f32x4*)(aj + wave * 64 + 16 * jb + 4 * quad); d4v[jb] = *(const LAS f32x4*)(dj + wave * 64 + 16 * jb + 4 * quad); }
            __builtin_amdgcn_sched_barrier(0);
#pragma unroll
            for (int ib = 0; ib < 4; ++ib) {
                f32x4 cb[4];
#pragma unroll
                for (int jb = 0; jb < 4; ++jb) cb[jb] = (f32x4){0.f, 0.f, 0.f, 0.f};
#pragma unroll
                for (int ks = 0; ks < 4; ++ks) { const bf16x8 Bc = *(const LAS bf16x8*)(Cs + (32 * ih + 16 * ib + li) * 144 + 32 * ks + 8 * quad);
#pragma unroll
                    for (int jb = 0; jb < 4; ++jb) { const bf16x8 Ab = *(const LAS bf16x8*)(Bs + (16 * jb + li) * 144 + 32 * ks + 8 * quad); cb[jb] = MFMA16(Ab, Bc, cb[jb]); } }
                const int ti = 32 * ih + 16 * ib + li;
#pragma unroll
                for (int jb = 0; jb < 4; ++jb) { const f32x4 a4 = a4v[jb], d4 = d4v[jb];
#pragma unroll
                    for (int jj = 0; jj < 4; ++jj) { const int tj = 16 * jb + 4 * quad + jj; float val = cb[jb][jj] * __expf(fminf(ai[ib] - a4[jj], 0.f)) * d4[jj];
                        if (j == i && tj > ti) val = 0.f; cb[jb][jj] = val; } }
#pragma unroll
                for (int s2 = 0; s2 < 2; ++s2) { u32x4 pk = {cvtpk(cb[2 * s2][0], cb[2 * s2][1]), cvtpk(cb[2 * s2][2], cb[2 * s2][3]), cvtpk(cb[2 * s2 + 1][0], cb[2 * s2 + 1][1]), cvtpk(cb[2 * s2 + 1][2], cb[2 * s2 + 1][3])};
                    const bf16x8 P = __builtin_bit_cast(bf16x8, pk);
#pragma unroll
                    for (int pb = 0; pb < 4; ++pb) acc[pb][ib] = MFMA16(XA[pb][s2], P, acc[pb][ib]); }
                __builtin_amdgcn_sched_barrier(0);
            }
        }
        float ss[4];
#pragma unroll
        for (int ib = 0; ib < 4; ++ib) { ss[ib] = 0.f; const int ti = 32 * ih + 16 * ib + li;
#pragma unroll
            for (int pb = 0; pb < 4; ++pb) { const int p0 = 16 * pb + 4 * quad; const u32x2 xr = *(const LAS u32x2*)(Xs + ti * 528 + 64 * wave + p0);
                const u32x2 zr = *(const u32x2*)(zb + (size_t)(rb + ti) * 2048 + 64 * h + p0);
                const float x4[4] = {bflo(xr.x), bfhi(xr.x), bflo(xr.y), bfhi(xr.y)}, z4[4] = {bflo(zr.x), bfhi(zr.x), bflo(zr.y), bfhi(zr.y)};
#pragma unroll
                for (int jj = 0; jj < 4; ++jj) { const float y = (acc[pb][ib][jj] + Dh * x4[jj]) * silu_f(z4[jj]); acc[pb][ib][jj] = y; ss[ib] += y * y; } }
            ss[ib] += __shfl_xor(ss[ib], 16); ss[ib] += __shfl_xor(ss[ib], 32);
            if (quad == 0) red[wave * 64 + ti] = ss[ib]; }
        __syncthreads();
#pragma unroll
        for (int ib = 0; ib < 4; ++ib) { const int ti = 32 * ih + 16 * ib + li; float t8 = 0.f;
#pragma unroll
            for (int w = 0; w < 8; ++w) t8 += red[w * 64 + ti];
            const float rs = rsqrtf(t8 * (1.f / 512.f) + EPS);
            if (ti < nti) {
#pragma unroll
                for (int pb = 0; pb < 4; ++pb) { const int p0 = 16 * pb + 4 * quad; const f32x4 gn = *(const f32x4*)(a.in[I_SSMN] + 64 * h + p0);
                    u32x2 o = {cvtpk(acc[pb][ib][0] * rs * gn[0], acc[pb][ib][1] * rs * gn[1]), cvtpk(acc[pb][ib][2] * rs * gn[2], acc[pb][ib][3] * rs * gn[3])};
                    *(u32x2*)(zb + (size_t)(rb + ti) * 2048 + 64 * h + p0) = o; } } }
        }
    }
}

__device__ __forceinline__ void attn_tile(bool prompt, int b_or_db, int tt, int& row0, int& nv) {
    if (tt == 0) { row0 = R_M0; nv = 16; return; }
    if (prompt) { row0 = b_or_db * 16384 + 64 * (tt - 1); nv = 64; }
    else if (tt <= 16) { row0 = R_C0 + 1024 * b_or_db + 64 * (tt - 1); nv = 64; }
    else { row0 = R_S0 + 32 * b_or_db; nv = 32; }
}
__device__ __forceinline__ void p11_phase(const Args& a, LAS unsigned char* L, const int wave) {
    const int lane = lane_id(); int tid = wave * 64 + lane; asm volatile("" : "+v"(tid)); tid &= 511;
    unsigned char* ws = a.ws; const bf16_t* Q = (const bf16_t*)(ws + WS_Q); const bf16_t* Kn = (const bf16_t*)(ws + WS_KN); const bf16_t* Vt = (const bf16_t*)(ws + WS_VT);
    const bf16_t* krb = (const bf16_t*)(ws + WS_KRB); bf16_t* O = (bf16_t*)(ws + WS_O); const float* rope = (const float*)(ws + WS_ROPE);
    constexpr int KSZ = 64 * 104, VSZ = 64 * 72, BUF = KSZ + VSZ;
    LAS bf16_t* LB = (LAS bf16_t*)L;
    const int li = lane & 15, quad = lane >> 4;
    const unsigned vo_kn = (unsigned)((tid >> 3) * 1024 + (tid & 7) * 8), vo_kr = (unsigned)(((tid & 255) >> 2) * 32 + (tid & 3) * 8), vo_vt = (unsigned)((tid >> 3) * RK + (tid & 7) * 8);
    const int so_kn = (tid >> 3) * 104 + (tid & 7) * 8, so_kr = ((tid & 255) >> 2) * 104 + 64 + (tid & 3) * 8, so_vt = KSZ + (tid >> 3) * 72 + (tid & 7) * 8;
    for (int u = blockIdx.x; u < 2304; u += gridDim.x) {
        bool prompt, active; int bq, hd, qr0, ntiles, limit;
        if (u < 2048) { const int k = u >> 8, c32 = (u & 255) >> 5, qblk = 63 - 8 * k - ((k & 1) ? 7 - c32 : c32); prompt = true; bq = (u & 31) >> 4; hd = u & 15;
            qr0 = bq * 16384 + 256 * qblk; ntiles = 4 * qblk + 5; limit = 4 * qblk + (wave >> 1) + 1; active = true; }
        else { const int v = u - 2048; prompt = false; bq = v >> 4; hd = v & 15; qr0 = R_S0 + 32 * bq; ntiles = 18; limit = 17; active = (wave == 0); }
        const int qrow = qr0 + 32 * wave;
        bf16x8 qf[2][3];
#pragma unroll
        for (int qb = 0; qb < 2; ++qb) {
            const int r = active ? qrow + 16 * qb + li : 0; const bf16_t* qp = Q + (size_t)r * 1536;
            qf[qb][0] = *(const bf16x8*)(qp + hd * 64 + 8 * quad); qf[qb][1] = *(const bf16x8*)(qp + hd * 64 + 32 + 8 * quad);
            const u32x4 x1 = *(const u32x4*)(qp + 1024 + hd * 32 + 8 * (quad & 1)), x2 = *(const u32x4*)(qp + 1024 + hd * 32 + 16 + 8 * (quad & 1));
            const float* rp = rope + ((size_t)pos_idx(r) * 16 + 8 * (quad & 1)) * 2; float ov[8];
#pragma unroll
            for (int e = 0; e < 4; ++e) { const f32x4 cs = *(const f32x4*)(rp + 4 * e);
                const float a0 = bflo(x1[e]), a1 = bfhi(x1[e]), b0 = bflo(x2[e]), b1 = bfhi(x2[e]);
                ov[2 * e] = quad < 2 ? a0 * cs[0] - b0 * cs[1] : a0 * cs[1] + b0 * cs[0]; ov[2 * e + 1] = quad < 2 ? a1 * cs[2] - b1 * cs[3] : a1 * cs[3] + b1 * cs[2]; }
            u32x4 pkq = {cvtpk(ov[0], ov[1]), cvtpk(ov[2], ov[3]), cvtpk(ov[4], ov[5]), cvtpk(ov[6], ov[7])}; qf[qb][2] = __builtin_bit_cast(bf16x8, pkq);
        }
        float mrun[2] = {-INFINITY, -INFINITY}, lrun[2] = {0.f, 0.f}; f32x4 o[4][2];
#pragma unroll
        for (int db = 0; db < 4; ++db) { o[db][0] = (f32x4){0.f, 0.f, 0.f, 0.f}; o[db][1] = o[db][0]; }
        int row0, nv, nvn; attn_tile(prompt, bq, 0, row0, nv);
        u32x4 pkn = *(const u32x4*)(Kn + (size_t)row0 * 1024 + hd * 64 + vo_kn);
        u32x4 pkr = *(const u32x4*)(krb + (size_t)row0 * 32 + vo_kr);
        u32x4 pvt = *(const u32x4*)(Vt + (size_t)hd * 64 * RK + row0 + vo_vt);
        __syncthreads();
        *(LAS u32x4*)(LB + so_kn) = pkn; if (tid < 256) *(LAS u32x4*)(LB + so_kr) = pkr; *(LAS u32x4*)(LB + so_vt) = pvt;
        attn_tile(prompt, bq, 1, row0, nvn);
        pkn = *(const u32x4*)(Kn + (size_t)row0 * 1024 + hd * 64 + vo_kn); pkr = *(const u32x4*)(krb + (size_t)row0 * 32 + vo_kr); pvt = *(const u32x4*)(Vt + (size_t)hd * 64 * RK + row0 + vo_vt);
        for (int tt = 0; tt < ntiles; ++tt) {
            const int nvc = nv; nv = nvn;
            __syncthreads();
            if (tt + 1 < ntiles) { LAS bf16_t* nb = LB + ((tt + 1) & 1) * BUF;
                *(LAS u32x4*)(nb + so_kn) = pkn; if (tid < 256) *(LAS u32x4*)(nb + so_kr) = pkr; *(LAS u32x4*)(nb + so_vt) = pvt;
                if (tt + 2 < ntiles) { attn_tile(prompt, bq, tt + 2, row0, nvn);
                    pkn = *(const u32x4*)(Kn + (size_t)row0 * 1024 + hd * 64 + vo_kn); pkr = *(const u32x4*)(krb + (size_t)row0 * 32 + vo_kr); pvt = *(const u32x4*)(Vt + (size_t)hd * 64 * RK + row0 + vo_vt); } }
            if (active && tt <= limit) {
                const LAS bf16_t* Ks = LB + (tt & 1) * BUF; const LAS bf16_t* Vs = Ks + KSZ;
                f32x4 s[4][2];
                const float m0 = mrun[0] == -INFINITY ? 0.f : mrun[0], m1 = mrun[1] == -INFINITY ? 0.f : mrun[1];
#pragma unroll
                for (int kb = 0; kb < 4; ++kb) { s[kb][0] = (f32x4){-m0, -m0, -m0, -m0}; s[kb][1] = (f32x4){-m1, -m1, -m1, -m1}; }
#pragma unroll
                for (int ks = 0; ks < 3; ++ks)
#pragma unroll
                    for (int kb = 0; kb < 4; ++kb) { const bf16x8 kf = *(const LAS bf16x8*)(Ks + (16 * kb + li) * 104 + 32 * ks + 8 * quad);
                        s[kb][0] = MFMA16(kf, qf[0][ks], s[kb][0]); s[kb][1] = MFMA16(kf, qf[1][ks], s[kb][1]); }
                if (nvc < 64) {
#pragma unroll
                    for (int kb = 0; kb < 4; ++kb)
#pragma unroll
                        for (int jj = 0; jj < 4; ++jj) if (16 * kb + 4 * quad + jj >= nvc) { s[kb][0][jj] = -INFINITY; s[kb][1][jj] = -INFINITY; } }
                bf16x8 P[2][2];
#pragma unroll
                for (int qb = 0; qb < 2; ++qb) {
                    float mx = fmaxf(fmaxf(s[0][qb][0], s[0][qb][1]), s[0][qb][2]);
                    mx = fmaxf(fmaxf(mx, s[0][qb][3]), s[1][qb][0]); mx = fmaxf(fmaxf(mx, s[1][qb][1]), s[1][qb][2]); mx = fmaxf(fmaxf(mx, s[1][qb][3]), s[2][qb][0]);
                    mx = fmaxf(fmaxf(mx, s[2][qb][1]), s[2][qb][2]); mx = fmaxf(fmaxf(mx, s[2][qb][3]), s[3][qb][0]); mx = fmaxf(fmaxf(mx, s[3][qb][1]), s[3][qb][2]); mx = fmaxf(mx, s[3][qb][3]);
                    const bool first = (mrun[qb] == -INFINITY);
                    if (__builtin_amdgcn_ballot_w64(first || mx > 16.f) != 0ull) {
                        mx = fmaxf(mx, __shfl_xor(mx, 16)); mx = fmaxf(mx, __shfl_xor(mx, 32));
                        const float mold = qb == 0 ? m0 : m1, d = first ? mx : fmaxf(mx, 0.f);
                        const float alpha = first ? 0.f : __builtin_amdgcn_exp2f(-d); mrun[qb] = mold + d; lrun[qb] *= alpha;
#pragma unroll
                        for (int kb = 0; kb < 4; ++kb) s[kb][qb] = s[kb][qb] - d;
#pragma unroll
                        for (int db = 0; db < 4; ++db) o[db][qb] = o[db][qb] * alpha; }
                    f32x4 rs4 = {0.f, 0.f, 0.f, 0.f};
#pragma unroll
                    for (int kb = 0; kb < 4; ++kb) { f32x4 t = s[kb][qb];
                        t[0] = __builtin_amdgcn_exp2f(t[0]); t[1] = __builtin_amdgcn_exp2f(t[1]); t[2] = __builtin_amdgcn_exp2f(t[2]); t[3] = __builtin_amdgcn_exp2f(t[3]); s[kb][qb] = t; rs4 = rs4 + t; }
                    lrun[qb] += (rs4[0] + rs4[1]) + (rs4[2] + rs4[3]);
#pragma unroll
                    for (int s2 = 0; s2 < 2; ++s2) { u32x4 pk = {cvtpk(s[2 * s2][qb][0], s[2 * s2][qb][1]), cvtpk(s[2 * s2][qb][2], s[2 * s2][qb][3]), cvtpk(s[2 * s2 + 1][qb][0], s[2 * s2 + 1][qb][1]), cvtpk(s[2 * s2 + 1][qb][2], s[2 * s2 + 1][qb][3])};
                        P[qb][s2] = __builtin_bit_cast(bf16x8, pk); }
                }
#pragma unroll
                for (int s2 = 0; s2 < 2; ++s2)
#pragma unroll
                    for (int db = 0; db < 4; ++db) { const LAS bf16_t* vp = Vs + (16 * db + li) * 72 + 32 * s2 + 4 * quad;
                        const bf16x8 vf = cat8u(*(const LAS u32x2*)vp, *(const LAS u32x2*)(vp + 16));
                        o[db][0] = MFMA16(vf, P[0][s2], o[db][0]); o[db][1] = MFMA16(vf, P[1][s2], o[db][1]); }
            }
        }
        if (active) {
#pragma unroll
            for (int qb = 0; qb < 2; ++qb) { float l = lrun[qb]; l += __shfl_xor(l, 16); l += __shfl_xor(l, 32); const float inv = 1.f / l;
#pragma unroll
                for (int db = 0; db < 4; ++db) { u32x2 w = {cvtpk(o[db][qb][0] * inv, o[db][qb][1] * inv), cvtpk(o[db][qb][2] * inv, o[db][qb][3] * inv)};
                    *(u32x2*)(O + (size_t)(qrow + 16 * qb + li) * 1024 + hd * 64 + 16 * db + 4 * quad) = w; } }
        }
    }
}

#ifndef ONLY_PHASE
#define ONLY_PHASE -1
#endif
#define PH(k) (ONLY_PHASE < 0 || ONLY_PHASE == (k))
constexpr int NPHASE = 20;
constexpr int LDS_BYTES = 131072;
__device__ __forceinline__ void grid_barrier(unsigned* ctr, unsigned target, int wave) {
    __syncthreads();
    if (wave == 0) {
        __builtin_amdgcn_fence(__ATOMIC_RELEASE, "agent");
        if (lane_id() == 0) {
            __hip_atomic_fetch_add(ctr, 1u, __ATOMIC_RELAXED, __HIP_MEMORY_SCOPE_AGENT);
            while (__hip_atomic_load(ctr, __ATOMIC_RELAXED, __HIP_MEMORY_SCOPE_AGENT) < target) __builtin_amdgcn_s_sleep(1);
        }
        __builtin_amdgcn_fence(__ATOMIC_ACQUIRE, "agent");
    }
    __syncthreads();
}
__global__ void __launch_bounds__(512, 2) fwd_megakernel(Args a) {
    extern __shared__ __attribute__((aligned(16))) unsigned char lds_raw[];
    LAS unsigned char* L = (LAS unsigned char*)lds_raw;
    unsigned char* ws = a.ws;
    bf16_t* W_IN = (bf16_t*)(ws + WS_W_IN); bf16_t* W_GU = (bf16_t*)(ws + WS_W_GU); bf16_t* W_D = (bf16_t*)(ws + WS_W_D); bf16_t* W_SO = (bf16_t*)(ws + WS_W_SO);
    bf16_t* W_UQ = (bf16_t*)(ws + WS_W_UQ); bf16_t* W_K = (bf16_t*)(ws + WS_W_K); bf16_t* W_V = (bf16_t*)(ws + WS_W_V); bf16_t* W_MO = (bf16_t*)(ws + WS_W_MO); bf16_t* W_MIX = (bf16_t*)(ws + WS_W_MIX);
    float* hmeta = (float*)(ws + WS_HMETA);
    const RowMap rm{a.out, hmeta, a.in[I_XP], a.in[I_XS], a.in[I_META]};
    const int wave = __builtin_amdgcn_readfirstlane((int)threadIdx.x >> 6);
    unsigned* bar = (unsigned*)(ws + WS_BAR);
    if (a.ph_hi > 1000) { cg::grid_group grid = cg::this_grid(); grid.sync(); }
    const int lo = a.ph_lo, hi = a.ph_hi;
    __builtin_amdgcn_fence(__ATOMIC_ACQUIRE, "agent");
#define TIDS const int lane = lane_id(); int tid = wave * 64 + lane; asm volatile("" : "+v"(tid)); tid &= 511; const int gw = blockIdx.x * 8 + wave, NGW = gridDim.x * 8; (void)tid; (void)lane; (void)gw; (void)NGW;
#define IN(k) (PH(k) && lo <= (k) && (k) < hi)
    unsigned nbar = 0;
#ifdef TIME_PHASE
    unsigned long long t_a = 0, t_b = 0;
#endif
#define SEAM(k) do { if ((k) + 1 < hi) { ++nbar; grid_barrier(bar, nbar * gridDim.x, wave); } } while (0)
    {
        {
#ifdef TIME_PHASE
        if (TIME_PHASE == 0) t_a = __builtin_amdgcn_s_memrealtime();
#endif
        if (IN(0)) { { TIDS
            LAS float* scr = (LAS float*)L;
            xpose_matrix(a.in[I_F1GU], 1024, 2 * FFN, W_GU, 2 * FFN, 1, scr, tid);
            xpose_matrix(a.in[I_F1D], FFN, 1024, W_D, 1024, 0, scr, tid);
            xpose_matrix(a.in[I_WIN], 1024, 7872, W_IN, 7936, 2, scr, tid);
            xpose_matrix(a.in[I_WSO], 2048, 1024, W_SO, 1024, 0, scr, tid);
            xpose_matrix(a.in[I_WUQ], 384, 1536, W_UQ, 1536, 3, scr, tid);
            xpose_matrix(a.in[I_WUKV], 256, 2048, W_K, 1024, 4, scr, tid);
            xpose_matrix(a.in[I_WUKV], 256, 2048, W_V, 1024, 5, scr, tid);
            xpose_matrix(a.in[I_WMO], 1024, 1024, W_MO, 1024, 0, scr, tid);
            xpose_matrix(a.in[I_WMIX], 1024, 1024, W_MIX, 1024, 0, scr, tid);
            __syncthreads();
            bf16_t* xn = (bf16_t*)(ws + WS_U);
            for (int row = gw; row < R1; row += 2 * NGW) { const int r1 = row + NGW; if (r1 < R1) norm_row2_bf16(xrow(rm, row), xrow(rm, r1), a.in[I_F1N], xn + (size_t)row * D, xn + (size_t)r1 * D, lane); else norm_row_bf16(xrow(rm, row), a.in[I_F1N], xn + (size_t)row * D, lane); }
            float* rope = (float*)(ws + WS_ROPE);
            for (int e = blockIdx.x * 512 + tid; e < 16400 * 16; e += gridDim.x * 512) { const int i = e & 15, pos = (e >> 4) - 16;
                const float inv = __builtin_amdgcn_exp2f(-(float)i * 0.83048202372184058f); const float ang = (float)pos * inv;
                double rev = (double)ang * 0.15915494309189535; rev -= __builtin_rint(rev); const float r = (float)rev;
                rope[2 * e] = __builtin_amdgcn_cosf(r); rope[2 * e + 1] = __builtin_amdgcn_sinf(r); }
        } SEAM(0); }
#ifdef TIME_PHASE
        if (TIME_PHASE == 0) t_b = __builtin_amdgcn_s_memrealtime();
#endif
#ifdef TIME_PHASE
        if (TIME_PHASE == 1) t_a = __builtin_amdgcn_s_memrealtime();
#endif
        if (IN(1)) { { EpiSwiglu E{(bf16_t*)(ws + WS_ACT)}; run_gemm(L, (const bf16_t*)(ws + WS_U), W_GU, R1, 2 * FFN, 1024, E, wave); } SEAM(1); }
#ifdef TIME_PHASE
        if (TIME_PHASE == 1) t_b = __builtin_amdgcn_s_memrealtime();
#endif
#ifdef TIME_PHASE
        if (TIME_PHASE == 2) t_a = __builtin_amdgcn_s_memrealtime();
#endif
        if (IN(2)) { { ElResid T{rm, 0.5f, 0}; tail_gemm((const bf16_t*)(ws + WS_ACT), W_D, FFN, 32768, R1, T, wave); EpiResid E{rm, 0.5f, 0}; run_gemm(L, (const bf16_t*)(ws + WS_ACT), W_D, 32768, 1024, FFN, E, wave); } SEAM(2); }
#ifdef TIME_PHASE
        if (TIME_PHASE == 2) t_b = __builtin_amdgcn_s_memrealtime();
#endif
#ifdef TIME_PHASE
        if (TIME_PHASE == 3) t_a = __builtin_amdgcn_s_memrealtime();
#endif
        if (IN(3)) { { TIDS
            bf16_t* un = (bf16_t*)(ws + WS_U);
            for (int row = gw; row < R1; row += 2 * NGW) { const int r1 = row + NGW; if (r1 < R1) norm_row2_bf16(hrow(rm, row), hrow(rm, r1), a.in[I_MIXN], un + (size_t)row * D, un + (size_t)r1 * D, lane); else norm_row_bf16(hrow(rm, row), a.in[I_MIXN], un + (size_t)row * D, lane); }
            LAS float* scr = (LAS float*)L;
            xpose_matrix(a.in[I_F2GU], 1024, 2 * FFN, W_GU, 2 * FFN, 1, scr, tid);
            xpose_matrix(a.in[I_F2D], FFN, 1024, W_D, 1024, 0, scr, tid);
            __syncthreads();
        } SEAM(3); }
#ifdef TIME_PHASE
        if (TIME_PHASE == 3) t_b = __builtin_amdgcn_s_memrealtime();
#endif
#ifdef TIME_PHASE
        if (TIME_PHASE == 4) t_a = __builtin_amdgcn_s_memrealtime();
#endif
        if (IN(4)) { { EpiProj E{(bf16_t*)(ws + WS_Z), (bf16_t*)(ws + WS_X), (bf16_t*)(ws + WS_MISC), (bf16_t*)(ws + WS_HALO), a.out};
                  run_gemm(L, (const bf16_t*)(ws + WS_U), W_IN, R1, 5888, 1024, E, wave); } SEAM(4); }
#ifdef TIME_PHASE
        if (TIME_PHASE == 4) t_b = __builtin_amdgcn_s_memrealtime();
#endif
#ifdef TIME_PHASE
        if (TIME_PHASE == 5) t_a = __builtin_amdgcn_s_memrealtime();
#endif
        if (IN(5)) { p5_phase(a, wave); SEAM(5); }
#ifdef TIME_PHASE
        if (TIME_PHASE == 5) t_b = __builtin_amdgcn_s_memrealtime();
#endif
#ifdef TIME_PHASE
        if (TIME_PHASE == 6) t_a = __builtin_amdgcn_s_memrealtime();
#endif
        if (IN(6)) { p6_phase(a, L, wave); SEAM(6); }
#ifdef TIME_PHASE
        if (TIME_PHASE == 6) t_b = __builtin_amdgcn_s_memrealtime();
#endif
#ifdef TIME_PHASE
        if (TIME_PHASE == 7) t_a = __builtin_amdgcn_s_memrealtime();
#endif
        if (IN(7)) { p7_phase(a, wave); SEAM(7); }
#ifdef TIME_PHASE
        if (TIME_PHASE == 7) t_b = __builtin_amdgcn_s_memrealtime();
#endif
#ifdef TIME_PHASE
        if (TIME_PHASE == 8) t_a = __builtin_amdgcn_s_memrealtime();
#endif
        if (IN(8)) { p8_phase(a, L, wave); SEAM(8); }
#ifdef TIME_PHASE
        if (TIME_PHASE == 8) t_b = __builtin_amdgcn_s_memrealtime();
#endif
#ifdef TIME_PHASE
        if (TIME_PHASE == 9) t_a = __builtin_amdgcn_s_memrealtime();
#endif
        if (IN(9)) { { ElBf16 T{(bf16_t*)(ws + WS_YS), 1024}; tail_gemm((const bf16_t*)(ws + WS_Z), W_SO, 2048, 32768, R2, T, wave); EpiBf16 E{(bf16_t*)(ws + WS_YS), 1024, 1.0f}; run_gemm(L, (const bf16_t*)(ws + WS_Z), W_SO, 32768, 1024, 2048, E, wave); } SEAM(9); }
#ifdef TIME_PHASE
        if (TIME_PHASE == 9) t_b = __builtin_amdgcn_s_memrealtime();
#endif
#ifdef TIME_PHASE
        if (TIME_PHASE == 10) t_a = __builtin_amdgcn_s_memrealtime();
#endif
        if (IN(10)) { {
            for (int gi = 0; gi < 3; ++gi) {
                const bf16_t* A = gi == 0 ? (const bf16_t*)(ws + WS_CQN) : (gi == 1 ? (const bf16_t*)(ws + WS_CKVB) : W_V);
                const bf16_t* B = gi == 0 ? W_UQ : (gi == 1 ? W_K : (const bf16_t*)(ws + WS_CKVB));
                const int M = gi == 0 ? R2 : (gi == 1 ? RK : 1024), N = gi == 0 ? 1536 : (gi == 1 ? 1024 : RK), K = gi == 0 ? 384 : 256;
                EpiBf16 E{gi == 0 ? (bf16_t*)(ws + WS_Q) : (gi == 1 ? (bf16_t*)(ws + WS_KN) : (bf16_t*)(ws + WS_VT)), N, gi == 0 ? QSCALE : 1.0f};
                run_gemm(L, A, B, M, N, K, E, wave);
            }
        } SEAM(10); }
#ifdef TIME_PHASE
        if (TIME_PHASE == 10) t_b = __builtin_amdgcn_s_memrealtime();
#endif
#ifdef TIME_PHASE
        if (TIME_PHASE == 11) t_a = __builtin_amdgcn_s_memrealtime();
#endif
        if (IN(11)) { p11_phase(a, L, wave); SEAM(11); }
#ifdef TIME_PHASE
        if (TIME_PHASE == 11) t_b = __builtin_amdgcn_s_memrealtime();
#endif
#ifdef TIME_PHASE
        if (TIME_PHASE == 12) t_a = __builtin_amdgcn_s_memrealtime();
#endif
        if (IN(12)) { { TIDS bf16_t* un = (bf16_t*)(ws + WS_Z); for (int row = gw; row < R2; row += 2 * NGW) { const int r1 = row + NGW; if (r1 < R2) norm_row2_bf16(hrow(rm, row), hrow(rm, r1), a.in[I_MIXN], un + (size_t)row * D, un + (size_t)r1 * D, lane); else norm_row_bf16(hrow(rm, row), a.in[I_MIXN], un + (size_t)row * D, lane); } } SEAM(12); }
#ifdef TIME_PHASE
        if (TIME_PHASE == 12) t_b = __builtin_amdgcn_s_memrealtime();
#endif
#ifdef TIME_PHASE
        if (TIME_PHASE == 13) t_a = __builtin_amdgcn_s_memrealtime();
#endif
        if (IN(13)) { { EpiGate E{(bf16_t*)(ws + WS_G), a.in[I_GBIAS]}; run_gemm(L, (const bf16_t*)(ws + WS_Z), W_IN + (size_t)5888 * 1024, R2, 2048, 1024, E, wave); } SEAM(13); }
#ifdef TIME_PHASE
        if (TIME_PHASE == 13) t_b = __builtin_amdgcn_s_memrealtime();
#endif
#ifdef TIME_PHASE
        if (TIME_PHASE == 14) t_a = __builtin_amdgcn_s_memrealtime();
#endif
        if (IN(14)) { { ElMerge T{(const bf16_t*)(ws + WS_G), (bf16_t*)(ws + WS_YS)}; tail_gemm((const bf16_t*)(ws + WS_O), W_MO, 1024, 32768, R2, T, wave); EpiMerge E{(const bf16_t*)(ws + WS_G), (bf16_t*)(ws + WS_YS)}; run_gemm(L, (const bf16_t*)(ws + WS_O), W_MO, 32768, 1024, 1024, E, wave); } SEAM(14); }
#ifdef TIME_PHASE
        if (TIME_PHASE == 14) t_b = __builtin_amdgcn_s_memrealtime();
#endif
#ifdef TIME_PHASE
        if (TIME_PHASE == 15) t_a = __builtin_amdgcn_s_memrealtime();
#endif
        if (IN(15)) { { ElResid T{rm, 1.0f, 1}; tail_gemm((const bf16_t*)(ws + WS_YS), W_MIX, 1024, 32768, R2, T, wave); EpiResid E{rm, 1.0f, 1}; run_gemm(L, (const bf16_t*)(ws + WS_YS), W_MIX, 32768, 1024, 1024, E, wave); } SEAM(15); }
#ifdef TIME_PHASE
        if (TIME_PHASE == 15) t_b = __builtin_amdgcn_s_memrealtime();
#endif
#ifdef TIME_PHASE
        if (TIME_PHASE == 16) t_a = __builtin_amdgcn_s_memrealtime();
#endif
        if (IN(16)) { { TIDS bf16_t* hn = (bf16_t*)(ws + WS_Z); for (int row = gw; row < R2; row += 2 * NGW) { const int r1 = row + NGW; if (r1 < R2) norm_row2_bf16(hrow(rm, row), hrow(rm, r1), a.in[I_F2N], hn + (size_t)row * D, hn + (size_t)r1 * D, lane); else norm_row_bf16(hrow(rm, row), a.in[I_F2N], hn + (size_t)row * D, lane); } } SEAM(16); }
#ifdef TIME_PHASE
        if (TIME_PHASE == 16) t_b = __builtin_amdgcn_s_memrealtime();
#endif
#ifdef TIME_PHASE
        if (TIME_PHASE == 17) t_a = __builtin_amdgcn_s_memrealtime();
#endif
        if (IN(17)) { { EpiSwiglu E{(bf16_t*)(ws + WS_ACT)}; run_gemm(L, (const bf16_t*)(ws + WS_Z), W_GU, R2, 2 * FFN, 1024, E, wave); } SEAM(17); }
#ifdef TIME_PHASE
        if (TIME_PHASE == 17) t_b = __builtin_amdgcn_s_memrealtime();
#endif
#ifdef TIME_PHASE
        if (TIME_PHASE == 18) t_a = __builtin_amdgcn_s_memrealtime();
#endif
        if (IN(18)) { { ElResid T{rm, 0.5f, 1}; tail_gemm((const bf16_t*)(ws + WS_ACT), W_D, FFN, 32768, R2, T, wave); EpiResid E{rm, 0.5f, 1}; run_gemm(L, (const bf16_t*)(ws + WS_ACT), W_D, 32768, 1024, FFN, E, wave); } SEAM(18); }
#ifdef TIME_PHASE
        if (TIME_PHASE == 18) t_b = __builtin_amdgcn_s_memrealtime();
#endif
#ifdef TIME_PHASE
        if (TIME_PHASE == 19) t_a = __builtin_amdgcn_s_memrealtime();
#endif
        if (IN(19)) { { TIDS
            for (int row = gw; row < R2; row += NGW) { float* hp = a.out + (size_t)row * D; f32x4 v[4]; float s = 0.f;
#pragma unroll
                for (int j = 0; j < 4; ++j) { v[j] = ((const f32x4*)hp)[lane + 64 * j]; s += v[j][0] * v[j][0] + v[j][1] * v[j][1] + v[j][2] * v[j][2] + v[j][3] * v[j][3]; }
                const float rs = rsqrtf(wave_sum(s) * (1.f / 1024.f) + EPS);
#pragma unroll
                for (int j = 0; j < 4; ++j) { const f32x4 g = ((const f32x4*)a.in[I_FINN])[lane + 64 * j]; ((f32x4*)hp)[lane + 64 * j] = v[j] * rs * g; } }
        } SEAM(19); }
#ifdef TIME_PHASE
        if (TIME_PHASE == 19) t_b = __builtin_amdgcn_s_memrealtime();
#endif
        }
    }
#ifdef TIME_PHASE
    if (blockIdx.x == 0 && threadIdx.x == 0) a.out[0] = (float)(t_b - t_a) * 0.01f;
#endif
    __builtin_amdgcn_fence(__ATOMIC_RELEASE, "agent");
}

#ifndef N_LAUNCH_MODE
#define N_LAUNCH_MODE 1
#endif
extern "C" void kernel_launch(void* const* d_in, const int* in_sizes, int n_in, void* d_out, int out_size, void* d_ws, size_t ws_size, hipStream_t stream) {
    static int grid = 0;
    if (grid == 0) {
        if (n_in != 30 || ws_size < WS_END) { fprintf(stderr, "kernel_launch: unexpected n_in %d / ws_size %zu (need %zu)\n", n_in, ws_size, (size_t)WS_END); grid = -1; return; }
        int dev = 0, cus = 0, per_cu = 0;
        hipGetDevice(&dev); hipDeviceGetAttribute(&cus, hipDeviceAttributeMultiprocessorCount, dev);
        if (hipFuncSetAttribute((const void*)fwd_megakernel, hipFuncAttributeMaxDynamicSharedMemorySize, LDS_BYTES) != hipSuccess) { fprintf(stderr, "kernel_launch: hipFuncSetAttribute failed\n"); grid = -1; return; }
        if (hipOccupancyMaxActiveBlocksPerMultiprocessor(&per_cu, (const void*)fwd_megakernel, 512, LDS_BYTES) != hipSuccess || per_cu < 1) per_cu = 1;
        (void)hipGetLastError();
        grid = cus * 1;
        if (grid <= 0) grid = 256;
    }
    if (grid < 0) return;
    Args a{};
    for (int i = 0; i < 30; ++i) a.in[i] = (const float*)d_in[i];
    a.out = (float*)d_out; a.ws = (unsigned char*)d_ws;
#if N_LAUNCH_MODE == 1
    a.ph_lo = 0; a.ph_hi = NPHASE;
    if (hipMemsetAsync((unsigned char*)d_ws + WS_BAR, 0, 256, stream) != hipSuccess) { fprintf(stderr, "memset failed\n"); return; }
    void* args[] = {&a};
    hipError_t e = hipLaunchCooperativeKernel((const void*)fwd_megakernel, dim3(grid), dim3(512), args, LDS_BYTES, stream);
    if (e != hipSuccess) fprintf(stderr, "cooperative launch failed: %s (grid %d)\n", hipGetErrorString(e), grid);
#else
    for (int ph = 0; ph < NPHASE; ++ph) { a.ph_lo = ph; a.ph_hi = ph + 1; hipLaunchKernelGGL(fwd_megakernel, dim3(grid), dim3(512), LDS_BYTES, stream, a); }
#endif
}
```

```cpp
#include <hip/hip_runtime.h>
#include <hip/hip_cooperative_groups.h>
#include <cstdio>
#include <cstdint>
namespace cg = cooperative_groups;
namespace pg8 {
#define PG8_LAS __attribute__((address_space(3)))
typedef unsigned short bf16_t;
typedef short bf16x8 __attribute__((ext_vector_type(8)));
typedef float f32x4 __attribute__((ext_vector_type(4)));
typedef unsigned u32x4 __attribute__((ext_vector_type(4)));
constexpr int BM = 256, BK = 64, HALF = 128, HTB = HALF * BK * 2  , STAGE_BYTES = 8 * HTB, NXCD = 8, WGM = 8;

__host__ __device__ __forceinline__ int lds_byte(int r, int c) { const int st = (r >> 4) * 2 + (c >> 5), rr = r & 15, cc = c & 31, ob = rr * 64 + cc * 2; return st * 1024 + (ob ^ (((ob >> 9) & 1) << 5)); }
__host__ __device__ __forceinline__ void stage_rc(int b, int& R, int& C) { const int st = b / 1024, sb = b % 1024, swz = sb ^ (((sb >> 9) & 1) << 5); R = (st >> 1) * 16 + swz / 64; C = (st & 1) * 32 + (swz % 64) / 2; }
__host__ __device__ __forceinline__ int perm32(int rho) { const int n = rho >> 4, i = rho & 15; return 8 * (i >> 2) + 4 * n + (i & 3); }

struct Unit { int pm, pn; };
struct Gemm { const bf16_t* A; const bf16_t* Bt; int M, N, K; };

struct StaticOrder {
    int nM, nN, nwg, G, c;
    __host__ __device__ void init(int M, int N, int G_, int c_) { nM = M / BM; nN = N / BM; nwg = nM * nN; G = G_; c = c_; }
    __host__ __device__ bool next(int i, Unit& u) const {
        const long L = (long)i * G + c; if (L >= nwg) return false;
        int wgid = (int)L; { const int q = nwg / NXCD, r = nwg % NXCD, xcd = wgid % NXCD, off = wgid / NXCD; wgid = (xcd < r ? xcd * (q + 1) : r * (q + 1) + (xcd - r) * q) + off; }
        const int nig = WGM * nN, gid = wgid / nig, fm = gid * WGM, gsz = (nM - fm) < WGM ? (nM - fm) : WGM;
        u.pm = fm + ((wgid % nig) % gsz); u.pn = (wgid % nig) / gsz; return true;
    }
    __device__ __forceinline__ void a_ready(const Unit&) const {}
    __device__ __forceinline__ void done(const Unit&) const {}
};
template <class Epi, class Sched, bool ALIGN_EPI = false, bool SP2 = false>
__device__ __forceinline__ void gemm_phase(PG8_LAS unsigned char* lds, const Gemm g, const Sched& S, const Epi& E, const int wid) {
    const int lane = (int)(__builtin_amdgcn_mbcnt_hi(~0u, __builtin_amdgcn_mbcnt_lo(~0u, 0u)) & 63u), tid = wid * 64 + lane, wr = wid >> 2, wc = wid & 3, fr = lane & 15, fq = lane >> 4;
    const int K = g.K, nt = K / BK;
    unsigned voffA[2], voffB[2];
#pragma unroll
    for (int i = 0; i < 2; ++i) { int R, C; stage_rc(tid * 16 + i * 8192, R, C); const int Rb = Epi::PERM ? ((R & ~31) + perm32(R & 31)) : R;
        voffA[i] = (unsigned)(R * K + C) * 2u; voffB[i] = (unsigned)(Rb * K + C) * 2u; }
    const size_t kstep = (size_t)(BK * 2);
    const size_t hstep = (size_t)HALF * K * 2;
    const size_t tstep = 2 * hstep;
    const unsigned ldsw = (unsigned)wid * 1024u;
    const int aoff = lds_byte(wr * 64 + fr, fq * 8), boff = lds_byte(wc * 32 + fr, fq * 8);
#define PG8_SA(b, h) (((b) * 2 + (h)) * HTB)
#define PG8_SB(b, h) ((4 + (b) * 2 + (h)) * HTB)
#define PG8_STAGE(bufoff, gbase, voff) do { _Pragma("unroll") for (int _i = 0; _i < 2; ++_i) \
        __builtin_amdgcn_global_load_lds((const unsigned*)((const char*)(gbase) + (voff)[_i]), (PG8_LAS unsigned*)(lds + (bufoff) + ldsw + _i * 8192), 16, 0, 0); } while (0)
#define PG8_LDA(dst, b, h) do { _Pragma("unroll") for (int m = 0; m < 4; ++m) _Pragma("unroll") for (int k = 0; k < 2; ++k) dst[m][k] = *(const PG8_LAS bf16x8*)(lds + PG8_SA(b, h) + aoff + m * 2048 + k * 1024); } while (0)
#define PG8_LDB(dst, b, h) do { _Pragma("unroll") for (int n = 0; n < 2; ++n) _Pragma("unroll") for (int k = 0; k < 2; ++k) dst[n][k] = *(const PG8_LAS bf16x8*)(lds + PG8_SB(b, h) + boff + n * 2048 + k * 1024); } while (0)
#define PG8_MMA(ai, bj, At, Bt) do { __builtin_amdgcn_s_setprio(1); _Pragma("unroll") for (int m = 0; m < 4; ++m) _Pragma("unroll") for (int n = 0; n < 2; ++n) _Pragma("unroll") for (int k = 0; k < 2; ++k) \
        acc[ai][bj][m][n] = __builtin_amdgcn_mfma_f32_16x16x32_bf16(Bt[n][k], At[m][k], acc[ai][bj][m][n], 0, 0, 0); __builtin_amdgcn_s_setprio(0); } while (0)
#define PG8_WAIT_V(n) asm volatile("s_waitcnt vmcnt(" #n ")" ::: "memory")
#define PG8_WAIT_L(n) asm volatile("s_waitcnt lgkmcnt(" #n ")" ::: "memory")
#define PG8_BAR __builtin_amdgcn_s_barrier()
#define PG8_SCHED __builtin_amdgcn_sched_barrier(0)
    Unit cur, nxt; int ui = 0;
    if (!S.next(0, cur)) return;
    f32x4 acc[2][2][4][2];
#pragma unroll
    for (int a = 0; a < 2; ++a)
#pragma unroll
        for (int b = 0; b < 2; ++b)
#pragma unroll
            for (int m = 0; m < 4; ++m)
#pragma unroll
                for (int n = 0; n < 2; ++n) acc[a][b][m][n] = (f32x4){0.f, 0.f, 0.f, 0.f};
    bf16x8 At[4][2], B0[2][2], B1[2][2];
    const char* cA = (const char*)g.A + (size_t)cur.pm * tstep; const char* cB = (const char*)g.Bt + (size_t)cur.pn * tstep;
    S.a_ready(cur);
    if constexpr (SP2) {
        PG8_STAGE(PG8_SB(0, 0), cB, voffB); PG8_STAGE(PG8_SB(0, 1), cB + hstep, voffB); PG8_STAGE(PG8_SA(0, 0), cA, voffA); PG8_STAGE(PG8_SA(0, 1), cA + hstep, voffA);
        if (wr == 1) PG8_BAR;
        PG8_WAIT_V(2); PG8_BAR;
        PG8_STAGE(PG8_SB(1, 0), cB + kstep, voffB); PG8_STAGE(PG8_SA(1, 0), cA + kstep, voffA); PG8_STAGE(PG8_SB(1, 1), cB + hstep + kstep, voffB);
        PG8_WAIT_V(6); PG8_BAR;
    } else {
        PG8_STAGE(PG8_SB(0, 0), cB, voffB); PG8_STAGE(PG8_SA(0, 0), cA, voffA); PG8_STAGE(PG8_SB(0, 1), cB + hstep, voffB); PG8_STAGE(PG8_SA(0, 1), cA + hstep, voffA);
        if (wr == 1) PG8_BAR;
        PG8_WAIT_V(4); PG8_BAR;
        PG8_STAGE(PG8_SB(1, 0), cB + kstep, voffB); PG8_STAGE(PG8_SA(1, 0), cA + kstep, voffA); PG8_STAGE(PG8_SB(1, 1), cB + hstep + kstep, voffB);
        PG8_WAIT_V(6); PG8_BAR;
    }
    for (;;) {
        const bool has_next = S.next(ui + 1, nxt);
        const char* nA = has_next ? (const char*)g.A + (size_t)nxt.pm * tstep : cA; const char* nB = has_next ? (const char*)g.Bt + (size_t)nxt.pn * tstep : cB;
        for (int t = 0; t < nt; t += 2) {
            const bool last = (t == nt - 2);
            const char* a1 = cA + (size_t)(t + 1) * kstep;
            const char* a2 = last ? nA : cA + (size_t)(t + 2) * kstep; const char* b2 = last ? nB : cB + (size_t)(t + 2) * kstep;
            const char* a3 = a2 + kstep; const char* b3 = b2 + kstep;
            if (last && has_next) S.a_ready(nxt);
            if constexpr (SP2) {
            PG8_LDB(B0, 0, 0); PG8_LDB(B1, 0, 1); PG8_SCHED; PG8_LDA(At, 0, 0); PG8_STAGE(PG8_SA(1, 1), a1 + hstep, voffA);
            PG8_WAIT_V(8); PG8_WAIT_L(0); PG8_BAR; PG8_MMA(0, 0, At, B0); PG8_MMA(0, 1, At, B1); PG8_BAR; PG8_SCHED;
            PG8_LDA(At, 0, 1); PG8_STAGE(PG8_SB(0, 0), b2, voffB); PG8_STAGE(PG8_SB(0, 1), b2 + hstep, voffB); PG8_STAGE(PG8_SA(0, 0), a2, voffA);
            PG8_WAIT_V(8); PG8_WAIT_L(0); PG8_BAR; PG8_MMA(1, 0, At, B0); PG8_MMA(1, 1, At, B1); PG8_BAR; PG8_SCHED;
            PG8_LDB(B0, 1, 0); PG8_LDB(B1, 1, 1); PG8_SCHED; PG8_LDA(At, 1, 0); PG8_STAGE(PG8_SA(0, 1), a2 + hstep, voffA);
            PG8_WAIT_V(8); PG8_WAIT_L(0); PG8_BAR; PG8_MMA(0, 0, At, B0); PG8_MMA(0, 1, At, B1); PG8_BAR; PG8_SCHED;
            PG8_LDA(At, 1, 1); PG8_STAGE(PG8_SB(1, 0), b3, voffB); PG8_STAGE(PG8_SB(1, 1), b3 + hstep, voffB); PG8_STAGE(PG8_SA(1, 0), a3, voffA);
            PG8_WAIT_V(8); PG8_WAIT_L(0); PG8_BAR; PG8_MMA(1, 0, At, B0); PG8_MMA(1, 1, At, B1); PG8_BAR; PG8_SCHED;
            } else {
            PG8_LDB(B0, 0, 0); PG8_SCHED; PG8_LDA(At, 0, 0); PG8_STAGE(PG8_SA(1, 1), a1 + hstep, voffA);
            PG8_WAIT_L(8); PG8_BAR; PG8_WAIT_L(0); PG8_MMA(0, 0, At, B0); PG8_BAR; PG8_SCHED;
            PG8_LDB(B1, 0, 1); PG8_STAGE(PG8_SB(0, 0), b2, voffB);
            PG8_BAR; PG8_WAIT_L(0); PG8_MMA(0, 1, At, B1); PG8_BAR;
            PG8_LDA(At, 0, 1); PG8_STAGE(PG8_SA(0, 0), a2, voffA);
            PG8_BAR; PG8_WAIT_L(0); PG8_MMA(1, 0, At, B0); PG8_BAR; PG8_SCHED;
            PG8_STAGE(PG8_SB(0, 1), b2 + hstep, voffB);
            PG8_WAIT_V(6); PG8_BAR; PG8_MMA(1, 1, At, B1); PG8_BAR;
            PG8_LDB(B0, 1, 0); PG8_SCHED; PG8_LDA(At, 1, 0); PG8_STAGE(PG8_SA(0, 1), a2 + hstep, voffA);
            PG8_WAIT_L(8); PG8_BAR; PG8_WAIT_L(0); PG8_MMA(0, 0, At, B0); PG8_BAR; PG8_SCHED;
            PG8_LDB(B1, 1, 1); PG8_STAGE(PG8_SB(1, 0), b3, voffB);
            PG8_BAR; PG8_WAIT_L(0); PG8_MMA(0, 1, At, B1); PG8_BAR;
            PG8_LDA(At, 1, 1); PG8_STAGE(PG8_SA(1, 0), a3, voffA);
            PG8_BAR; PG8_WAIT_L(0); PG8_MMA(1, 0, At, B0); PG8_BAR; PG8_SCHED;
            PG8_STAGE(PG8_SB(1, 1), b3 + hstep, voffB);
            PG8_WAIT_V(6); PG8_BAR; PG8_MMA(1, 1, At, B1); PG8_BAR;
            }
        }
        if constexpr (ALIGN_EPI) { if (wr == 0) PG8_BAR; }
        if constexpr (!Epi::AFTER_DRAIN) { E(acc, cur, wr, wc, fr, fq); S.done(cur); }
        if (!has_next) break;
#pragma unroll
        for (int a = 0; a < 2; ++a)
#pragma unroll
            for (int b = 0; b < 2; ++b)
#pragma unroll
                for (int m = 0; m < 4; ++m)
#pragma unroll
                    for (int n = 0; n < 2; ++n) acc[a][b][m][n] = (f32x4){0.f, 0.f, 0.f, 0.f};
        cur = nxt; cA = nA; cB = nB; ++ui;
        if constexpr (ALIGN_EPI) { if (wr == 1) PG8_BAR; }
    }
    PG8_WAIT_V(0);
    if constexpr (!ALIGN_EPI) { if (wr == 0) PG8_BAR; }
    PG8_BAR;
    if constexpr (Epi::AFTER_DRAIN) { E.fused(acc, cur, wr, wc, fr, fq, lds, wid, lane); S.done(cur); }
#undef PG8_SA
#undef PG8_SB
#undef PG8_STAGE
#undef PG8_LDA
#undef PG8_LDB
#undef PG8_MMA
#undef PG8_WAIT_V
#undef PG8_WAIT_L
#undef PG8_BAR
#undef PG8_SCHED
}
}
using namespace pg8;
#define LAS __attribute__((address_space(3)))
typedef short v4i16_t __attribute__((ext_vector_type(4)));
typedef unsigned u32x2 __attribute__((ext_vector_type(2)));
typedef float f32x2 __attribute__((ext_vector_type(2)));

constexpr int D = 1024, FFN = 2816;
constexpr int R_S0 = 32768;
constexpr int R_M0 = 33280;
constexpr int R_ACT = 33296;
constexpr int R1 = 33536;
constexpr int R2 = 33280;
constexpr int RK = 49920;
constexpr int R_C0 = 33536;
constexpr int NCHUNK = 146;
constexpr float EPS = 1e-6f;
constexpr float QSCALE = 0.14724448f;

constexpr size_t MiB = 1048576;
constexpr size_t WS_W_IN = 0, WS_W_GU = 16252928, WS_W_D = 27787264, WS_W_SO = 33554432, WS_W_UQ = 37748736, WS_W_K = 38928384, WS_W_V = 39452672,
                 WS_W_MO = 39976960, WS_W_MIX = 42074112, WS_ROPE = 44171264, WS_HMETA = 46270464, WS_KRB = 47319040, WS_TOT = 50513920, WS_BAR = 50540544;
constexpr size_t WS_Z = 49 * MiB, WS_X = 180 * MiB, WS_U = 376 * MiB + MiB / 2, WS_MISC = 442 * MiB, WS_HALO = WS_MISC + (size_t)R1 * 768 * 2;
constexpr size_t WS_DT = WS_U, WS_ACS = WS_U + 4292608, WS_CQN = WS_U + 8585216, WS_CKVB = WS_U + 34144256, WS_S = WS_U + 57 * MiB;
constexpr size_t WS_YS = 447 * MiB, WS_Q = WS_Z, WS_KN = WS_X, WS_VT = WS_X + 102236160, WS_O = WS_U, WS_G = WS_X, WS_ACT = WS_X;
constexpr size_t WS_END = 512 * MiB;
static_assert(WS_S + (size_t)NCHUNK * 32 * 8192 * 2 <= WS_END && WS_O + (size_t)R2 * 1024 * 2 <= WS_YS && WS_YS + (size_t)R2 * 1024 * 2 <= WS_END, "ws map 4");
static_assert(WS_END <= 512 * MiB, "ws map");
static_assert(WS_CKVB + (size_t)RK * 256 * 2 <= WS_S, "ws map 2");
static_assert(WS_HALO + 514 * 3 * 3072 * 2 <= 512 * MiB, "ws map 3");

constexpr size_t OUT_YP = 0, OUT_YS = 33554432, OUT_CKVP = 34078720, OUT_KRP = 42475520, OUT_SSMP = 43525120, OUT_CONVP = 44049408,
                 OUT_CKVS = 44067840, OUT_KRS = 44198912, OUT_SSMS = 44215296, OUT_CONVS = 48409600;

enum { I_XP = 0, I_XS, I_CCKV, I_CKR, I_SSSM, I_SCONV, I_META, I_F1N, I_F1GU, I_F1D, I_MIXN, I_WIN, I_GBIAS, I_CONVW, I_CONVB, I_DTB, I_ALOG, I_SSMD,
       I_SSMN, I_WSO, I_QN, I_WUQ, I_KVN, I_WUKV, I_WMO, I_WMIX, I_F2N, I_F2GU, I_F2D, I_FINN };

struct Args { const float* in[30]; float* out; unsigned char* ws; int ph_lo, ph_hi; };

__device__ __forceinline__ unsigned f2bf(float f) { unsigned u = __builtin_bit_cast(unsigned, f); return (u + 0x7fffu + ((u >> 16) & 1u)) >> 16; }
typedef float f32x2_t __attribute__((ext_vector_type(2))); typedef __bf16 bf16x2_t __attribute__((ext_vector_type(2)));
__device__ __forceinline__ unsigned cvtpk(float lo, float hi) { f32x2_t v = {lo, hi}; bf16x2_t b = __builtin_convertvector(v, bf16x2_t); return __builtin_bit_cast(unsigned, b); }
__device__ __forceinline__ float bflo(unsigned u) { return __builtin_bit_cast(float, u << 16); }
__device__ __forceinline__ float bfhi(unsigned u) { return __builtin_bit_cast(float, u & 0xffff0000u); }
__device__ __forceinline__ float bf2f(bf16_t b) { return __builtin_bit_cast(float, (unsigned)b << 16); }
__device__ __forceinline__ float wave_sum(float v) {
#pragma unroll
    for (int o = 1; o < 64; o <<= 1) v += __shfl_xor(v, o);
    return v;
}
__device__ __forceinline__ float silu_f(float x) { return x * __builtin_amdgcn_rcpf(1.f + __expf(-x)); }
__device__ __forceinline__ float sigmoid_f(float x) { return __builtin_amdgcn_rcpf(1.f + __expf(-x)); }
__device__ __forceinline__ float softplus_f(float x) {
    const float e = __expf(x);
    const float sp = e < 0.02f ? e * (1.f - e * (0.5f - e * (0.33333334f - 0.25f * e))) : __logf(1.f + e);
    return x > 15.f ? x : sp;
}
__device__ __forceinline__ int pos_idx(int row) {
    if (row < R_S0) return (row & 16383) + 16;
    if (row < R_M0) return 1024 + ((row - R_S0) & 31) + 16;
    return row - R_M0;
}
__device__ __forceinline__ void chunk_info(int ci, int& row0, int& ntok) {
    if (ci < 130) { const int b = ci / 65, k = ci - b * 65; if (k == 0) { row0 = R_M0; ntok = 16; } else { row0 = b * 16384 + 256 * (k - 1); ntok = 256; } }
    else { row0 = R_S0 + 32 * (ci - 130); ntok = 32; }
}
__device__ __forceinline__ v4i16_t ldtr(const LAS bf16_t* p) { return __builtin_amdgcn_ds_read_tr16_b64_v4i16((LAS v4i16_t*)p); }
__device__ __forceinline__ bf16x8 cat8(v4i16_t a, v4i16_t b) { return __builtin_shufflevector(a, b, 0, 1, 2, 3, 4, 5, 6, 7); }
__device__ __forceinline__ bf16x8 cat8u(u32x2 a, u32x2 b) { u32x4 t = {a.x, a.y, b.x, b.y}; return __builtin_bit_cast(bf16x8, t); }
#define MFMA16(a, b, c) __builtin_amdgcn_mfma_f32_16x16x32_bf16((a), (b), (c), 0, 0, 0)

struct EpiSwiglu {
    static constexpr bool PERM = true, AFTER_DRAIN = false; bf16_t* O;
    __device__ __forceinline__ void operator()(const f32x4 (&acc)[2][2][4][2], const Unit& u, int wr, int wc, int fr, int fq) const {
        const int row0 = u.pm * 256 + wr * 64 + fr, col0 = u.pn * 128 + wc * 32 + 8 * fq;
#pragma unroll
        for (int ai = 0; ai < 2; ++ai)
#pragma unroll
            for (int m = 0; m < 4; ++m) {
                const f32x4 g0 = acc[ai][0][m][0], g1 = acc[ai][0][m][1], u0 = acc[ai][1][m][0], u1 = acc[ai][1][m][1];
                u32x4 w; w.x = cvtpk(silu_f(g0[0]) * u0[0], silu_f(g0[1]) * u0[1]); w.y = cvtpk(silu_f(g0[2]) * u0[2], silu_f(g0[3]) * u0[3]);
                w.z = cvtpk(silu_f(g1[0]) * u1[0], silu_f(g1[1]) * u1[1]); w.w = cvtpk(silu_f(g1[2]) * u1[2], silu_f(g1[3]) * u1[3]);
                *(u32x4*)(O + (size_t)(row0 + ai * 128 + m * 16) * FFN + col0) = w;
            }
    }
};
struct RowMap { float* out; float* hmeta; const float* xp; const float* xs; const float* meta; };
__device__ __forceinline__ float* hrow(const RowMap& a, int row) { return row < R2 ? a.out + (size_t)row * D : a.hmeta + (size_t)(row - R2) * D; }
__device__ __forceinline__ const float* xrow(const RowMap& a, int row) {
    if (row < R_S0) return a.xp + (size_t)row * D;
    if (row < R_M0) return a.xs + (size_t)(row - R_S0) * D;
    if (row < R_ACT) return a.meta + (size_t)(row - R_M0) * D;
    return nullptr;
}
struct EpiResid {
    static constexpr bool PERM = true, AFTER_DRAIN = false; RowMap a; float s; int mode;
    __device__ __forceinline__ void operator()(const f32x4 (&acc)[2][2][4][2], const Unit& u, int wr, int wc, int fr, int fq) const {
        const int row0 = u.pm * 256 + wr * 64 + fr, col0 = u.pn * 256 + wc * 32 + 8 * fq;
#pragma unroll
        for (int ai = 0; ai < 2; ++ai)
#pragma unroll
            for (int m = 0; m < 4; ++m) {
                const int row = row0 + ai * 128 + m * 16; float* hp = hrow(a, row); const float* bp = mode ? hp : xrow(a, row);
#pragma unroll
                for (int bj = 0; bj < 2; ++bj) {
                    const int c = col0 + bj * 128; f32x4 b0 = {0.f, 0.f, 0.f, 0.f}, b1 = b0;
                    if (bp) { b0 = *(const f32x4*)(bp + c); b1 = *(const f32x4*)(bp + c + 4); }
                    *(f32x4*)(hp + c) = b0 + acc[ai][bj][m][0] * s; *(f32x4*)(hp + c + 4) = b1 + acc[ai][bj][m][1] * s;
                }
            }
    }
};
struct EpiProj {
    static constexpr bool PERM = true, AFTER_DRAIN = false; bf16_t *Z, *X, *MISC, *HALO; float* out;
    __device__ __forceinline__ void operator()(const f32x4 (&acc)[2][2][4][2], const Unit& u, int wr, int wc, int fr, int fq) const {
        const int row0 = u.pm * 256 + wr * 64 + fr; const int pn = u.pn;
#pragma unroll
        for (int ai = 0; ai < 2; ++ai)
#pragma unroll
            for (int m = 0; m < 4; ++m) {
                const int row = row0 + ai * 128 + m * 16;
#pragma unroll
                for (int bj = 0; bj < 2; ++bj) {
                    const f32x4 v0 = acc[ai][bj][m][0], v1 = acc[ai][bj][m][1];
                    u32x4 w; w.x = cvtpk(v0[0], v0[1]); w.y = cvtpk(v0[2], v0[3]); w.z = cvtpk(v1[0], v1[1]); w.w = cvtpk(v1[2], v1[3]);
                    const int ct = bj * 128 + wc * 32 + 8 * fq;
                    if (pn < 8) { *(u32x4*)(Z + (size_t)row * 2048 + pn * 256 + ct) = w; }
                    else if (pn < 20) {
                        const int cx = (pn - 8) * 256 + ct;
                        *(u32x4*)(X + (size_t)row * 3072 + cx) = w;
                        if (row < R_S0) {
                            const int r6 = row & 63;
                            if (r6 >= 61) { const int T = (row >> 6) + 1; if (T & 255) *(u32x4*)(HALO + ((size_t)T * 3 + (r6 - 61)) * 3072 + cx) = w; }
                            const int t = row & 16383;
                            if (t >= 16381) { float* o = out + OUT_CONVP + ((size_t)(row >> 14) * 3 + (t - 16381)) * 3072 + cx; *(f32x4*)o = v0; *(f32x4*)(o + 4) = v1; }
                        } else if (row < R_M0) {
                            const int t = (row - R_S0) & 31, db = (row - R_S0) >> 5;
                            if (t >= 29) { float* o = out + OUT_CONVS + ((size_t)db * 3 + (t - 29)) * 3072 + cx; *(f32x4*)o = v0; *(f32x4*)(o + 4) = v1; }
                        } else if (row >= R_M0 + 13 && row < R_ACT) {
                            const int sl = row - R_M0 - 13;
                            *(u32x4*)(HALO + ((size_t)0 * 3 + sl) * 3072 + cx) = w; *(u32x4*)(HALO + ((size_t)256 * 3 + sl) * 3072 + cx) = w;
                        }
                    } else { *(u32x4*)(MISC + (size_t)row * 768 + (pn - 20) * 256 + ct) = w; }
                }
            }
    }
};
struct EpiBf16 {
    static constexpr bool PERM = true, AFTER_DRAIN = false; bf16_t* O; int ldc; float sc;
    __device__ __forceinline__ void operator()(const f32x4 (&acc)[2][2][4][2], const Unit& u, int wr, int wc, int fr, int fq) const {
        const int row0 = u.pm * 256 + wr * 64 + fr, col0 = u.pn * 256 + wc * 32 + 8 * fq;
#pragma unroll
        for (int ai = 0; ai < 2; ++ai)
#pragma unroll
            for (int m = 0; m < 4; ++m)
#pragma unroll
                for (int bj = 0; bj < 2; ++bj) {
                    const f32x4 v0 = acc[ai][bj][m][0] * sc, v1 = acc[ai][bj][m][1] * sc;
                    u32x4 w; w.x = cvtpk(v0[0], v0[1]); w.y = cvtpk(v0[2], v0[3]); w.z = cvtpk(v1[0], v1[1]); w.w = cvtpk(v1[2], v1[3]);
                    *(u32x4*)(O + (size_t)(row0 + ai * 128 + m * 16) * ldc + col0 + bj * 128) = w;
                }
    }
};
struct EpiGate {
    static constexpr bool PERM = true, AFTER_DRAIN = false; bf16_t* G; const float* bias;
    __device__ __forceinline__ void operator()(const f32x4 (&acc)[2][2][4][2], const Unit& u, int wr, int wc, int fr, int fq) const {
        const int row0 = u.pm * 256 + wr * 64 + fr, col0 = u.pn * 256 + wc * 32 + 8 * fq;
#pragma unroll
        for (int bj = 0; bj < 2; ++bj) {
            const int c = col0 + bj * 128; const f32x4 b0 = *(const f32x4*)(bias + c), b1 = *(const f32x4*)(bias + c + 4);
#pragma unroll
            for (int ai = 0; ai < 2; ++ai)
#pragma unroll
                for (int m = 0; m < 4; ++m) {
                    const f32x4 v0 = acc[ai][bj][m][0] + b0, v1 = acc[ai][bj][m][1] + b1;
                    u32x4 w; w.x = cvtpk(sigmoid_f(v0[0]), sigmoid_f(v0[1])); w.y = cvtpk(sigmoid_f(v0[2]), sigmoid_f(v0[3]));
                    w.z = cvtpk(sigmoid_f(v1[0]), sigmoid_f(v1[1])); w.w = cvtpk(sigmoid_f(v1[2]), sigmoid_f(v1[3]));
                    *(u32x4*)(G + (size_t)(row0 + ai * 128 + m * 16) * 2048 + c) = w;
                }
        }
    }
};
struct EpiMerge {
    static constexpr bool PERM = true, AFTER_DRAIN = false; const bf16_t* G; bf16_t* YS;
    __device__ __forceinline__ void operator()(const f32x4 (&acc)[2][2][4][2], const Unit& u, int wr, int wc, int fr, int fq) const {
        const int row0 = u.pm * 256 + wr * 64 + fr, col0 = u.pn * 256 + wc * 32 + 8 * fq;
#pragma unroll
        for (int ai = 0; ai < 2; ++ai)
#pragma unroll
            for (int m = 0; m < 4; ++m)
#pragma unroll
                for (int bj = 0; bj < 2; ++bj) {
                    const int row = row0 + ai * 128 + m * 16, c = col0 + bj * 128;
                    const u32x4 gs = *(const u32x4*)(G + (size_t)row * 2048 + c), gm = *(const u32x4*)(G + (size_t)row * 2048 + 1024 + c), ys = *(const u32x4*)(YS + (size_t)row * 1024 + c);
                    const f32x4 v0 = acc[ai][bj][m][0], v1 = acc[ai][bj][m][1];
                    u32x4 w;
                    w.x = cvtpk(bflo(gs.x) * bflo(ys.x) + bflo(gm.x) * v0[0], bfhi(gs.x) * bfhi(ys.x) + bfhi(gm.x) * v0[1]);
                    w.y = cvtpk(bflo(gs.y) * bflo(ys.y) + bflo(gm.y) * v0[2], bfhi(gs.y) * bfhi(ys.y) + bfhi(gm.y) * v0[3]);
                    w.z = cvtpk(bflo(gs.z) * bflo(ys.z) + bflo(gm.z) * v1[0], bfhi(gs.z) * bfhi(ys.z) + bfhi(gm.z) * v1[1]);
                    w.w = cvtpk(bflo(gs.w) * bflo(ys.w) + bflo(gm.w) * v1[2], bfhi(gs.w) * bfhi(ys.w) + bfhi(gm.w) * v1[3]);
                    *(u32x4*)(YS + (size_t)row * 1024 + c) = w;
                }
    }
};
__device__ __forceinline__ int lane_id() { return (int)(__builtin_amdgcn_mbcnt_hi(~0u, __builtin_amdgcn_mbcnt_lo(~0u, 0u)) & 63u); }
template <class Epi> __device__ __forceinline__ void run_gemm(LAS unsigned char* lds, const bf16_t* A, const bf16_t* Bt, int M, int N, int K, const Epi& E, int wave) {
    Gemm g{A, Bt, M, N, K}; StaticOrder S; S.init(M, N, (int)gridDim.x, (int)blockIdx.x);
    gemm_phase<Epi, StaticOrder, false, true>(lds, g, S, E, wave);
    __syncthreads();
}

struct ElResid { RowMap a; float s; int mode; __device__ __forceinline__ void operator()(int row, int col, float v) const {
    float* hp = hrow(a, row) + col; float b = 0.f; if (mode) b = *hp; else { const float* xp = xrow(a, row); if (xp) b = xp[col]; } *hp = b + s * v; } };
struct ElBf16 { bf16_t* O; int ldc; __device__ __forceinline__ void operator()(int row, int col, float v) const { O[(size_t)row * ldc + col] = (bf16_t)(cvtpk(v, 0.f) & 0xffffu); } };
struct ElMerge { const bf16_t* G; bf16_t* YS; __device__ __forceinline__ void operator()(int row, int col, float v) const {
    const float gs = bf2f(G[(size_t)row * 2048 + col]), gm = bf2f(G[(size_t)row * 2048 + 1024 + col]); bf16_t* p = YS + (size_t)row * 1024 + col; *p = (bf16_t)(cvtpk(gs * bf2f(*p) + gm * v, 0.f) & 0xffffu); } };
template <class El> __device__ __forceinline__ void tail_gemm(const bf16_t* A, const bf16_t* Bt, int K, int row_begin, int row_end, const El& E, int wave) {
    const int lane = lane_id(), li = lane & 15, quad = lane >> 4; const int gw = blockIdx.x * 8 + wave, NGW = gridDim.x * 8;
    const int total = ((row_end - row_begin) >> 4) * 64;
    for (int blk = gw; blk < total; blk += NGW) {
        const int rb = blk >> 6, cb = blk & 63;
        const bf16_t* ap = A + (size_t)(row_begin + 16 * rb + li) * K + 8 * quad; const bf16_t* bp = Bt + (size_t)(16 * cb + li) * K + 8 * quad;
        f32x4 acc = {0.f, 0.f, 0.f, 0.f};
        for (int k = 0; k < K; k += 256) { bf16x8 af[8], bf[8];
#pragma unroll
            for (int e = 0; e < 8; ++e) { af[e] = *(const bf16x8*)(ap + k + 32 * e); bf[e] = *(const bf16x8*)(bp + k + 32 * e); }
#pragma unroll
            for (int e = 0; e < 8; ++e) acc = MFMA16(af[e], bf[e], acc); }
#pragma unroll
        for (int j = 0; j < 4; ++j) E(row_begin + 16 * rb + 4 * quad + j, 16 * cb + li, acc[j]);
    }
}

__device__ __forceinline__ int srccol(int mapid, int n) {
    switch (mapid) {
        case 0: return n;
        case 1: { const int pn = n >> 8, bj = (n >> 7) & 1, i = n & 127; return (bj ? FFN : 0) + pn * 128 + i; }
        case 2: return n < 5824 ? n : (n < 5888 ? -1 : n - 64);
        case 3: return n < 1024 ? (n >> 6) * 96 + (n & 63) : ((n - 1024) >> 5) * 96 + 64 + ((n - 1024) & 31);
        case 4: return (n >> 6) * 128 + (n & 63);
        default: return (n >> 6) * 128 + 64 + (n & 63);
    }
}
__device__ __forceinline__ void xpose_matrix(const float* __restrict__ src, int K, int Nsrc, bf16_t* dst, int Ndst, int mapid, LAS float* scr, int tid) {
    const int nblk = Ndst >> 6, nitems = (K >> 6) * nblk;
    for (int item = blockIdx.x; item < nitems; item += gridDim.x) {
        const int kb = item / nblk, nb = item - kb * nblk, k0 = kb * 64, n0 = nb * 64;
        __syncthreads();
#pragma unroll
        for (int i = 0; i < 8; ++i) { const int idx = tid + 512 * i, kk = idx >> 6, nn = idx & 63; const int sc = srccol(mapid, n0 + nn);
            scr[nn * 65 + kk] = sc >= 0 ? src[(size_t)(k0 + kk) * Nsrc + sc] : 0.f; }
        __syncthreads();
        { const int nn = tid >> 3, c = tid & 7; const LAS float* s = scr + nn * 65 + 8 * c;
          u32x4 o; o.x = cvtpk(s[0], s[1]); o.y = cvtpk(s[2], s[3]); o.z = cvtpk(s[4], s[5]); o.w = cvtpk(s[6], s[7]);
          *(u32x4*)(dst + (size_t)(n0 + nn) * K + k0 + 8 * c) = o; }
    }
}
__device__ __forceinline__ void norm_row_bf16(const float* src, const float* gain, bf16_t* dst, int lane) {
    f32x4 v[4]; float s = 0.f;
#pragma unroll
    for (int j = 0; j < 4; ++j) { v[j] = src ? ((const f32x4*)src)[lane + 64 * j] : (f32x4){0.f, 0.f, 0.f, 0.f}; s += v[j][0] * v[j][0] + v[j][1] * v[j][1] + v[j][2] * v[j][2] + v[j][3] * v[j][3]; }
    const float rs = rsqrtf(wave_sum(s) * (1.f / 1024.f) + EPS);
#pragma unroll
    for (int j = 0; j < 4; ++j) { const f32x4 g = ((const f32x4*)gain)[lane + 64 * j];
        u32x2 o = {cvtpk(v[j][0] * rs * g[0], v[j][1] * rs * g[1]), cvtpk(v[j][2] * rs * g[2], v[j][3] * rs * g[3])}; ((u32x2*)dst)[lane + 64 * j] = o; }
}

__device__ __forceinline__ void norm_row2_bf16(const float* s0, const float* s1, const float* gain, bf16_t* d0, bf16_t* d1, int lane) {
    f32x4 v[4], w[4]; float a = 0.f, b = 0.f;
#pragma unroll
    for (int j = 0; j < 4; ++j) { v[j] = s0 ? ((const f32x4*)s0)[lane + 64 * j] : (f32x4){0.f, 0.f, 0.f, 0.f}; w[j] = s1 ? ((const f32x4*)s1)[lane + 64 * j] : (f32x4){0.f, 0.f, 0.f, 0.f}; }
#pragma unroll
    for (int j = 0; j < 4; ++j) { a += v[j][0] * v[j][0] + v[j][1] * v[j][1] + v[j][2] * v[j][2] + v[j][3] * v[j][3]; b += w[j][0] * w[j][0] + w[j][1] * w[j][1] + w[j][2] * w[j][2] + w[j][3] * w[j][3]; }
    const float ra = rsqrtf(wave_sum(a) * (1.f / 1024.f) + EPS), rb = rsqrtf(wave_sum(b) * (1.f / 1024.f) + EPS);
#pragma unroll
    for (int j = 0; j < 4; ++j) { const f32x4 g = ((const f32x4*)gain)[lane + 64 * j];
        u32x2 o = {cvtpk(v[j][0] * ra * g[0], v[j][1] * ra * g[1]), cvtpk(v[j][2] * ra * g[2], v[j][3] * ra * g[3])}; ((u32x2*)d0)[lane + 64 * j] = o;
        u32x2 p = {cvtpk(w[j][0] * rb * g[0], w[j][1] * rb * g[1]), cvtpk(w[j][2] * rb * g[2], w[j][3] * rb * g[3])}; ((u32x2*)d1)[lane + 64 * j] = p; }
}

__device__ __forceinline__ void p5_phase(const Args& a, const int wave) {
    const int lane = lane_id(); int tid = wave * 64 + lane; asm volatile("" : "+v"(tid)); tid &= 511; const int gw = blockIdx.x * 8 + wave, NGW = gridDim.x * 8;
    unsigned char* ws = a.ws;
    const bf16_t* misc = (const bf16_t*)(ws + WS_MISC); float* dt = (float*)(ws + WS_DT); float* acs = (float*)(ws + WS_ACS); float* tot = (float*)(ws + WS_TOT);
    bf16_t* cqn = (bf16_t*)(ws + WS_CQN); bf16_t* ckvb = (bf16_t*)(ws + WS_CKVB); bf16_t* krb = (bf16_t*)(ws + WS_KRB); bf16_t* xc = (bf16_t*)(ws + WS_X);
    const bf16_t* halo = (const bf16_t*)(ws + WS_HALO); const float* rope = (const float*)(ws + WS_ROPE);
    for (int ci = gw; ci < NCHUNK; ci += NGW) {
        int row0, ntok; chunk_info(ci, row0, ntok);
        const int h = lane & 31;
        const float A = -__expf(a.in[I_ALOG][h]), bias = a.in[I_DTB][h]; float accv = 0.f;
        for (int t = 0; t < ntok; t += 16) { float v[16];
#pragma unroll
            for (int k = 0; k < 16; ++k) v[k] = bf2f(misc[(size_t)(row0 + t + k) * 768 + h]);
#pragma unroll
            for (int k = 0; k < 16; ++k) { accv += softplus_f(v[k] + bias) * A; if (lane < 32) acs[(size_t)(row0 + t + k) * 32 + h] = accv; } }
        if (lane < 32) tot[ci * 32 + h] = accv;
    }
    for (int row = gw; row < R_ACT; row += NGW) {
        const bf16_t* mr = misc + (size_t)row * 768;
        if (lane < 32) dt[(size_t)row * 32 + lane] = softplus_f(bf2f(mr[lane]) + a.in[I_DTB][lane]);
        { const unsigned* cp = (const unsigned*)(mr + 32) + 3 * lane; const unsigned c0 = cp[0], c1 = cp[1], c2 = cp[2];
          float q[6] = {bflo(c0), bfhi(c0), bflo(c1), bfhi(c1), bflo(c2), bfhi(c2)}; float ss = 0.f;
#pragma unroll
          for (int e = 0; e < 6; ++e) ss += q[e] * q[e];
          const float rs = rsqrtf(wave_sum(ss) * (1.f / 384.f) + EPS);
          if (row < R2) { const float* gq = a.in[I_QN] + 6 * lane; unsigned* op = (unsigned*)(cqn + (size_t)row * 384) + 3 * lane;
              op[0] = cvtpk(q[0] * rs * gq[0], q[1] * rs * gq[1]); op[1] = cvtpk(q[2] * rs * gq[2], q[3] * rs * gq[3]); op[2] = cvtpk(q[4] * rs * gq[4], q[5] * rs * gq[5]); } }
        { const u32x2 kv = *(const u32x2*)(mr + 416 + 4 * lane); float v[4] = {bflo(kv.x), bfhi(kv.x), bflo(kv.y), bfhi(kv.y)};
          const float rs = rsqrtf(wave_sum(v[0] * v[0] + v[1] * v[1] + v[2] * v[2] + v[3] * v[3]) * (1.f / 256.f) + EPS);
          const f32x4 g = *(const f32x4*)(a.in[I_KVN] + 4 * lane); const f32x4 o = {v[0] * rs * g[0], v[1] * rs * g[1], v[2] * rs * g[2], v[3] * rs * g[3]};
          if (row < R_S0) *(f32x4*)(a.out + OUT_CKVP + ((size_t)(row >> 14) * 16400 + 16 + (row & 16383)) * 256 + 4 * lane) = o;
          else if (row < R_M0) *(f32x4*)(a.out + OUT_CKVS + (size_t)(row - R_S0) * 256 + 4 * lane) = o;
          else { *(f32x4*)(a.out + OUT_CKVP + (size_t)(row - R_M0) * 256 + 4 * lane) = o; *(f32x4*)(a.out + OUT_CKVP + (size_t)(16400 + row - R_M0) * 256 + 4 * lane) = o; }
          u32x2 ob = {cvtpk(o[0], o[1]), cvtpk(o[2], o[3])}; *(u32x2*)(ckvb + (size_t)row * 256 + 4 * lane) = ob; }
        if (lane < 16) { const float x1 = bf2f(mr[672 + lane]), x2 = bf2f(mr[688 + lane]); const f32x2 cs = *(const f32x2*)(rope + ((size_t)pos_idx(row) * 16 + lane) * 2);
          const float o1 = x1 * cs[0] - x2 * cs[1], o2 = x1 * cs[1] + x2 * cs[0];
          if (row < R_S0) { float* p = a.out + OUT_KRP + ((size_t)(row >> 14) * 16400 + 16 + (row & 16383)) * 32; p[lane] = o1; p[16 + lane] = o2; }
          else if (row < R_M0) { float* p = a.out + OUT_KRS + (size_t)(row - R_S0) * 32; p[lane] = o1; p[16 + lane] = o2; }
          else { float* p = a.out + OUT_KRP + (size_t)(row - R_M0) * 32; p[lane] = o1; p[16 + lane] = o2; p += (size_t)16400 * 32; p[lane] = o1; p[16 + lane] = o2; }
          krb[(size_t)row * 32 + lane] = (bf16_t)f2bf(o1); krb[(size_t)row * 32 + 16 + lane] = (bf16_t)f2bf(o2); }
    }
    for (int row = R_ACT + gw; row < R1; row += NGW) { u32x2 z = {0u, 0u}; *(u32x2*)(ckvb + (size_t)row * 256 + 4 * lane) = z; if (lane < 16) ((unsigned*)(krb + (size_t)row * 32))[lane] = 0u; }
    for (int r = gw; r < 16384; r += NGW) {
        const f32x4 v = *(const f32x4*)(a.in[I_CCKV] + (size_t)r * 256 + 4 * lane); u32x2 o = {cvtpk(v[0], v[1]), cvtpk(v[2], v[3])}; *(u32x2*)(ckvb + (size_t)(R_C0 + r) * 256 + 4 * lane) = o;
        if (lane < 8) { const f32x4 k = *(const f32x4*)(a.in[I_CKR] + (size_t)r * 32 + 4 * lane); u32x2 ok = {cvtpk(k[0], k[1]), cvtpk(k[2], k[3])}; *(u32x2*)(krb + (size_t)(R_C0 + r) * 32 + 4 * lane) = ok; }
    }
    for (int item = NGW - 1 - gw; item < 529 * 6; item += NGW) {
        const int T = item / 6, cc = item - T * 6, c0 = cc * 512 + lane * 8;
        int row0, nrows; float p0[8], p1[8], p2[8];
        if (T < 512) { row0 = T * 64; nrows = 64; const bf16_t* hp = halo + (size_t)T * 3 * 3072 + c0;
            const u32x4 h0 = *(const u32x4*)hp, h1 = *(const u32x4*)(hp + 3072), h2 = *(const u32x4*)(hp + 6144);
#pragma unroll
            for (int e = 0; e < 4; ++e) { p0[2 * e] = bflo(h0[e]); p0[2 * e + 1] = bfhi(h0[e]); p1[2 * e] = bflo(h1[e]); p1[2 * e + 1] = bfhi(h1[e]); p2[2 * e] = bflo(h2[e]); p2[2 * e + 1] = bfhi(h2[e]); } }
        else if (T == 512) { row0 = R_M0; nrows = 16;
#pragma unroll
            for (int e = 0; e < 8; ++e) { p0[e] = 0.f; p1[e] = 0.f; p2[e] = 0.f; } }
        else { const int db = T - 513; row0 = R_S0 + 32 * db; nrows = 32; const float* sp = a.in[I_SCONV] + (size_t)db * 3 * 3072 + c0;
#pragma unroll
            for (int e = 0; e < 8; ++e) { p0[e] = sp[e]; p1[e] = sp[3072 + e]; p2[e] = sp[6144 + e]; } }
        float w0[8], w1[8], w2[8], w3[8], bb[8];
#pragma unroll
        for (int e = 0; e < 8; ++e) { w0[e] = a.in[I_CONVW][c0 + e]; w1[e] = a.in[I_CONVW][3072 + c0 + e]; w2[e] = a.in[I_CONVW][6144 + c0 + e]; w3[e] = a.in[I_CONVW][9216 + c0 + e]; bb[e] = a.in[I_CONVB][c0 + e]; }
        for (int t0 = 0; t0 < nrows; t0 += 8) {
            u32x4 raw[8];
#pragma unroll
            for (int k = 0; k < 8; ++k) raw[k] = *(const u32x4*)(xc + (size_t)(row0 + t0 + k) * 3072 + c0);
#pragma unroll
            for (int k = 0; k < 8; ++k) { float x[8], y[8];
#pragma unroll
                for (int e = 0; e < 4; ++e) { x[2 * e] = bflo(raw[k][e]); x[2 * e + 1] = bfhi(raw[k][e]); }
#pragma unroll
                for (int e = 0; e < 8; ++e) { y[e] = silu_f(bb[e] + w0[e] * p0[e] + w1[e] * p1[e] + w2[e] * p2[e] + w3[e] * x[e]); p0[e] = p1[e]; p1[e] = p2[e]; p2[e] = x[e]; }
                u32x4 o; o.x = cvtpk(y[0], y[1]); o.y = cvtpk(y[2], y[3]); o.z = cvtpk(y[4], y[5]); o.w = cvtpk(y[6], y[7]);
                *(u32x4*)(xc + (size_t)(row0 + t0 + k) * 3072 + c0) = o; }
        }
    }
}

__device__ __forceinline__ void p6_phase(const Args& a, LAS unsigned char* L, const int wave) {
    const int lane = lane_id(); int tid = wave * 64 + lane; asm volatile("" : "+v"(tid)); tid &= 511;
    unsigned char* ws = a.ws; const bf16_t* xc = (const bf16_t*)(ws + WS_X); const float* dt = (const float*)(ws + WS_DT); const float* acs = (const float*)(ws + WS_ACS);
    const float* tot = (const float*)(ws + WS_TOT); bf16_t* S = (bf16_t*)(ws + WS_S);
    LAS bf16_t* Bs = (LAS bf16_t*)L; LAS bf16_t* Xs = (LAS bf16_t*)(L + 18432); LAS float* scs = (LAS float*)(L + 86016);
    const int li = lane & 15, quad = lane >> 4;
    const unsigned voffB = (unsigned)((tid >> 4) * 3072 + (tid & 15) * 8), voffX = (unsigned)((tid >> 6) * 3072 + (tid & 63) * 8);
    for (int unit = blockIdx.x; unit < NCHUNK * 4; unit += gridDim.x) {
        const int ci = unit >> 2, g = unit & 3, h = 8 * g + wave; int row0, ntok; chunk_info(ci, row0, ntok);
        f32x4 acc[8][4];
#pragma unroll
        for (int nb = 0; nb < 8; ++nb)
#pragma unroll
            for (int pb = 0; pb < 4; ++pb) acc[nb][pb] = (f32x4){0.f, 0.f, 0.f, 0.f};
        const int nsub = (ntok + 63) >> 6;
        for (int jb = 0; jb < nsub; ++jb) {
            const int rj = row0 + 64 * jb;
            __syncthreads();
            { const int hh = tid >> 6, t = tid & 63; const size_t r = (size_t)(rj + t) * 32 + 8 * g + hh; float v = 0.f;
              if (64 * jb + t < ntok) v = __expf(tot[ci * 32 + 8 * g + hh] - acs[r]) * dt[r];
              scs[hh * 64 + t] = v; }
#pragma unroll
            for (int i = 0; i < 2; ++i) { const bf16_t* gb = xc + (size_t)(rj + 32 * i) * 3072 + 2048 + 128 * g;
                *(LAS u32x4*)(Bs + ((tid >> 4) + 32 * i) * 144 + (tid & 15) * 8) = *(const u32x4*)(gb + voffB); }
            __syncthreads();
#pragma unroll
            for (int i = 0; i < 8; ++i) { const int t = (tid >> 6) + 8 * i, c = tid & 63; const bf16_t* gb = xc + (size_t)(rj + 8 * i) * 3072 + 512 * g;
                const u32x4 v = *(const u32x4*)(gb + voffX); const float s = scs[(c >> 3) * 64 + t];
                u32x4 o; o.x = cvtpk(bflo(v.x) * s, bfhi(v.x) * s); o.y = cvtpk(bflo(v.y) * s, bfhi(v.y) * s); o.z = cvtpk(bflo(v.z) * s, bfhi(v.z) * s); o.w = cvtpk(bflo(v.w) * s, bfhi(v.w) * s);
                *(LAS u32x4*)(Xs + t * 528 + c * 8) = o; }
            __syncthreads();
#pragma unroll
            for (int s2 = 0; s2 < 2; ++s2) {
                const int tok0 = 32 * s2 + 4 * quad + (li >> 2), cq4 = 4 * (li & 3);
                bf16x8 Bf[4];
#pragma unroll
                for (int pb = 0; pb < 4; ++pb) Bf[pb] = cat8(ldtr(Xs + tok0 * 528 + 64 * wave + 16 * pb + cq4), ldtr(Xs + (tok0 + 16) * 528 + 64 * wave + 16 * pb + cq4));
#pragma unroll
                for (int nb = 0; nb < 8; ++nb) { const bf16x8 Af = cat8(ldtr(Bs + tok0 * 144 + 16 * nb + cq4), ldtr(Bs + (tok0 + 16) * 144 + 16 * nb + cq4));
#pragma unroll
                    for (int pb = 0; pb < 4; ++pb) acc[nb][pb] = MFMA16(Af, Bf[pb], acc[nb][pb]); }
            }
        }
        bf16_t* Sp = S + ((size_t)(ci * 32 + h) * 64) * 128;
#pragma unroll
        for (int nb = 0; nb < 8; ++nb)
#pragma unroll
            for (int pb = 0; pb < 4; ++pb) { u32x2 o = {cvtpk(acc[nb][pb][0], acc[nb][pb][1]), cvtpk(acc[nb][pb][2], acc[nb][pb][3])};
                *(u32x2*)(Sp + (size_t)(16 * pb + li) * 128 + 16 * nb + 4 * quad) = o; }
    }
}

__device__ __forceinline__ void p7_phase(const Args& a, const int wave) {
    int tid = wave * 64 + lane_id(); asm volatile("" : "+v"(tid)); tid &= 511;
    unsigned char* ws = a.ws; bf16_t* S = (bf16_t*)(ws + WS_S); const float* tot = (const float*)(ws + WS_TOT);
    const int gt = blockIdx.x * 512 + tid, NT = gridDim.x * 512;
    for (int e = gt; e < 131072; e += NT) {
        const int b = e >> 16, rem = e & 65535, h = rem >> 11; f32x4 st = {0.f, 0.f, 0.f, 0.f};
        for (int k0 = 0; k0 < 65; k0 += 5) { u32x2 v[5]; float dec[5];
#pragma unroll
            for (int k = 0; k < 5; ++k) { const int ci = b * 65 + k0 + k; v[k] = *(const u32x2*)(S + (size_t)ci * 262144 + rem * 4); dec[k] = __expf(tot[ci * 32 + h]); }
#pragma unroll
            for (int k = 0; k < 5; ++k) { const int ci = b * 65 + k0 + k; u32x2 o = {cvtpk(st[0], st[1]), cvtpk(st[2], st[3])}; *(u32x2*)(S + (size_t)ci * 262144 + rem * 4) = o;
                st[0] = st[0] * dec[k] + bflo(v[k].x); st[1] = st[1] * dec[k] + bfhi(v[k].x); st[2] = st[2] * dec[k] + bflo(v[k].y); st[3] = st[3] * dec[k] + bfhi(v[k].y); } }
        *(f32x4*)(a.out + OUT_SSMP + (size_t)b * 262144 + rem * 4) = st;
    }
    for (int e = gt; e < 16 * 65536; e += NT) {
        const int db = e >> 16, rem = e & 65535, h = rem >> 11, ci = 130 + db;
        const f32x4 s0 = *(const f32x4*)(a.in[I_SSSM] + (size_t)db * 262144 + rem * 4); const u32x2 v = *(const u32x2*)(S + (size_t)ci * 262144 + rem * 4); const float dec = __expf(tot[ci * 32 + h]);
        u32x2 o = {cvtpk(s0[0], s0[1]), cvtpk(s0[2], s0[3])}; *(u32x2*)(S + (size_t)ci * 262144 + rem * 4) = o;
        const f32x4 r = {s0[0] * dec + bflo(v.x), s0[1] * dec + bfhi(v.x), s0[2] * dec + bflo(v.y), s0[3] * dec + bfhi(v.y)};
        *(f32x4*)(a.out + OUT_SSMS + (size_t)db * 262144 + rem * 4) = r;
    }
}

__device__ __forceinline__ void p8_phase(const Args& a, LAS unsigned char* L, const int wave) {
    const int lane = lane_id(); int tid = wave * 64 + lane; asm volatile("" : "+v"(tid)); tid &= 511;
    unsigned char* ws = a.ws; const bf16_t* xc = (const bf16_t*)(ws + WS_X); const float* dt = (const float*)(ws + WS_DT); const float* acs = (const float*)(ws + WS_ACS);
    const bf16_t* S = (const bf16_t*)(ws + WS_S); bf16_t* zb = (bf16_t*)(ws + WS_Z);
    LAS bf16_t* Cs = (LAS bf16_t*)L; LAS bf16_t* Bs = (LAS bf16_t*)(L + 18432); LAS bf16_t* Xs = (LAS bf16_t*)(L + 36864);
    LAS float* aj = (LAS float*)(L + 104448); LAS float* dj = (LAS float*)(L + 106496); LAS float* red = (LAS float*)(L + 108544);
    const int li = lane & 15, quad = lane >> 4;
    const unsigned voffB = (unsigned)((tid >> 4) * 3072 + (tid & 15) * 8), voffX = (unsigned)((tid >> 6) * 3072 + (tid & 63) * 8);
    for (int u = blockIdx.x; u < 2120; u += gridDim.x) {
        int ci, i, g;
        if (u < 2048) { i = 3 - (u >> 9); const int rest = u & 511; ci = (rest >> 8) * 65 + 1 + ((rest & 255) >> 2); g = rest & 3; }
        else { int v = u - 2048; i = 0; g = v & 3; if (v < 8) ci = (v >> 2) * 65; else ci = 130 + ((v - 8) >> 2); }
        int row0, ntok; chunk_info(ci, row0, ntok);
        const int rb = row0 + 64 * i, nti = (ntok - 64 * i) < 64 ? (ntok - 64 * i) : 64, h = 8 * g + wave;
        __syncthreads();
#pragma unroll
        for (int i2 = 0; i2 < 2; ++i2) { const bf16_t* gb = xc + (size_t)(rb + 32 * i2) * 3072 + 2560 + 128 * g;
            *(LAS u32x4*)(Cs + ((tid >> 4) + 32 * i2) * 144 + (tid & 15) * 8) = *(const u32x4*)(gb + voffB); }
        __syncthreads();
        const bf16_t* Sp = S + ((size_t)(ci * 32 + h) * 64) * 128;
        const float Dh = a.in[I_SSMD][h];
        { constexpr int ih = 0;
        f32x4 acc[4][4];
#pragma unroll
        for (int pb = 0; pb < 4; ++pb)
#pragma unroll
            for (int ib = 0; ib < 4; ++ib) acc[pb][ib] = (f32x4){0.f, 0.f, 0.f, 0.f};
        float ai[4];
#pragma unroll
        for (int ib = 0; ib < 4; ++ib) ai[ib] = acs[(size_t)(rb + 32 * ih + 16 * ib + li) * 32 + h];
        { bf16x8 Af[4][4];
#pragma unroll
          for (int ks = 0; ks < 4; ++ks)
#pragma unroll
            for (int pb = 0; pb < 4; ++pb) Af[ks][pb] = *(const bf16x8*)(Sp + (size_t)(16 * pb + li) * 128 + 32 * ks + 8 * quad);
#pragma unroll
          for (int ks = 0; ks < 4; ++ks) { bf16x8 Bf[4];
#pragma unroll
            for (int ib = 0; ib < 4; ++ib) Bf[ib] = *(const LAS bf16x8*)(Cs + (32 * ih + 16 * ib + li) * 144 + 32 * ks + 8 * quad);
#pragma unroll
            for (int pb = 0; pb < 4; ++pb)
#pragma unroll
                for (int ib = 0; ib < 4; ++ib) acc[pb][ib] = MFMA16(Af[ks][pb], Bf[ib], acc[pb][ib]);
            __builtin_amdgcn_sched_barrier(0); } }
#pragma unroll
        for (int ib = 0; ib < 4; ++ib) { const float e = __expf(ai[ib]);
#pragma unroll
            for (int pb = 0; pb < 4; ++pb) acc[pb][ib] = acc[pb][ib] * e; }
        for (int j = 0; j <= i; ++j) {
            const int rj = row0 + 64 * j;
            __syncthreads();
#pragma unroll
            for (int i2 = 0; i2 < 2; ++i2) { const bf16_t* gb = xc + (size_t)(rj + 32 * i2) * 3072 + 2048 + 128 * g;
                *(LAS u32x4*)(Bs + ((tid >> 4) + 32 * i2) * 144 + (tid & 15) * 8) = *(const u32x4*)(gb + voffB); }
#pragma unroll
            for (int i2 = 0; i2 < 8; ++i2) { const bf16_t* gb = xc + (size_t)(rj + 8 * i2) * 3072 + 512 * g;
                *(LAS u32x4*)(Xs + ((tid >> 6) + 8 * i2) * 528 + (tid & 63) * 8) = *(const u32x4*)(gb + voffX); }
            { const int hh = tid >> 6, t = tid & 63; const size_t r = (size_t)(rj + t) * 32 + 8 * g + hh; aj[hh * 64 + t] = acs[r]; dj[hh * 64 + t] = dt[r]; }
            __syncthreads();
            bf16x8 XA[4][2]; f32x4 a4v[4], d4v[4];
#pragma unroll
            for (int s2 = 0; s2 < 2; ++s2) { const LAS bf16_t* xp = Xs + (32 * s2 + 4 * quad + (li >> 2)) * 528 + 64 * wave + 4 * (li & 3);
#pragma unroll
                for (int pb = 0; pb < 4; ++pb) XA[pb][s2] = cat8(ldtr(xp + 16 * pb), ldtr(xp + 16 * 528 + 16 * pb)); }
#pragma unroll
            for (int jb = 0; jb < 4; ++jb) { a4v[jb] = *(const LAS f32x4*)(aj + wave * 64 + 16 * jb + 4 * quad); d4v[jb] = *(const LAS f32x4*)(dj + wave * 64 + 16 * jb + 4 * quad); }
            __builtin_amdgcn_sched_barrier(0);
#pragma unroll
            for (int ib = 0; ib < 4; ++ib) {
                f32x4 cb[4];
#pragma unroll
                for (int jb = 0; jb < 4; ++jb) cb[jb] = (f32x4){0.f, 0.f, 0.f, 0.f};
#pragma unroll
                for (int ks = 0; ks < 4; ++ks) { const bf16x8 Bc = *(const LAS bf16x8*)(Cs + (32 * ih + 16 * ib + li) * 144 + 32 * ks + 8 * quad);
#pragma unroll
                    for (int jb = 0; jb < 4; ++jb) { const bf16x8 Ab = *(const LAS bf16x8*)(Bs + (16 * jb + li) * 144 + 32 * ks + 8 * quad); cb[jb] = MFMA16(Ab, Bc, cb[jb]); } }
                const int ti = 32 * ih + 16 * ib + li;
#pragma unroll
                for (int jb = 0; jb < 4; ++jb) { const f32x4 a4 = a4v[jb], d4 = d4v[jb];
#pragma unroll
                    for (int jj = 0; jj < 4; ++jj) { const int tj = 16 * jb + 4 * quad + jj; float val = cb[jb][jj] * __expf(fminf(ai[ib] - a4[jj], 0.f)) * d4[jj];
                        if (j == i && tj > ti) val = 0.f; cb[jb][jj] = val; } }
#pragma unroll
                for (int s2 = 0; s2 < 2; ++s2) { u32x4 pk = {cvtpk(cb[2 * s2][0], cb[2 * s2][1]), cvtpk(cb[2 * s2][2], cb[2 * s2][3]), cvtpk(cb[2 * s2 + 1][0], cb[2 * s2 + 1][1]), cvtpk(cb[2 * s2 + 1][2], cb[2 * s2 + 1][3])};
                    const bf16x8 P = __builtin_bit_cast(bf16x8, pk);
#pragma unroll
                    for (int pb = 0; pb < 4; ++pb) acc[pb][ib] = MFMA16(XA[pb][s2], P, acc[pb][ib]); }
                __builtin_amdgcn_sched_barrier(0);
            }
        }
        float ss[4];
#pragma unroll
        for (int ib = 0; ib < 4; ++ib) { ss[ib] = 0.f; const int ti = 32 * ih + 16 * ib + li;
#pragma unroll
            for (int pb = 0; pb < 4; ++pb) { const int p0 = 16 * pb + 4 * quad; const u32x2 xr = *(const LAS u32x2*)(Xs + ti * 528 + 64 * wave + p0);
                const u32x2 zr = *(const u32x2*)(zb + (size_t)(rb + ti) * 2048 + 64 * h + p0);
                const float x4[4] = {bflo(xr.x), bfhi(xr.x), bflo(xr.y), bfhi(xr.y)}, z4[4] = {bflo(zr.x), bfhi(zr.x), bflo(zr.y), bfhi(zr.y)};
#pragma unroll
                for (int jj = 0; jj < 4; ++jj) { const float y = (acc[pb][ib][jj] + Dh * x4[jj]) * silu_f(z4[jj]); acc[pb][ib][jj] = y; ss[ib] += y * y; } }
            ss[ib] += __shfl_xor(ss[ib], 16); ss[ib] += __shfl_xor(ss[ib], 32);
            if (quad == 0) red[wave * 64 + ti] = ss[ib]; }
        __syncthreads();
#pragma unroll
        for (int ib = 0; ib < 4; ++ib) { const int ti = 32 * ih + 16 * ib + li; float t8 = 0.f;
#pragma unroll
            for (int w = 0; w < 8; ++w) t8 += red[w * 64 + ti];
            const float rs = rsqrtf(t8 * (1.f / 512.f) + EPS);
            if (ti < nti) {
#pragma unroll
                for (int pb = 0; pb < 4; ++pb) { const int p0 = 16 * pb + 4 * quad; const f32x4 gn = *(const f32x4*)(a.in[I_SSMN] + 64 * h + p0);
                    u32x2 o = {cvtpk(acc[pb][ib][0] * rs * gn[0], acc[pb][ib][1] * rs * gn[1]), cvtpk(acc[pb][ib][2] * rs * gn[2], acc[pb][ib][3] * rs * gn[3])};
                    *(u32x2*)(zb + (size_t)(rb + ti) * 2048 + 64 * h + p0) = o; } } }
        }
    }
}

__device__ __forceinline__ void attn_tile(bool prompt, int b_or_db, int tt, int& row0, int& nv) {
    if (tt == 0) { row0 = R_M0; nv = 16; return; }
    if (prompt) { row0 = b_or_db * 16384 + 64 * (tt - 1); nv = 64; }
    else if (tt <= 16) { row0 = R_C0 + 1024 * b_or_db + 64 * (tt - 1); nv = 64; }
    else { row0 = R_S0 + 32 * b_or_db; nv = 32; }
}
__device__ __forceinline__ void p11_phase(const Args& a, LAS unsigned char* L, const int wave) {
    const int lane = lane_id(); int tid = wave * 64 + lane; asm volatile("" : "+v"(tid)); tid &= 511;
    unsigned char* ws = a.ws; const bf16_t* Q = (const bf16_t*)(ws + WS_Q); const bf16_t* Kn = (const bf16_t*)(ws + WS_KN); const bf16_t* Vt = (const bf16_t*)(ws + WS_VT);
    const bf16_t* krb = (const bf16_t*)(ws + WS_KRB); bf16_t* O = (bf16_t*)(ws + WS_O); const float* rope = (const float*)(ws + WS_ROPE);
    constexpr int KSZ = 64 * 104, VSZ = 64 * 72, BUF = KSZ + VSZ;
    LAS bf16_t* LB = (LAS bf16_t*)L;
    const int li = lane & 15, quad = lane >> 4;
    const unsigned vo_kn = (unsigned)((tid >> 3) * 1024 + (tid & 7) * 8), vo_kr = (unsigned)(((tid & 255) >> 2) * 32 + (tid & 3) * 8), vo_vt = (unsigned)((tid >> 3) * RK + (tid & 7) * 8);
    const int so_kn = (tid >> 3) * 104 + (tid & 7) * 8, so_kr = ((tid & 255) >> 2) * 104 + 64 + (tid & 3) * 8, so_vt = KSZ + (tid >> 3) * 72 + (tid & 7) * 8;
    for (int u = blockIdx.x; u < 2304; u += gridDim.x) {
        bool prompt, active; int bq, hd, qr0, ntiles, limit;
        if (u < 2048) { const int k = u >> 8, c32 = (u & 255) >> 5, qblk = 63 - 8 * k - ((k & 1) ? 7 - c32 : c32); prompt = true; bq = (u & 31) >> 4; hd = u & 15;
            qr0 = bq * 16384 + 256 * qblk; ntiles = 4 * qblk + 5; limit = 4 * qblk + (wave >> 1) + 1; active = true; }
        else { const int v = u - 2048; prompt = false; bq = v >> 4; hd = v & 15; qr0 = R_S0 + 32 * bq; ntiles = 18; limit = 17; active = (wave == 0); }
        const int qrow = qr0 + 32 * wave;
        bf16x8 qf[2][3];
#pragma unroll
        for (int qb = 0; qb < 2; ++qb) {
            const int r = active ? qrow + 16 * qb + li : 0; const bf16_t* qp = Q + (size_t)r * 1536;
            qf[qb][0] = *(const bf16x8*)(qp + hd * 64 + 8 * quad); qf[qb][1] = *(const bf16x8*)(qp + hd * 64 + 32 + 8 * quad);
            const u32x4 x1 = *(const u32x4*)(qp + 1024 + hd * 32 + 8 * (quad & 1)), x2 = *(const u32x4*)(qp + 1024 + hd * 32 + 16 + 8 * (quad & 1));
            const float* rp = rope + ((size_t)pos_idx(r) * 16 + 8 * (quad & 1)) * 2; float ov[8];
#pragma unroll
            for (int e = 0; e < 4; ++e) { const f32x4 cs = *(const f32x4*)(rp + 4 * e);
                const float a0 = bflo(x1[e]), a1 = bfhi(x1[e]), b0 = bflo(x2[e]), b1 = bfhi(x2[e]);
                ov[2 * e] = quad < 2 ? a0 * cs[0] - b0 * cs[1] : a0 * cs[1] + b0 * cs[0]; ov[2 * e + 1] = quad < 2 ? a1 * cs[2] - b1 * cs[3] : a1 * cs[3] + b1 * cs[2]; }
            u32x4 pkq = {cvtpk(ov[0], ov[1]), cvtpk(ov[2], ov[3]), cvtpk(ov[4], ov[5]), cvtpk(ov[6], ov[7])}; qf[qb][2] = __builtin_bit_cast(bf16x8, pkq);
        }
        float mrun[2] = {-INFINITY, -INFINITY}, lrun[2] = {0.f, 0.f}; f32x4 o[4][2];
#pragma unroll
        for (int db = 0; db < 4; ++db) { o[db][0] = (f32x4){0.f, 0.f, 0.f, 0.f}; o[db][1] = o[db][0]; }
        int row0, nv, nvn; attn_tile(prompt, bq, 0, row0, nv);
        u32x4 pkn = *(const u32x4*)(Kn + (size_t)row0 * 1024 + hd * 64 + vo_kn);
        u32x4 pkr = *(const u32x4*)(krb + (size_t)row0 * 32 + vo_kr);
        u32x4 pvt = *(const u32x4*)(Vt + (size_t)hd * 64 * RK + row0 + vo_vt);
        __syncthreads();
        *(LAS u32x4*)(LB + so_kn) = pkn; if (tid < 256) *(LAS u32x4*)(LB + so_kr) = pkr; *(LAS u32x4*)(LB + so_vt) = pvt;
        attn_tile(prompt, bq, 1, row0, nvn);
        pkn = *(const u32x4*)(Kn + (size_t)row0 * 1024 + hd * 64 + vo_kn); pkr = *(const u32x4*)(krb + (size_t)row0 * 32 + vo_kr); pvt = *(const u32x4*)(Vt + (size_t)hd * 64 * RK + row0 + vo_vt);
        for (int tt = 0; tt < ntiles; ++tt) {
            const int nvc = nv; nv = nvn;
            __syncthreads();
            if (tt + 1 < ntiles) { LAS bf16_t* nb = LB + ((tt + 1) & 1) * BUF;
                *(LAS u32x4*)(nb + so_kn) = pkn; if (tid < 256) *(LAS u32x4*)(nb + so_kr) = pkr; *(LAS u32x4*)(nb + so_vt) = pvt;
                if (tt + 2 < ntiles) { attn_tile(prompt, bq, tt + 2, row0, nvn);
                    pkn = *(const u32x4*)(Kn + (size_t)row0 * 1024 + hd * 64 + vo_kn); pkr = *(const u32x4*)(krb + (size_t)row0 * 32 + vo_kr); pvt = *(const u32x4*)(Vt + (size_t)hd * 64 * RK + row0 + vo_vt); } }
            if (active && tt <= limit) {
                const LAS bf16_t* Ks = LB + (tt & 1) * BUF; const LAS bf16_t* Vs = Ks + KSZ;
                f32x4 s[4][2];
                const float m0 = mrun[0] == -INFINITY ? 0.f : mrun[0], m1 = mrun[1] == -INFINITY ? 0.f : mrun[1];
#pragma unroll
                for (int kb = 0; kb < 4; ++kb) { s[kb][0] = (f32x4){-m0, -m0, -m0, -m0}; s[kb][1] = (f32x4){-m1, -m1, -m1, -m1}; }
#pragma unroll
                for (int ks = 0; ks < 3; ++ks)
#pragma unroll
                    for (int kb = 0; kb < 4; ++kb) { const bf16x8 kf = *(const LAS bf16x8*)(Ks + (16 * kb + li) * 104 + 32 * ks + 8 * quad);
                        s[kb][0] = MFMA16(kf, qf[0][ks], s[kb][0]); s[kb][1] = MFMA16(kf, qf[1][ks], s[kb][1]); }
                if (nvc < 64) {
#pragma unroll
                    for (int kb = 0; kb < 4; ++kb)
#pragma unroll
                        for (int jj = 0; jj < 4; ++jj) if (16 * kb + 4 * quad + jj >= nvc) { s[kb][0][jj] = -INFINITY; s[kb][1][jj] = -INFINITY; } }
                bf16x8 P[2][2];
#pragma unroll
                for (int qb = 0; qb < 2; ++qb) {
                    float mx = fmaxf(fmaxf(s[0][qb][0], s[0][qb][1]), s[0][qb][2]);
                    mx = fmaxf(fmaxf(mx, s[0][qb][3]), s[1][qb][0]); mx = fmaxf(fmaxf(mx, s[1][qb][1]), s[1][qb][2]); mx = fmaxf(fmaxf(mx, s[1][qb][3]), s[2][qb][0]);
                    mx = fmaxf(fmaxf(mx, s[2][qb][1]), s[2][qb][2]); mx = fmaxf(fmaxf(mx, s[2][qb][3]), s[3][qb][0]); mx = fmaxf(fmaxf(mx, s[3][qb][1]), s[3][qb][2]); mx = fmaxf(mx, s[3][qb][3]);
                    const bool first = (mrun[qb] == -INFINITY);
                    if (__builtin_amdgcn_ballot_w64(first || mx > 16.f) != 0ull) {
                        mx = fmaxf(mx, __shfl_xor(mx, 16)); mx = fmaxf(mx, __shfl_xor(mx, 32));
                        const float mold = qb == 0 ? m0 : m1, d = first ? mx : fmaxf(mx, 0.f);
                        const float alpha = first ? 0.f : __builtin_amdgcn_exp2f(-d); mrun[qb] = mold + d; lrun[qb] *= alpha;
#pragma unroll
                        for (int kb = 0; kb < 4; ++kb) s[kb][qb] = s[kb][qb] - d;
#pragma unroll
                        for (int db = 0; db < 4; ++db) o[db][qb] = o[db][qb] * alpha; }
                    f32x4 rs4 = {0.f, 0.f, 0.f, 0.f};
#pragma unroll
                    for (int kb = 0; kb < 4; ++kb) { f32x4 t = s[kb][qb];
                        t[0] = __builtin_amdgcn_exp2f(t[0]); t[1] = __builtin_amdgcn_exp2f(t[1]); t[2] = __builtin_amdgcn_exp2f(t[2]); t[3] = __builtin_amdgcn_exp2f(t[3]); s[kb][qb] = t; rs4 = rs4 + t; }
                    lrun[qb] += (rs4[0] + rs4[1]) + (rs4[2] + rs4[3]);
#pragma unroll
                    for (int s2 = 0; s2 < 2; ++s2) { u32x4 pk = {cvtpk(s[2 * s2][qb][0], s[2 * s2][qb][1]), cvtpk(s[2 * s2][qb][2], s[2 * s2][qb][3]), cvtpk(s[2 * s2 + 1][qb][0], s[2 * s2 + 1][qb][1]), cvtpk(s[2 * s2 + 1][qb][2], s[2 * s2 + 1][qb][3])};
                        P[qb][s2] = __builtin_bit_cast(bf16x8, pk); }
                }
#pragma unroll
                for (int s2 = 0; s2 < 2; ++s2)
#pragma unroll
                    for (int db = 0; db < 4; ++db) { const LAS bf16_t* vp = Vs + (16 * db + li) * 72 + 32 * s2 + 4 * quad;
                        const bf16x8 vf = cat8u(*(const LAS u32x2*)vp, *(const LAS u32x2*)(vp + 16));
                        o[db][0] = MFMA16(vf, P[0][s2], o[db][0]); o[db][1] = MFMA16(vf, P[1][s2], o[db][1]); }
            }
        }
        if (active) {
#pragma unroll
            for (int qb = 0; qb < 2; ++qb) { float l = lrun[qb]; l += __shfl_xor(l, 16); l += __shfl_xor(l, 32); const float inv = 1.f / l;
#pragma unroll
                for (int db = 0; db < 4; ++db) { u32x2 w = {cvtpk(o[db][qb][0] * inv, o[db][qb][1] * inv), cvtpk(o[db][qb][2] * inv, o[db][qb][3] * inv)};
                    *(u32x2*)(O + (size_t)(qrow + 16 * qb + li) * 1024 + hd * 64 + 16 * db + 4 * quad) = w; } }
        }
    }
}

#ifndef ONLY_PHASE
#define ONLY_PHASE -1
#endif
#define PH(k) (ONLY_PHASE < 0 || ONLY_PHASE == (k))
constexpr int NPHASE = 20;
constexpr int LDS_BYTES = 131072;
__device__ __forceinline__ void grid_barrier(unsigned* bar, unsigned k, int wave) {
    __syncthreads();
    if (wave == 0) {
        __builtin_amdgcn_fence(__ATOMIC_RELEASE, "agent");
        if (lane_id() == 0) {
            const unsigned g = blockIdx.x & 7u, ngrp = gridDim.x < 8u ? gridDim.x : 8u, ng = (gridDim.x - g + 7u) >> 3;
            unsigned* cnt = bar + 64 * g; unsigned* top = bar + 64 * 8; unsigned* rel = bar + 64 * (9 + g);
            const unsigned old = __hip_atomic_fetch_add(cnt, 1u, __ATOMIC_RELAXED, __HIP_MEMORY_SCOPE_AGENT);
            if (old + 1u == ng * k) {
                const unsigned old2 = __hip_atomic_fetch_add(top, 1u, __ATOMIC_RELAXED, __HIP_MEMORY_SCOPE_AGENT);
                if (old2 + 1u == ngrp * k) { for (unsigned j = 0; j < ngrp; ++j) __hip_atomic_store(bar + 64 * (9 + j), k, __ATOMIC_RELAXED, __HIP_MEMORY_SCOPE_AGENT); }
            }
            while (__hip_atomic_load(rel, __ATOMIC_RELAXED, __HIP_MEMORY_SCOPE_AGENT) < k) __builtin_amdgcn_s_sleep(1);
        }
        __builtin_amdgcn_fence(__ATOMIC_ACQUIRE, "agent");
    }
    __syncthreads();
}
__global__ void __launch_bounds__(512, 2) fwd_megakernel(Args a) {
    extern __shared__ __attribute__((aligned(16))) unsigned char lds_raw[];
    LAS unsigned char* L = (LAS unsigned char*)lds_raw;
    unsigned char* ws = a.ws;
    bf16_t* W_IN = (bf16_t*)(ws + WS_W_IN); bf16_t* W_GU = (bf16_t*)(ws + WS_W_GU); bf16_t* W_D = (bf16_t*)(ws + WS_W_D); bf16_t* W_SO = (bf16_t*)(ws + WS_W_SO);
    bf16_t* W_UQ = (bf16_t*)(ws + WS_W_UQ); bf16_t* W_K = (bf16_t*)(ws + WS_W_K); bf16_t* W_V = (bf16_t*)(ws + WS_W_V); bf16_t* W_MO = (bf16_t*)(ws + WS_W_MO); bf16_t* W_MIX = (bf16_t*)(ws + WS_W_MIX);
    float* hmeta = (float*)(ws + WS_HMETA);
    const RowMap rm{a.out, hmeta, a.in[I_XP], a.in[I_XS], a.in[I_META]};
    const int wave = __builtin_amdgcn_readfirstlane((int)threadIdx.x >> 6);
    unsigned* bar = (unsigned*)(ws + WS_BAR);
    if (a.ph_hi > 1000) { cg::grid_group grid = cg::this_grid(); grid.sync(); }
    const int lo = a.ph_lo, hi = a.ph_hi;
    __builtin_amdgcn_fence(__ATOMIC_ACQUIRE, "agent");
#define TIDS const int lane = lane_id(); int tid = wave * 64 + lane; asm volatile("" : "+v"(tid)); tid &= 511; const int gw = blockIdx.x * 8 + wave, NGW = gridDim.x * 8; (void)tid; (void)lane; (void)gw; (void)NGW;
#define IN(k) (PH(k) && lo <= (k) && (k) < hi)
    unsigned nbar = 0;
#ifdef TIME_PHASE
    unsigned long long t_a = 0, t_b = 0;
#endif
#define SEAM(k) do { if ((k) + 1 < hi) { ++nbar; grid_barrier(bar, nbar, wave); } } while (0)
    {
        {
#ifdef TIME_PHASE
        if (TIME_PHASE == 0) t_a = __builtin_amdgcn_s_memrealtime();
#endif
        if (IN(0)) { { TIDS
            LAS float* scr = (LAS float*)L;
            xpose_matrix(a.in[I_F1GU], 1024, 2 * FFN, W_GU, 2 * FFN, 1, scr, tid);
            xpose_matrix(a.in[I_F1D], FFN, 1024, W_D, 1024, 0, scr, tid);
            xpose_matrix(a.in[I_WIN], 1024, 7872, W_IN, 7936, 2, scr, tid);
            xpose_matrix(a.in[I_WSO], 2048, 1024, W_SO, 1024, 0, scr, tid);
            xpose_matrix(a.in[I_WUQ], 384, 1536, W_UQ, 1536, 3, scr, tid);
            xpose_matrix(a.in[I_WUKV], 256, 2048, W_K, 1024, 4, scr, tid);
            xpose_matrix(a.in[I_WUKV], 256, 2048, W_V, 1024, 5, scr, tid);
            xpose_matrix(a.in[I_WMO], 1024, 1024, W_MO, 1024, 0, scr, tid);
            xpose_matrix(a.in[I_WMIX], 1024, 1024, W_MIX, 1024, 0, scr, tid);
            __syncthreads();
            bf16_t* xn = (bf16_t*)(ws + WS_U);
            for (int row = gw; row < R1; row += 2 * NGW) { const int r1 = row + NGW; if (r1 < R1) norm_row2_bf16(xrow(rm, row), xrow(rm, r1), a.in[I_F1N], xn + (size_t)row * D, xn + (size_t)r1 * D, lane); else norm_row_bf16(xrow(rm, row), a.in[I_F1N], xn + (size_t)row * D, lane); }
            float* rope = (float*)(ws + WS_ROPE);
            for (int e = blockIdx.x * 512 + tid; e < 16400 * 16; e += gridDim.x * 512) { const int i = e & 15, pos = (e >> 4) - 16;
                const float inv = __builtin_amdgcn_exp2f(-(float)i * 0.83048202372184058f); const float ang = (float)pos * inv;
                double rev = (double)ang * 0.15915494309189535; rev -= __builtin_rint(rev); const float r = (float)rev;
                rope[2 * e] = __builtin_amdgcn_cosf(r); rope[2 * e + 1] = __builtin_amdgcn_sinf(r); }
        } SEAM(0); }
#ifdef TIME_PHASE
        if (TIME_PHASE == 0) t_b = __builtin_amdgcn_s_memrealtime();
#endif
#ifdef TIME_PHASE
        if (TIME_PHASE == 1) t_a = __builtin_amdgcn_s_memrealtime();
#endif
        if (IN(1)) { { EpiSwiglu E{(bf16_t*)(ws + WS_ACT)}; run_gemm(L, (const bf16_t*)(ws + WS_U), W_GU, R1, 2 * FFN, 1024, E, wave); } SEAM(1); }
#ifdef TIME_PHASE
        if (TIME_PHASE == 1) t_b = __builtin_amdgcn_s_memrealtime();
#endif
#ifdef TIME_PHASE
        if (TIME_PHASE == 2) t_a = __builtin_amdgcn_s_memrealtime();
#endif
        if (IN(2)) { { ElResid T{rm, 0.5f, 0}; tail_gemm((const bf16_t*)(ws + WS_ACT), W_D, FFN, 32768, R1, T, wave); EpiResid E{rm, 0.5f, 0}; run_gemm(L, (const bf16_t*)(ws + WS_ACT), W_D, 32768, 1024, FFN, E, wave); } SEAM(2); }
#ifdef TIME_PHASE
        if (TIME_PHASE == 2) t_b = __builtin_amdgcn_s_memrealtime();
#endif
#ifdef TIME_PHASE
        if (TIME_PHASE == 3) t_a = __builtin_amdgcn_s_memrealtime();
#endif
        if (IN(3)) { { TIDS
            bf16_t* un = (bf16_t*)(ws + WS_U);
            for (int row = gw; row < R1; row += 2 * NGW) { const int r1 = row + NGW; if (r1 < R1) norm_row2_bf16(hrow(rm, row), hrow(rm, r1), a.in[I_MIXN], un + (size_t)row * D, un + (size_t)r1 * D, lane); else norm_row_bf16(hrow(rm, row), a.in[I_MIXN], un + (size_t)row * D, lane); }
            LAS float* scr = (LAS float*)L;
            xpose_matrix(a.in[I_F2GU], 1024, 2 * FFN, W_GU, 2 * FFN, 1, scr, tid);
            xpose_matrix(a.in[I_F2D], FFN, 1024, W_D, 1024, 0, scr, tid);
            __syncthreads();
        } SEAM(3); }
#ifdef TIME_PHASE
        if (TIME_PHASE == 3) t_b = __builtin_amdgcn_s_memrealtime();
#endif
#ifdef TIME_PHASE
        if (TIME_PHASE == 4) t_a = __builtin_amdgcn_s_memrealtime();
#endif
        if (IN(4)) { { EpiProj E{(bf16_t*)(ws + WS_Z), (bf16_t*)(ws + WS_X), (bf16_t*)(ws + WS_MISC), (bf16_t*)(ws + WS_HALO), a.out};
                  run_gemm(L, (const bf16_t*)(ws + WS_U), W_IN, R1, 5888, 1024, E, wave); } SEAM(4); }
#ifdef TIME_PHASE
        if (TIME_PHASE == 4) t_b = __builtin_amdgcn_s_memrealtime();
#endif
#ifdef TIME_PHASE
        if (TIME_PHASE == 5) t_a = __builtin_amdgcn_s_memrealtime();
#endif
        if (IN(5)) { p5_phase(a, wave); SEAM(5); }
#ifdef TIME_PHASE
        if (TIME_PHASE == 5) t_b = __builtin_amdgcn_s_memrealtime();
#endif
#ifdef TIME_PHASE
        if (TIME_PHASE == 6) t_a = __builtin_amdgcn_s_memrealtime();
#endif
        if (IN(6)) { p6_phase(a, L, wave); SEAM(6); }
#ifdef TIME_PHASE
        if (TIME_PHASE == 6) t_b = __builtin_amdgcn_s_memrealtime();
#endif
#ifdef TIME_PHASE
        if (TIME_PHASE == 7) t_a = __builtin_amdgcn_s_memrealtime();
#endif
        if (IN(7)) { p7_phase(a, wave); SEAM(7); }
#ifdef TIME_PHASE
        if (TIME_PHASE == 7) t_b = __builtin_amdgcn_s_memrealtime();
#endif
#ifdef TIME_PHASE
        if (TIME_PHASE == 8) t_a = __builtin_amdgcn_s_memrealtime();
#endif
        if (IN(8)) { p8_phase(a, L, wave); SEAM(8); }
#ifdef TIME_PHASE
        if (TIME_PHASE == 8) t_b = __builtin_amdgcn_s_memrealtime();
#endif
#ifdef TIME_PHASE
        if (TIME_PHASE == 9) t_a = __builtin_amdgcn_s_memrealtime();
#endif
        if (IN(9)) { { ElBf16 T{(bf16_t*)(ws + WS_YS), 1024}; tail_gemm((const bf16_t*)(ws + WS_Z), W_SO, 2048, 32768, R2, T, wave); EpiBf16 E{(bf16_t*)(ws + WS_YS), 1024, 1.0f}; run_gemm(L, (const bf16_t*)(ws + WS_Z), W_SO, 32768, 1024, 2048, E, wave); } SEAM(9); }
#ifdef TIME_PHASE
        if (TIME_PHASE == 9) t_b = __builtin_amdgcn_s_memrealtime();
#endif
#ifdef TIME_PHASE
        if (TIME_PHASE == 10) t_a = __builtin_amdgcn_s_memrealtime();
#endif
        if (IN(10)) { {
            for (int gi = 0; gi < 3; ++gi) {
                const bf16_t* A = gi == 0 ? (const bf16_t*)(ws + WS_CQN) : (gi == 1 ? (const bf16_t*)(ws + WS_CKVB) : W_V);
                const bf16_t* B = gi == 0 ? W_UQ : (gi == 1 ? W_K : (const bf16_t*)(ws + WS_CKVB));
                const int M = gi == 0 ? R2 : (gi == 1 ? RK : 1024), N = gi == 0 ? 1536 : (gi == 1 ? 1024 : RK), K = gi == 0 ? 384 : 256;
                EpiBf16 E{gi == 0 ? (bf16_t*)(ws + WS_Q) : (gi == 1 ? (bf16_t*)(ws + WS_KN) : (bf16_t*)(ws + WS_VT)), N, gi == 0 ? QSCALE : 1.0f};
                run_gemm(L, A, B, M, N, K, E, wave);
            }
        } SEAM(10); }
#ifdef TIME_PHASE
        if (TIME_PHASE == 10) t_b = __builtin_amdgcn_s_memrealtime();
#endif
#ifdef TIME_PHASE
        if (TIME_PHASE == 11) t_a = __builtin_amdgcn_s_memrealtime();
#endif
        if (IN(11)) { p11_phase(a, L, wave); SEAM(11); }
#ifdef TIME_PHASE
        if (TIME_PHASE == 11) t_b = __builtin_amdgcn_s_memrealtime();
#endif
#ifdef TIME_PHASE
        if (TIME_PHASE == 12) t_a = __builtin_amdgcn_s_memrealtime();
#endif
        if (IN(12)) { { TIDS bf16_t* un = (bf16_t*)(ws + WS_Z); for (int row = gw; row < R2; row += 2 * NGW) { const int r1 = row + NGW; if (r1 < R2) norm_row2_bf16(hrow(rm, row), hrow(rm, r1), a.in[I_MIXN], un + (size_t)row * D, un + (size_t)r1 * D, lane); else norm_row_bf16(hrow(rm, row), a.in[I_MIXN], un + (size_t)row * D, lane); } } SEAM(12); }
#ifdef TIME_PHASE
        if (TIME_PHASE == 12) t_b = __builtin_amdgcn_s_memrealtime();
#endif
#ifdef TIME_PHASE
        if (TIME_PHASE == 13) t_a = __builtin_amdgcn_s_memrealtime();
#endif
        if (IN(13)) { { EpiGate E{(bf16_t*)(ws + WS_G), a.in[I_GBIAS]}; run_gemm(L, (const bf16_t*)(ws + WS_Z), W_IN + (size_t)5888 * 1024, R2, 2048, 1024, E, wave); } SEAM(13); }
#ifdef TIME_PHASE
        if (TIME_PHASE == 13) t_b = __builtin_amdgcn_s_memrealtime();
#endif
#ifdef TIME_PHASE
        if (TIME_PHASE == 14) t_a = __builtin_amdgcn_s_memrealtime();
#endif
        if (IN(14)) { { ElMerge T{(const bf16_t*)(ws + WS_G), (bf16_t*)(ws + WS_YS)}; tail_gemm((const bf16_t*)(ws + WS_O), W_MO, 1024, 32768, R2, T, wave); EpiMerge E{(const bf16_t*)(ws + WS_G), (bf16_t*)(ws + WS_YS)}; run_gemm(L, (const bf16_t*)(ws + WS_O), W_MO, 32768, 1024, 1024, E, wave); } SEAM(14); }
#ifdef TIME_PHASE
        if (TIME_PHASE == 14) t_b = __builtin_amdgcn_s_memrealtime();
#endif
#ifdef TIME_PHASE
        if (TIME_PHASE == 15) t_a = __builtin_amdgcn_s_memrealtime();
#endif
        if (IN(15)) { { ElResid T{rm, 1.0f, 1}; tail_gemm((const bf16_t*)(ws + WS_YS), W_MIX, 1024, 32768, R2, T, wave); EpiResid E{rm, 1.0f, 1}; run_gemm(L, (const bf16_t*)(ws + WS_YS), W_MIX, 32768, 1024, 1024, E, wave); } SEAM(15); }
#ifdef TIME_PHASE
        if (TIME_PHASE == 15) t_b = __builtin_amdgcn_s_memrealtime();
#endif
#ifdef TIME_PHASE
        if (TIME_PHASE == 16) t_a = __builtin_amdgcn_s_memrealtime();
#endif
        if (IN(16)) { { TIDS bf16_t* hn = (bf16_t*)(ws + WS_Z); for (int row = gw; row < R2; row += 2 * NGW) { const int r1 = row + NGW; if (r1 < R2) norm_row2_bf16(hrow(rm, row), hrow(rm, r1), a.in[I_F2N], hn + (size_t)row * D, hn + (size_t)r1 * D, lane); else norm_row_bf16(hrow(rm, row), a.in[I_F2N], hn + (size_t)row * D, lane); } } SEAM(16); }
#ifdef TIME_PHASE
        if (TIME_PHASE == 16) t_b = __builtin_amdgcn_s_memrealtime();
#endif
#ifdef TIME_PHASE
        if (TIME_PHASE == 17) t_a = __builtin_amdgcn_s_memrealtime();
#endif
        if (IN(17)) { { EpiSwiglu E{(bf16_t*)(ws + WS_ACT)}; run_gemm(L, (const bf16_t*)(ws + WS_Z), W_GU, R2, 2 * FFN, 1024, E, wave); } SEAM(17); }
#ifdef TIME_PHASE
        if (TIME_PHASE == 17) t_b = __builtin_amdgcn_s_memrealtime();
#endif
#ifdef TIME_PHASE
        if (TIME_PHASE == 18) t_a = __builtin_amdgcn_s_memrealtime();
#endif
        if (IN(18)) { { ElResid T{rm, 0.5f, 1}; tail_gemm((const bf16_t*)(ws + WS_ACT), W_D, FFN, 32768, R2, T, wave); EpiResid E{rm, 0.5f, 1}; run_gemm(L, (const bf16_t*)(ws + WS_ACT), W_D, 32768, 1024, FFN, E, wave); } SEAM(18); }
#ifdef TIME_PHASE
        if (TIME_PHASE == 18) t_b = __builtin_amdgcn_s_memrealtime();
#endif
#ifdef TIME_PHASE
        if (TIME_PHASE == 19) t_a = __builtin_amdgcn_s_memrealtime();
#endif
        if (IN(19)) { { TIDS
            for (int row = gw; row < R2; row += NGW) { float* hp = a.out + (size_t)row * D; f32x4 v[4]; float s = 0.f;
#pragma unroll
                for (int j = 0; j < 4; ++j) { v[j] = ((const f32x4*)hp)[lane + 64 * j]; s += v[j][0] * v[j][0] + v[j][1] * v[j][1] + v[j][2] * v[j][2] + v[j][3] * v[j][3]; }
                const float rs = rsqrtf(wave_sum(s) * (1.f / 1024.f) + EPS);
#pragma unroll
                for (int j = 0; j < 4; ++j) { const f32x4 g = ((const f32x4*)a.in[I_FINN])[lane + 64 * j]; ((f32x4*)hp)[lane + 64 * j] = v[j] * rs * g; } }
        } SEAM(19); }
#ifdef TIME_PHASE
        if (TIME_PHASE == 19) t_b = __builtin_amdgcn_s_memrealtime();
#endif
        }
    }
#ifdef TIME_PHASE
    if (blockIdx.x == 0 && threadIdx.x == 0) a.out[0] = (float)(t_b - t_a) * 0.01f;
#endif
    __builtin_amdgcn_fence(__ATOMIC_RELEASE, "agent");
}

#ifndef N_LAUNCH_MODE
#define N_LAUNCH_MODE 1
#endif
extern "C" void kernel_launch(void* const* d_in, const int* in_sizes, int n_in, void* d_out, int out_size, void* d_ws, size_t ws_size, hipStream_t stream) {
    static int grid = 0;
    if (grid == 0) {
        if (n_in != 30 || ws_size < WS_END) { fprintf(stderr, "kernel_launch: unexpected n_in %d / ws_size %zu (need %zu)\n", n_in, ws_size, (size_t)WS_END); grid = -1; return; }
        int dev = 0, cus = 0, per_cu = 0;
        hipGetDevice(&dev); hipDeviceGetAttribute(&cus, hipDeviceAttributeMultiprocessorCount, dev);
        if (hipFuncSetAttribute((const void*)fwd_megakernel, hipFuncAttributeMaxDynamicSharedMemorySize, LDS_BYTES) != hipSuccess) { fprintf(stderr, "kernel_launch: hipFuncSetAttribute failed\n"); grid = -1; return; }
        if (hipOccupancyMaxActiveBlocksPerMultiprocessor(&per_cu, (const void*)fwd_megakernel, 512, LDS_BYTES) != hipSuccess || per_cu < 1) per_cu = 1;
        (void)hipGetLastError();
        grid = cus * 1;
        if (grid <= 0) grid = 256;
    }
    if (grid < 0) return;
    Args a{};
    for (int i = 0; i < 30; ++i) a.in[i] = (const float*)d_in[i];
    a.out = (float*)d_out; a.ws = (unsigned char*)d_ws;
#if N_LAUNCH_MODE == 1
    a.ph_lo = 0; a.ph_hi = NPHASE;
    if (hipMemsetAsync((unsigned char*)d_ws + WS_BAR, 0, 8192, stream) != hipSuccess) { fprintf(stderr, "memset failed\n"); return; }
    void* args[] = {&a};
    hipError_t e = hipLaunchCooperativeKernel((const void*)fwd_megakernel, dim3(grid), dim3(512), args, LDS_BYTES, stream);
    if (e != hipSuccess) fprintf(stderr, "cooperative launch failed: %s (grid %d)\n", hipGetErrorString(e), grid);
#else
    for (int ph = 0; ph < NPHASE; ++ph) { a.ph_lo = ph; a.ph_hi = ph + 1; hipLaunchKernelGGL(fwd_megakernel, dim3(grid), dim3(512), LDS_BYTES, stream, a); }
#endif
}
```

```cpp
#include <hip/hip_runtime.h>
#include <hip/hip_cooperative_groups.h>
#include <cstdio>
#include <cstdint>
namespace cg = cooperative_groups;
namespace pg8 {
#define PG8_LAS __attribute__((address_space(3)))
typedef unsigned short bf16_t;
typedef short bf16x8 __attribute__((ext_vector_type(8)));
typedef float f32x4 __attribute__((ext_vector_type(4)));
typedef unsigned u32x4 __attribute__((ext_vector_type(4)));
constexpr int BM = 256, BK = 64, HALF = 128, HTB = HALF * BK * 2  , STAGE_BYTES = 8 * HTB, NXCD = 8, WGM = 8;

__host__ __device__ __forceinline__ int lds_byte(int r, int c) { const int st = (r >> 4) * 2 + (c >> 5), rr = r & 15, cc = c & 31, ob = rr * 64 + cc * 2; return st * 1024 + (ob ^ (((ob >> 9) & 1) << 5)); }
__host__ __device__ __forceinline__ void stage_rc(int b, int& R, int& C) { const int st = b / 1024, sb = b % 1024, swz = sb ^ (((sb >> 9) & 1) << 5); R = (st >> 1) * 16 + swz / 64; C = (st & 1) * 32 + (swz % 64) / 2; }
__host__ __device__ __forceinline__ int perm32(int rho) { const int n = rho >> 4, i = rho & 15; return 8 * (i >> 2) + 4 * n + (i & 3); }

struct Unit { int pm, pn; };
struct Gemm { const bf16_t* A; const bf16_t* Bt; int M, N, K; };

struct StaticOrder {
    int nM, nN, nwg, G, c;
    __host__ __device__ void init(int M, int N, int G_, int c_) { nM = M / BM; nN = N / BM; nwg = nM * nN; G = G_; c = c_; }
    __host__ __device__ bool next(int i, Unit& u) const {
        const long L = (long)i * G + c; if (L >= nwg) return false;
        int wgid = (int)L; { const int q = nwg / NXCD, r = nwg % NXCD, xcd = wgid % NXCD, off = wgid / NXCD; wgid = (xcd < r ? xcd * (q + 1) : r * (q + 1) + (xcd - r) * q) + off; }
        const int nig = WGM * nN, gid = wgid / nig, fm = gid * WGM, gsz = (nM - fm) < WGM ? (nM - fm) : WGM;
        u.pm = fm + ((wgid % nig) % gsz); u.pn = (wgid % nig) / gsz; return true;
    }
    __device__ __forceinline__ void a_ready(const Unit&) const {}
    __device__ __forceinline__ void done(const Unit&) const {}
};
template <class Epi, class Sched, bool ALIGN_EPI = false, bool SP2 = false>
__device__ __forceinline__ void gemm_phase(PG8_LAS unsigned char* lds, const Gemm g, const Sched& S, const Epi& E, const int wid) {
    const int lane = (int)(__builtin_amdgcn_mbcnt_hi(~0u, __builtin_amdgcn_mbcnt_lo(~0u, 0u)) & 63u), tid = wid * 64 + lane, wr = wid >> 2, wc = wid & 3, fr = lane & 15, fq = lane >> 4;
    const int K = g.K, nt = K / BK;
    unsigned voffA[2], voffB[2];
#pragma unroll
    for (int i = 0; i < 2; ++i) { int R, C; stage_rc(tid * 16 + i * 8192, R, C); const int Rb = Epi::PERM ? ((R & ~31) + perm32(R & 31)) : R;
        voffA[i] = (unsigned)(R * K + C) * 2u; voffB[i] = (unsigned)(Rb * K + C) * 2u; }
    const size_t kstep = (size_t)(BK * 2);
    const size_t hstep = (size_t)HALF * K * 2;
    const size_t tstep = 2 * hstep;
    const unsigned ldsw = (unsigned)wid * 1024u;
    const int aoff = lds_byte(wr * 64 + fr, fq * 8), boff = lds_byte(wc * 32 + fr, fq * 8);
#define PG8_SA(b, h) (((b) * 2 + (h)) * HTB)
#define PG8_SB(b, h) ((4 + (b) * 2 + (h)) * HTB)
#define PG8_STAGE(bufoff, gbase, voff) do { _Pragma("unroll") for (int _i = 0; _i < 2; ++_i) \
        __builtin_amdgcn_global_load_lds((const unsigned*)((const char*)(gbase) + (voff)[_i]), (PG8_LAS unsigned*)(lds + (bufoff) + ldsw + _i * 8192), 16, 0, 0); } while (0)
#define PG8_LDA(dst, b, h) do { _Pragma("unroll") for (int m = 0; m < 4; ++m) _Pragma("unroll") for (int k = 0; k < 2; ++k) dst[m][k] = *(const PG8_LAS bf16x8*)(lds + PG8_SA(b, h) + aoff + m * 2048 + k * 1024); } while (0)
#define PG8_LDB(dst, b, h) do { _Pragma("unroll") for (int n = 0; n < 2; ++n) _Pragma("unroll") for (int k = 0; k < 2; ++k) dst[n][k] = *(const PG8_LAS bf16x8*)(lds + PG8_SB(b, h) + boff + n * 2048 + k * 1024); } while (0)
#define PG8_MMA(ai, bj, At, Bt) do { __builtin_amdgcn_s_setprio(1); _Pragma("unroll") for (int m = 0; m < 4; ++m) _Pragma("unroll") for (int n = 0; n < 2; ++n) _Pragma("unroll") for (int k = 0; k < 2; ++k) \
        acc[ai][bj][m][n] = __builtin_amdgcn_mfma_f32_16x16x32_bf16(Bt[n][k], At[m][k], acc[ai][bj][m][n], 0, 0, 0); __builtin_amdgcn_s_setprio(0); } while (0)
#define PG8_WAIT_V(n) asm volatile("s_waitcnt vmcnt(" #n ")" ::: "memory")
#define PG8_WAIT_L(n) asm volatile("s_waitcnt lgkmcnt(" #n ")" ::: "memory")
#define PG8_BAR __builtin_amdgcn_s_barrier()
#define PG8_SCHED __builtin_amdgcn_sched_barrier(0)
    Unit cur, nxt; int ui = 0;
    if (!S.next(0, cur)) return;
    f32x4 acc[2][2][4][2];
#pragma unroll
    for (int a = 0; a < 2; ++a)
#pragma unroll
        for (int b = 0; b < 2; ++b)
#pragma unroll
            for (int m = 0; m < 4; ++m)
#pragma unroll
                for (int n = 0; n < 2; ++n) acc[a][b][m][n] = (f32x4){0.f, 0.f, 0.f, 0.f};
    bf16x8 At[4][2], B0[2][2], B1[2][2];
    const char* cA = (const char*)g.A + (size_t)cur.pm * tstep; const char* cB = (const char*)g.Bt + (size_t)cur.pn * tstep;
    S.a_ready(cur);
    if constexpr (SP2) {
        PG8_STAGE(PG8_SB(0, 0), cB, voffB); PG8_STAGE(PG8_SB(0, 1), cB + hstep, voffB); PG8_STAGE(PG8_SA(0, 0), cA, voffA); PG8_STAGE(PG8_SA(0, 1), cA + hstep, voffA);
        if (wr == 1) PG8_BAR;
        PG8_WAIT_V(2); PG8_BAR;
        PG8_STAGE(PG8_SB(1, 0), cB + kstep, voffB); PG8_STAGE(PG8_SA(1, 0), cA + kstep, voffA); PG8_STAGE(PG8_SB(1, 1), cB + hstep + kstep, voffB);
        PG8_WAIT_V(6); PG8_BAR;
    } else {
        PG8_STAGE(PG8_SB(0, 0), cB, voffB); PG8_STAGE(PG8_SA(0, 0), cA, voffA); PG8_STAGE(PG8_SB(0, 1), cB + hstep, voffB); PG8_STAGE(PG8_SA(0, 1), cA + hstep, voffA);
        if (wr == 1) PG8_BAR;
        PG8_WAIT_V(4); PG8_BAR;
        PG8_STAGE(PG8_SB(1, 0), cB + kstep, voffB); PG8_STAGE(PG8_SA(1, 0), cA + kstep, voffA); PG8_STAGE(PG8_SB(1, 1), cB + hstep + kstep, voffB);
        PG8_WAIT_V(6); PG8_BAR;
    }
    for (;;) {
        const bool has_next = S.next(ui + 1, nxt);
        const char* nA = has_next ? (const char*)g.A + (size_t)nxt.pm * tstep : cA; const char* nB = has_next ? (const char*)g.Bt + (size_t)nxt.pn * tstep : cB;
        for (int t = 0; t < nt; t += 2) {
            const bool last = (t == nt - 2);
            const char* a1 = cA + (size_t)(t + 1) * kstep;
            const char* a2 = last ? nA : cA + (size_t)(t + 2) * kstep; const char* b2 = last ? nB : cB + (size_t)(t + 2) * kstep;
            const char* a3 = a2 + kstep; const char* b3 = b2 + kstep;
            if (last && has_next) S.a_ready(nxt);
            if constexpr (SP2) {
            PG8_LDB(B0, 0, 0); PG8_LDB(B1, 0, 1); PG8_SCHED; PG8_LDA(At, 0, 0); PG8_STAGE(PG8_SA(1, 1), a1 + hstep, voffA);
            PG8_WAIT_V(8); PG8_WAIT_L(0); PG8_BAR; PG8_MMA(0, 0, At, B0); PG8_MMA(0, 1, At, B1); PG8_BAR; PG8_SCHED;
            PG8_LDA(At, 0, 1); PG8_STAGE(PG8_SB(0, 0), b2, voffB); PG8_STAGE(PG8_SB(0, 1), b2 + hstep, voffB); PG8_STAGE(PG8_SA(0, 0), a2, voffA);
            PG8_WAIT_V(8); PG8_WAIT_L(0); PG8_BAR; PG8_MMA(1, 0, At, B0); PG8_MMA(1, 1, At, B1); PG8_BAR; PG8_SCHED;
            PG8_LDB(B0, 1, 0); PG8_LDB(B1, 1, 1); PG8_SCHED; PG8_LDA(At, 1, 0); PG8_STAGE(PG8_SA(0, 1), a2 + hstep, voffA);
            PG8_WAIT_V(8); PG8_WAIT_L(0); PG8_BAR; PG8_MMA(0, 0, At, B0); PG8_MMA(0, 1, At, B1); PG8_BAR; PG8_SCHED;
            PG8_LDA(At, 1, 1); PG8_STAGE(PG8_SB(1, 0), b3, voffB); PG8_STAGE(PG8_SB(1, 1), b3 + hstep, voffB); PG8_STAGE(PG8_SA(1, 0), a3, voffA);
            PG8_WAIT_V(8); PG8_WAIT_L(0); PG8_BAR; PG8_MMA(1, 0, At, B0); PG8_MMA(1, 1, At, B1); PG8_BAR; PG8_SCHED;
            } else {
            PG8_LDB(B0, 0, 0); PG8_SCHED; PG8_LDA(At, 0, 0); PG8_STAGE(PG8_SA(1, 1), a1 + hstep, voffA);
            PG8_WAIT_L(8); PG8_BAR; PG8_WAIT_L(0); PG8_MMA(0, 0, At, B0); PG8_BAR; PG8_SCHED;
            PG8_LDB(B1, 0, 1); PG8_STAGE(PG8_SB(0, 0), b2, voffB);
            PG8_BAR; PG8_WAIT_L(0); PG8_MMA(0, 1, At, B1); PG8_BAR;
            PG8_LDA(At, 0, 1); PG8_STAGE(PG8_SA(0, 0), a2, voffA);
            PG8_BAR; PG8_WAIT_L(0); PG8_MMA(1, 0, At, B0); PG8_BAR; PG8_SCHED;
            PG8_STAGE(PG8_SB(0, 1), b2 + hstep, voffB);
            PG8_WAIT_V(6); PG8_BAR; PG8_MMA(1, 1, At, B1); PG8_BAR;
            PG8_LDB(B0, 1, 0); PG8_SCHED; PG8_LDA(At, 1, 0); PG8_STAGE(PG8_SA(0, 1), a2 + hstep, voffA);
            PG8_WAIT_L(8); PG8_BAR; PG8_WAIT_L(0); PG8_MMA(0, 0, At, B0); PG8_BAR; PG8_SCHED;
            PG8_LDB(B1, 1, 1); PG8_STAGE(PG8_SB(1, 0), b3, voffB);
            PG8_BAR; PG8_WAIT_L(0); PG8_MMA(0, 1, At, B1); PG8_BAR;
            PG8_LDA(At, 1, 1); PG8_STAGE(PG8_SA(1, 0), a3, voffA);
            PG8_BAR; PG8_WAIT_L(0); PG8_MMA(1, 0, At, B0); PG8_BAR; PG8_SCHED;
            PG8_STAGE(PG8_SB(1, 1), b3 + hstep, voffB);
            PG8_WAIT_V(6); PG8_BAR; PG8_MMA(1, 1, At, B1); PG8_BAR;
            }
        }
        if constexpr (ALIGN_EPI) { if (wr == 0) PG8_BAR; }
        if constexpr (!Epi::AFTER_DRAIN) { E(acc, cur, wr, wc, fr, fq); S.done(cur); }
        if (!has_next) break;
#pragma unroll
        for (int a = 0; a < 2; ++a)
#pragma unroll
            for (int b = 0; b < 2; ++b)
#pragma unroll
                for (int m = 0; m < 4; ++m)
#pragma unroll
                    for (int n = 0; n < 2; ++n) acc[a][b][m][n] = (f32x4){0.f, 0.f, 0.f, 0.f};
        cur = nxt; cA = nA; cB = nB; ++ui;
        if constexpr (ALIGN_EPI) { if (wr == 1) PG8_BAR; }
    }
    PG8_WAIT_V(0);
    if constexpr (!ALIGN_EPI) { if (wr == 0) PG8_BAR; }
    PG8_BAR;
    if constexpr (Epi::AFTER_DRAIN) { E.fused(acc, cur, wr, wc, fr, fq, lds, wid, lane); S.done(cur); }
#undef PG8_SA
#undef PG8_SB
#undef PG8_STAGE
#undef PG8_LDA
#undef PG8_LDB
#undef PG8_MMA
#undef PG8_WAIT_V
#undef PG8_WAIT_L
#undef PG8_BAR
#undef PG8_SCHED
}
}
using namespace pg8;
#define LAS __attribute__((address_space(3)))
typedef short v4i16_t __attribute__((ext_vector_type(4)));
typedef unsigned u32x2 __attribute__((ext_vector_type(2)));
typedef float f32x2 __attribute__((ext_vector_type(2)));

constexpr int D = 1024, FFN = 2816;
constexpr int R_S0 = 32768;
constexpr int R_M0 = 33280;
constexpr int R_ACT = 33296;
constexpr int R1 = 33536;
constexpr int R2 = 33280;
constexpr int RK = 49920;
constexpr int R_C0 = 33536;
constexpr int NCHUNK = 146;
constexpr float EPS = 1e-6f;
constexpr float QSCALE = 0.14724448f;

constexpr size_t MiB = 1048576;
constexpr size_t WS_W_IN = 0, WS_W_GU = 16252928, WS_W_D = 27787264, WS_W_SO = 33554432, WS_W_UQ = 37748736, WS_W_K = 38928384, WS_W_V = 39452672,
                 WS_W_MO = 39976960, WS_W_MIX = 42074112, WS_ROPE = 44171264, WS_HMETA = 46270464, WS_KRB = 47319040, WS_TOT = 50513920, WS_BAR = 50540544;
constexpr size_t WS_Z = 49 * MiB, WS_X = 180 * MiB, WS_U = 376 * MiB + MiB / 2, WS_MISC = 442 * MiB, WS_HALO = WS_MISC + (size_t)R1 * 768 * 2;
constexpr size_t WS_DT = WS_U, WS_ACS = WS_U + 4292608, WS_CQN = WS_U + 8585216, WS_CKVB = WS_U + 34144256, WS_S = WS_U + 57 * MiB;
constexpr size_t WS_YS = 447 * MiB, WS_Q = WS_Z, WS_KN = WS_X, WS_VT = WS_X + 102236160, WS_O = WS_U, WS_G = WS_X, WS_ACT = WS_X;
constexpr size_t WS_END = 512 * MiB;
static_assert(WS_S + (size_t)NCHUNK * 32 * 8192 * 2 <= WS_END && WS_O + (size_t)R2 * 1024 * 2 <= WS_YS && WS_YS + (size_t)R2 * 1024 * 2 <= WS_END, "ws map 4");
static_assert(WS_END <= 512 * MiB, "ws map");
static_assert(WS_CKVB + (size_t)RK * 256 * 2 <= WS_S, "ws map 2");
static_assert(WS_HALO + 514 * 3 * 3072 * 2 <= 512 * MiB, "ws map 3");

constexpr size_t OUT_YP = 0, OUT_YS = 33554432, OUT_CKVP = 34078720, OUT_KRP = 42475520, OUT_SSMP = 43525120, OUT_CONVP = 44049408,
                 OUT_CKVS = 44067840, OUT_KRS = 44198912, OUT_SSMS = 44215296, OUT_CONVS = 48409600;

enum { I_XP = 0, I_XS, I_CCKV, I_CKR, I_SSSM, I_SCONV, I_META, I_F1N, I_F1GU, I_F1D, I_MIXN, I_WIN, I_GBIAS, I_CONVW, I_CONVB, I_DTB, I_ALOG, I_SSMD,
       I_SSMN, I_WSO, I_QN, I_WUQ, I_KVN, I_WUKV, I_WMO, I_WMIX, I_F2N, I_F2GU, I_F2D, I_FINN };

struct Args { const float* in[30]; float* out; unsigned char* ws; int ph_lo, ph_hi; };

__device__ __forceinline__ unsigned f2bf(float f) { unsigned u = __builtin_bit_cast(unsigned, f); return (u + 0x7fffu + ((u >> 16) & 1u)) >> 16; }
typedef float f32x2_t __attribute__((ext_vector_type(2))); typedef __bf16 bf16x2_t __attribute__((ext_vector_type(2)));
__device__ __forceinline__ unsigned cvtpk(float lo, float hi) { f32x2_t v = {lo, hi}; bf16x2_t b = __builtin_convertvector(v, bf16x2_t); return __builtin_bit_cast(unsigned, b); }
__device__ __forceinline__ float bflo(unsigned u) { return __builtin_bit_cast(float, u << 16); }
__device__ __forceinline__ float bfhi(unsigned u) { return __builtin_bit_cast(float, u & 0xffff0000u); }
__device__ __forceinline__ float bf2f(bf16_t b) { return __builtin_bit_cast(float, (unsigned)b << 16); }
__device__ __forceinline__ float wave_sum(float v) {
#pragma unroll
    for (int o = 1; o < 64; o <<= 1) v += __shfl_xor(v, o);
    return v;
}
__device__ __forceinline__ float silu_f(float x) { return x * __builtin_amdgcn_rcpf(1.f + __expf(-x)); }
__device__ __forceinline__ float sigmoid_f(float x) { return __builtin_amdgcn_rcpf(1.f + __expf(-x)); }
__device__ __forceinline__ float softplus_f(float x) {
    const float e = __expf(x);
    const float sp = e < 0.02f ? e * (1.f - e * (0.5f - e * (0.33333334f - 0.25f * e))) : __logf(1.f + e);
    return x > 15.f ? x : sp;
}
__device__ __forceinline__ int pos_idx(int row) {
    if (row < R_S0) return (row & 16383) + 16;
    if (row < R_M0) return 1024 + ((row - R_S0) & 31) + 16;
    return row - R_M0;
}
__device__ __forceinline__ void chunk_info(int ci, int& row0, int& ntok) {
    if (ci < 130) { const int b = ci / 65, k = ci - b * 65; if (k == 0) { row0 = R_M0; ntok = 16; } else { row0 = b * 16384 + 256 * (k - 1); ntok = 256; } }
    else { row0 = R_S0 + 32 * (ci - 130); ntok = 32; }
}
__device__ __forceinline__ v4i16_t ldtr(const LAS bf16_t* p) { return __builtin_amdgcn_ds_read_tr16_b64_v4i16((LAS v4i16_t*)p); }
__device__ __forceinline__ bf16x8 cat8(v4i16_t a, v4i16_t b) { return __builtin_shufflevector(a, b, 0, 1, 2, 3, 4, 5, 6, 7); }
__device__ __forceinline__ bf16x8 cat8u(u32x2 a, u32x2 b) { u32x4 t = {a.x, a.y, b.x, b.y}; return __builtin_bit_cast(bf16x8, t); }
#define MFMA16(a, b, c) __builtin_amdgcn_mfma_f32_16x16x32_bf16((a), (b), (c), 0, 0, 0)

struct EpiSwiglu {
    static constexpr bool PERM = true, AFTER_DRAIN = false; bf16_t* O;
    __device__ __forceinline__ void operator()(const f32x4 (&acc)[2][2][4][2], const Unit& u, int wr, int wc, int fr, int fq) const {
        const int row0 = u.pm * 256 + wr * 64 + fr, col0 = u.pn * 128 + wc * 32 + 8 * fq;
#pragma unroll
        for (int ai = 0; ai < 2; ++ai)
#pragma unroll
            for (int m = 0; m < 4; ++m) {
                const f32x4 g0 = acc[ai][0][m][0], g1 = acc[ai][0][m][1], u0 = acc[ai][1][m][0], u1 = acc[ai][1][m][1];
                u32x4 w; w.x = cvtpk(silu_f(g0[0]) * u0[0], silu_f(g0[1]) * u0[1]); w.y = cvtpk(silu_f(g0[2]) * u0[2], silu_f(g0[3]) * u0[3]);
                w.z = cvtpk(silu_f(g1[0]) * u1[0], silu_f(g1[1]) * u1[1]); w.w = cvtpk(silu_f(g1[2]) * u1[2], silu_f(g1[3]) * u1[3]);
                *(u32x4*)(O + (size_t)(row0 + ai * 128 + m * 16) * FFN + col0) = w;
            }
    }
};
struct RowMap { float* out; float* hmeta; const float* xp; const float* xs; const float* meta; };
__device__ __forceinline__ float* hrow(const RowMap& a, int row) { return row < R2 ? a.out + (size_t)row * D : a.hmeta + (size_t)(row - R2) * D; }
__device__ __forceinline__ const float* xrow(const RowMap& a, int row) {
    if (row < R_S0) return a.xp + (size_t)row * D;
    if (row < R_M0) return a.xs + (size_t)(row - R_S0) * D;
    if (row < R_ACT) return a.meta + (size_t)(row - R_M0) * D;
    return nullptr;
}
struct EpiResid {
    static constexpr bool PERM = true, AFTER_DRAIN = false; RowMap a; float s; int mode;
    __device__ __forceinline__ void operator()(const f32x4 (&acc)[2][2][4][2], const Unit& u, int wr, int wc, int fr, int fq) const {
        const int row0 = u.pm * 256 + wr * 64 + fr, col0 = u.pn * 256 + wc * 32 + 8 * fq;
#pragma unroll
        for (int ai = 0; ai < 2; ++ai)
#pragma unroll
            for (int m = 0; m < 4; ++m) {
                const int row = row0 + ai * 128 + m * 16; float* hp = hrow(a, row); const float* bp = mode ? hp : xrow(a, row);
#pragma unroll
                for (int bj = 0; bj < 2; ++bj) {
                    const int c = col0 + bj * 128; f32x4 b0 = {0.f, 0.f, 0.f, 0.f}, b1 = b0;
                    if (bp) { b0 = *(const f32x4*)(bp + c); b1 = *(const f32x4*)(bp + c + 4); }
                    *(f32x4*)(hp + c) = b0 + acc[ai][bj][m][0] * s; *(f32x4*)(hp + c + 4) = b1 + acc[ai][bj][m][1] * s;
                }
            }
    }
};
struct EpiProj {
    static constexpr bool PERM = true, AFTER_DRAIN = false; bf16_t *Z, *X, *MISC, *HALO; float* out;
    __device__ __forceinline__ void operator()(const f32x4 (&acc)[2][2][4][2], const Unit& u, int wr, int wc, int fr, int fq) const {
        const int row0 = u.pm * 256 + wr * 64 + fr; const int pn = u.pn;
#pragma unroll
        for (int ai = 0; ai < 2; ++ai)
#pragma unroll
            for (int m = 0; m < 4; ++m) {
                const int row = row0 + ai * 128 + m * 16;
#pragma unroll
                for (int bj = 0; bj < 2; ++bj) {
                    const f32x4 v0 = acc[ai][bj][m][0], v1 = acc[ai][bj][m][1];
                    u32x4 w; w.x = cvtpk(v0[0], v0[1]); w.y = cvtpk(v0[2], v0[3]); w.z = cvtpk(v1[0], v1[1]); w.w = cvtpk(v1[2], v1[3]);
                    const int ct = bj * 128 + wc * 32 + 8 * fq;
                    if (pn < 8) { *(u32x4*)(Z + (size_t)row * 2048 + pn * 256 + ct) = w; }
                    else if (pn < 20) {
                        const int cx = (pn - 8) * 256 + ct;
                        *(u32x4*)(X + (size_t)row * 3072 + cx) = w;
                        if (row < R_S0) {
                            const int r6 = row & 63;
                            if (r6 >= 61) { const int T = (row >> 6) + 1; if (T & 255) *(u32x4*)(HALO + ((size_t)T * 3 + (r6 - 61)) * 3072 + cx) = w; }
                            const int t = row & 16383;
                            if (t >= 16381) { float* o = out + OUT_CONVP + ((size_t)(row >> 14) * 3 + (t - 16381)) * 3072 + cx; *(f32x4*)o = v0; *(f32x4*)(o + 4) = v1; }
                        } else if (row < R_M0) {
                            const int t = (row - R_S0) & 31, db = (row - R_S0) >> 5;
                            if (t >= 29) { float* o = out + OUT_CONVS + ((size_t)db * 3 + (t - 29)) * 3072 + cx; *(f32x4*)o = v0; *(f32x4*)(o + 4) = v1; }
                        } else if (row >= R_M0 + 13 && row < R_ACT) {
                            const int sl = row - R_M0 - 13;
                            *(u32x4*)(HALO + ((size_t)0 * 3 + sl) * 3072 + cx) = w; *(u32x4*)(HALO + ((size_t)256 * 3 + sl) * 3072 + cx) = w;
                        }
                    } else { *(u32x4*)(MISC + (size_t)row * 768 + (pn - 20) * 256 + ct) = w; }
                }
            }
    }
};
struct EpiBf16 {
    static constexpr bool PERM = true, AFTER_DRAIN = false; bf16_t* O; int ldc; float sc;
    __device__ __forceinline__ void operator()(const f32x4 (&acc)[2][2][4][2], const Unit& u, int wr, int wc, int fr, int fq) const {
        const int row0 = u.pm * 256 + wr * 64 + fr, col0 = u.pn * 256 + wc * 32 + 8 * fq;
#pragma unroll
        for (int ai = 0; ai < 2; ++ai)
#pragma unroll
            for (int m = 0; m < 4; ++m)
#pragma unroll
                for (int bj = 0; bj < 2; ++bj) {
                    const f32x4 v0 = acc[ai][bj][m][0] * sc, v1 = acc[ai][bj][m][1] * sc;
                    u32x4 w; w.x = cvtpk(v0[0], v0[1]); w.y = cvtpk(v0[2], v0[3]); w.z = cvtpk(v1[0], v1[1]); w.w = cvtpk(v1[2], v1[3]);
                    *(u32x4*)(O + (size_t)(row0 + ai * 128 + m * 16) * ldc + col0 + bj * 128) = w;
                }
    }
};
struct EpiGate {
    static constexpr bool PERM = true, AFTER_DRAIN = false; bf16_t* G; const float* bias;
    __device__ __forceinline__ void operator()(const f32x4 (&acc)[2][2][4][2], const Unit& u, int wr, int wc, int fr, int fq) const {
        const int row0 = u.pm * 256 + wr * 64 + fr, col0 = u.pn * 256 + wc * 32 + 8 * fq;
#pragma unroll
        for (int bj = 0; bj < 2; ++bj) {
            const int c = col0 + bj * 128; const f32x4 b0 = *(const f32x4*)(bias + c), b1 = *(const f32x4*)(bias + c + 4);
#pragma unroll
            for (int ai = 0; ai < 2; ++ai)
#pragma unroll
                for (int m = 0; m < 4; ++m) {
                    const f32x4 v0 = acc[ai][bj][m][0] + b0, v1 = acc[ai][bj][m][1] + b1;
                    u32x4 w; w.x = cvtpk(sigmoid_f(v0[0]), sigmoid_f(v0[1])); w.y = cvtpk(sigmoid_f(v0[2]), sigmoid_f(v0[3]));
                    w.z = cvtpk(sigmoid_f(v1[0]), sigmoid_f(v1[1])); w.w = cvtpk(sigmoid_f(v1[2]), sigmoid_f(v1[3]));
                    *(u32x4*)(G + (size_t)(row0 + ai * 128 + m * 16) * 2048 + c) = w;
                }
        }
    }
};
struct EpiMerge {
    static constexpr bool PERM = true, AFTER_DRAIN = false; const bf16_t* G; bf16_t* YS;
    __device__ __forceinline__ void operator()(const f32x4 (&acc)[2][2][4][2], const Unit& u, int wr, int wc, int fr, int fq) const {
        const int row0 = u.pm * 256 + wr * 64 + fr, col0 = u.pn * 256 + wc * 32 + 8 * fq;
#pragma unroll
        for (int ai = 0; ai < 2; ++ai)
#pragma unroll
            for (int m = 0; m < 4; ++m)
#pragma unroll
                for (int bj = 0; bj < 2; ++bj) {
                    const int row = row0 + ai * 128 + m * 16, c = col0 + bj * 128;
                    const u32x4 gs = *(const u32x4*)(G + (size_t)row * 2048 + c), gm = *(const u32x4*)(G + (size_t)row * 2048 + 1024 + c), ys = *(const u32x4*)(YS + (size_t)row * 1024 + c);
                    const f32x4 v0 = acc[ai][bj][m][0], v1 = acc[ai][bj][m][1];
                    u32x4 w;
                    w.x = cvtpk(bflo(gs.x) * bflo(ys.x) + bflo(gm.x) * v0[0], bfhi(gs.x) * bfhi(ys.x) + bfhi(gm.x) * v0[1]);
                    w.y = cvtpk(bflo(gs.y) * bflo(ys.y) + bflo(gm.y) * v0[2], bfhi(gs.y) * bfhi(ys.y) + bfhi(gm.y) * v0[3]);
                    w.z = cvtpk(bflo(gs.z) * bflo(ys.z) + bflo(gm.z) * v1[0], bfhi(gs.z) * bfhi(ys.z) + bfhi(gm.z) * v1[1]);
                    w.w = cvtpk(bflo(gs.w) * bflo(ys.w) + bflo(gm.w) * v1[2], bfhi(gs.w) * bfhi(ys.w) + bfhi(gm.w) * v1[3]);
                    *(u32x4*)(YS + (size_t)row * 1024 + c) = w;
                }
    }
};
__device__ __forceinline__ int lane_id() { return (int)(__builtin_amdgcn_mbcnt_hi(~0u, __builtin_amdgcn_mbcnt_lo(~0u, 0u)) & 63u); }
template <class Epi> __device__ __forceinline__ void run_gemm(LAS unsigned char* lds, const bf16_t* A, const bf16_t* Bt, int M, int N, int K, const Epi& E, int wave) {
    Gemm g{A, Bt, M, N, K}; StaticOrder S; S.init(M, N, (int)gridDim.x, (int)blockIdx.x);
    gemm_phase<Epi, StaticOrder, false, true>(lds, g, S, E, wave);
    __syncthreads();
}

struct ElResid { RowMap a; float s; int mode; __device__ __forceinline__ void operator()(int row, int col, float v) const {
    float* hp = hrow(a, row) + col; float b = 0.f; if (mode) b = *hp; else { const float* xp = xrow(a, row); if (xp) b = xp[col]; } *hp = b + s * v; } };
struct ElBf16 { bf16_t* O; int ldc; __device__ __forceinline__ void operator()(int row, int col, float v) const { O[(size_t)row * ldc + col] = (bf16_t)(cvtpk(v, 0.f) & 0xffffu); } };
struct ElMerge { const bf16_t* G; bf16_t* YS; __device__ __forceinline__ void operator()(int row, int col, float v) const {
    const float gs = bf2f(G[(size_t)row * 2048 + col]), gm = bf2f(G[(size_t)row * 2048 + 1024 + col]); bf16_t* p = YS + (size_t)row * 1024 + col; *p = (bf16_t)(cvtpk(gs * bf2f(*p) + gm * v, 0.f) & 0xffffu); } };
template <class El> __device__ __forceinline__ void tail_gemm(const bf16_t* A, const bf16_t* Bt, int K, int row_begin, int row_end, const El& E, int wave) {
    const int lane = lane_id(), li = lane & 15, quad = lane >> 4; const int gw = blockIdx.x * 8 + wave, NGW = gridDim.x * 8;
    const int total = ((row_end - row_begin) >> 4) * 64;
    for (int blk = gw; blk < total; blk += NGW) {
        const int rb = blk >> 6, cb = blk & 63;
        const bf16_t* ap = A + (size_t)(row_begin + 16 * rb + li) * K + 8 * quad; const bf16_t* bp = Bt + (size_t)(16 * cb + li) * K + 8 * quad;
        f32x4 acc = {0.f, 0.f, 0.f, 0.f};
        for (int k = 0; k < K; k += 256) { bf16x8 af[8], bf[8];
#pragma unroll
            for (int e = 0; e < 8; ++e) { af[e] = *(const bf16x8*)(ap + k + 32 * e); bf[e] = *(const bf16x8*)(bp + k + 32 * e); }
#pragma unroll
            for (int e = 0; e < 8; ++e) acc = MFMA16(af[e], bf[e], acc); }
#pragma unroll
        for (int j = 0; j < 4; ++j) E(row_begin + 16 * rb + 4 * quad + j, 16 * cb + li, acc[j]);
    }
}

__device__ __forceinline__ int srccol(int mapid, int n) {
    switch (mapid) {
        case 0: return n;
        case 1: { const int pn = n >> 8, bj = (n >> 7) & 1, i = n & 127; return (bj ? FFN : 0) + pn * 128 + i; }
        case 2: return n < 5824 ? n : (n < 5888 ? -1 : n - 64);
        case 3: return n < 1024 ? (n >> 6) * 96 + (n & 63) : ((n - 1024) >> 5) * 96 + 64 + ((n - 1024) & 31);
        case 4: return (n >> 6) * 128 + (n & 63);
        default: return (n >> 6) * 128 + 64 + (n & 63);
    }
}
__device__ __forceinline__ void xpose_matrix(const float* __restrict__ src, int K, int Nsrc, bf16_t* dst, int Ndst, int mapid, LAS float* scr, int tid) {
    const int nblk = Ndst >> 6, nitems = (K >> 6) * nblk;
    for (int item = blockIdx.x; item < nitems; item += gridDim.x) {
        const int kb = item / nblk, nb = item - kb * nblk, k0 = kb * 64, n0 = nb * 64;
        __syncthreads();
#pragma unroll
        for (int i = 0; i < 8; ++i) { const int idx = tid + 512 * i, kk = idx >> 6, nn = idx & 63; const int sc = srccol(mapid, n0 + nn);
            scr[nn * 65 + kk] = sc >= 0 ? src[(size_t)(k0 + kk) * Nsrc + sc] : 0.f; }
        __syncthreads();
        { const int nn = tid >> 3, c = tid & 7; const LAS float* s = scr + nn * 65 + 8 * c;
          u32x4 o; o.x = cvtpk(s[0], s[1]); o.y = cvtpk(s[2], s[3]); o.z = cvtpk(s[4], s[5]); o.w = cvtpk(s[6], s[7]);
          *(u32x4*)(dst + (size_t)(n0 + nn) * K + k0 + 8 * c) = o; }
    }
}
__device__ __forceinline__ void norm_row_bf16(const float* src, const float* gain, bf16_t* dst, int lane) {
    f32x4 v[4]; float s = 0.f;
#pragma unroll
    for (int j = 0; j < 4; ++j) { v[j] = src ? ((const f32x4*)src)[lane + 64 * j] : (f32x4){0.f, 0.f, 0.f, 0.f}; s += v[j][0] * v[j][0] + v[j][1] * v[j][1] + v[j][2] * v[j][2] + v[j][3] * v[j][3]; }
    const float rs = rsqrtf(wave_sum(s) * (1.f / 1024.f) + EPS);
#pragma unroll
    for (int j = 0; j < 4; ++j) { const f32x4 g = ((const f32x4*)gain)[lane + 64 * j];
        u32x2 o = {cvtpk(v[j][0] * rs * g[0], v[j][1] * rs * g[1]), cvtpk(v[j][2] * rs * g[2], v[j][3] * rs * g[3])}; ((u32x2*)dst)[lane + 64 * j] = o; }
}

__device__ __forceinline__ void norm_row2_bf16(const float* s0, const float* s1, const float* gain, bf16_t* d0, bf16_t* d1, int lane) {
    f32x4 v[4], w[4]; float a = 0.f, b = 0.f;
#pragma unroll
    for (int j = 0; j < 4; ++j) { v[j] = s0 ? ((const f32x4*)s0)[lane + 64 * j] : (f32x4){0.f, 0.f, 0.f, 0.f}; w[j] = s1 ? ((const f32x4*)s1)[lane + 64 * j] : (f32x4){0.f, 0.f, 0.f, 0.f}; }
#pragma unroll
    for (int j = 0; j < 4; ++j) { a += v[j][0] * v[j][0] + v[j][1] * v[j][1] + v[j][2] * v[j][2] + v[j][3] * v[j][3]; b += w[j][0] * w[j][0] + w[j][1] * w[j][1] + w[j][2] * w[j][2] + w[j][3] * w[j][3]; }
    const float ra = rsqrtf(wave_sum(a) * (1.f / 1024.f) + EPS), rb = rsqrtf(wave_sum(b) * (1.f / 1024.f) + EPS);
#pragma unroll
    for (int j = 0; j < 4; ++j) { const f32x4 g = ((const f32x4*)gain)[lane + 64 * j];
        u32x2 o = {cvtpk(v[j][0] * ra * g[0], v[j][1] * ra * g[1]), cvtpk(v[j][2] * ra * g[2], v[j][3] * ra * g[3])}; ((u32x2*)d0)[lane + 64 * j] = o;
        u32x2 p = {cvtpk(w[j][0] * rb * g[0], w[j][1] * rb * g[1]), cvtpk(w[j][2] * rb * g[2], w[j][3] * rb * g[3])}; ((u32x2*)d1)[lane + 64 * j] = p; }
}

__device__ __forceinline__ void p5_phase(const Args& a, const int wave) {
    const int lane = lane_id(); int tid = wave * 64 + lane; asm volatile("" : "+v"(tid)); tid &= 511; const int gw = blockIdx.x * 8 + wave, NGW = gridDim.x * 8;
    unsigned char* ws = a.ws;
    const bf16_t* misc = (const bf16_t*)(ws + WS_MISC); float* dt = (float*)(ws + WS_DT); float* acs = (float*)(ws + WS_ACS); float* tot = (float*)(ws + WS_TOT);
    bf16_t* cqn = (bf16_t*)(ws + WS_CQN); bf16_t* ckvb = (bf16_t*)(ws + WS_CKVB); bf16_t* krb = (bf16_t*)(ws + WS_KRB); bf16_t* xc = (bf16_t*)(ws + WS_X);
    const bf16_t* halo = (const bf16_t*)(ws + WS_HALO); const float* rope = (const float*)(ws + WS_ROPE);
    for (int ci = gw; ci < NCHUNK; ci += NGW) {
        int row0, ntok; chunk_info(ci, row0, ntok);
        const int h = lane & 31;
        const float A = -__expf(a.in[I_ALOG][h]), bias = a.in[I_DTB][h]; float accv = 0.f;
        for (int t = 0; t < ntok; t += 16) { float v[16];
#pragma unroll
            for (int k = 0; k < 16; ++k) v[k] = bf2f(misc[(size_t)(row0 + t + k) * 768 + h]);
#pragma unroll
            for (int k = 0; k < 16; ++k) { accv += softplus_f(v[k] + bias) * A; if (lane < 32) acs[(size_t)(row0 + t + k) * 32 + h] = accv; } }
        if (lane < 32) tot[ci * 32 + h] = accv;
    }
    for (int row = gw; row < R_ACT; row += NGW) {
        const bf16_t* mr = misc + (size_t)row * 768;
        if (lane < 32) dt[(size_t)row * 32 + lane] = softplus_f(bf2f(mr[lane]) + a.in[I_DTB][lane]);
        { const unsigned* cp = (const unsigned*)(mr + 32) + 3 * lane; const unsigned c0 = cp[0], c1 = cp[1], c2 = cp[2];
          float q[6] = {bflo(c0), bfhi(c0), bflo(c1), bfhi(c1), bflo(c2), bfhi(c2)}; float ss = 0.f;
#pragma unroll
          for (int e = 0; e < 6; ++e) ss += q[e] * q[e];
          const float rs = rsqrtf(wave_sum(ss) * (1.f / 384.f) + EPS);
          if (row < R2) { const float* gq = a.in[I_QN] + 6 * lane; unsigned* op = (unsigned*)(cqn + (size_t)row * 384) + 3 * lane;
              op[0] = cvtpk(q[0] * rs * gq[0], q[1] * rs * gq[1]); op[1] = cvtpk(q[2] * rs * gq[2], q[3] * rs * gq[3]); op[2] = cvtpk(q[4] * rs * gq[4], q[5] * rs * gq[5]); } }
        { const u32x2 kv = *(const u32x2*)(mr + 416 + 4 * lane); float v[4] = {bflo(kv.x), bfhi(kv.x), bflo(kv.y), bfhi(kv.y)};
          const float rs = rsqrtf(wave_sum(v[0] * v[0] + v[1] * v[1] + v[2] * v[2] + v[3] * v[3]) * (1.f / 256.f) + EPS);
          const f32x4 g = *(const f32x4*)(a.in[I_KVN] + 4 * lane); const f32x4 o = {v[0] * rs * g[0], v[1] * rs * g[1], v[2] * rs * g[2], v[3] * rs * g[3]};
          if (row < R_S0) *(f32x4*)(a.out + OUT_CKVP + ((size_t)(row >> 14) * 16400 + 16 + (row & 16383)) * 256 + 4 * lane) = o;
          else if (row < R_M0) *(f32x4*)(a.out + OUT_CKVS + (size_t)(row - R_S0) * 256 + 4 * lane) = o;
          else { *(f32x4*)(a.out + OUT_CKVP + (size_t)(row - R_M0) * 256 + 4 * lane) = o; *(f32x4*)(a.out + OUT_CKVP + (size_t)(16400 + row - R_M0) * 256 + 4 * lane) = o; }
          u32x2 ob = {cvtpk(o[0], o[1]), cvtpk(o[2], o[3])}; *(u32x2*)(ckvb + (size_t)row * 256 + 4 * lane) = ob; }
        if (lane < 16) { const float x1 = bf2f(mr[672 + lane]), x2 = bf2f(mr[688 + lane]); const f32x2 cs = *(const f32x2*)(rope + ((size_t)pos_idx(row) * 16 + lane) * 2);
          const float o1 = x1 * cs[0] - x2 * cs[1], o2 = x1 * cs[1] + x2 * cs[0];
          if (row < R_S0) { float* p = a.out + OUT_KRP + ((size_t)(row >> 14) * 16400 + 16 + (row & 16383)) * 32; p[lane] = o1; p[16 + lane] = o2; }
          else if (row < R_M0) { float* p = a.out + OUT_KRS + (size_t)(row - R_S0) * 32; p[lane] = o1; p[16 + lane] = o2; }
          else { float* p = a.out + OUT_KRP + (size_t)(row - R_M0) * 32; p[lane] = o1; p[16 + lane] = o2; p += (size_t)16400 * 32; p[lane] = o1; p[16 + lane] = o2; }
          krb[(size_t)row * 32 + lane] = (bf16_t)f2bf(o1); krb[(size_t)row * 32 + 16 + lane] = (bf16_t)f2bf(o2); }
    }
    for (int row = R_ACT + gw; row < R1; row += NGW) { u32x2 z = {0u, 0u}; *(u32x2*)(ckvb + (size_t)row * 256 + 4 * lane) = z; if (lane < 16) ((unsigned*)(krb + (size_t)row * 32))[lane] = 0u; }
    for (int r = gw; r < 16384; r += NGW) {
        const f32x4 v = *(const f32x4*)(a.in[I_CCKV] + (size_t)r * 256 + 4 * lane); u32x2 o = {cvtpk(v[0], v[1]), cvtpk(v[2], v[3])}; *(u32x2*)(ckvb + (size_t)(R_C0 + r) * 256 + 4 * lane) = o;
        if (lane < 8) { const f32x4 k = *(const f32x4*)(a.in[I_CKR] + (size_t)r * 32 + 4 * lane); u32x2 ok = {cvtpk(k[0], k[1]), cvtpk(k[2], k[3])}; *(u32x2*)(krb + (size_t)(R_C0 + r) * 32 + 4 * lane) = ok; }
    }
    for (int item = NGW - 1 - gw; item < 529 * 6; item += NGW) {
        const int T = item / 6, cc = item - T * 6, c0 = cc * 512 + lane * 8;
        int row0, nrows; float p0[8], p1[8], p2[8];
        if (T < 512) { row0 = T * 64; nrows = 64; const bf16_t* hp = halo + (size_t)T * 3 * 3072 + c0;
            const u32x4 h0 = *(const u32x4*)hp, h1 = *(const u32x4*)(hp + 3072), h2 = *(const u32x4*)(hp + 6144);
#pragma unroll
            for (int e = 0; e < 4; ++e) { p0[2 * e] = bflo(h0[e]); p0[2 * e + 1] = bfhi(h0[e]); p1[2 * e] = bflo(h1[e]); p1[2 * e + 1] = bfhi(h1[e]); p2[2 * e] = bflo(h2[e]); p2[2 * e + 1] = bfhi(h2[e]); } }
        else if (T == 512) { row0 = R_M0; nrows = 16;
#pragma unroll
            for (int e = 0; e < 8; ++e) { p0[e] = 0.f; p1[e] = 0.f; p2[e] = 0.f; } }
        else { const int db = T - 513; row0 = R_S0 + 32 * db; nrows = 32; const float* sp = a.in[I_SCONV] + (size_t)db * 3 * 3072 + c0;
#pragma unroll
            for (int e = 0; e < 8; ++e) { p0[e] = sp[e]; p1[e] = sp[3072 + e]; p2[e] = sp[6144 + e]; } }
        float w0[8], w1[8], w2[8], w3[8], bb[8];
#pragma unroll
        for (int e = 0; e < 8; ++e) { w0[e] = a.in[I_CONVW][c0 + e]; w1[e] = a.in[I_CONVW][3072 + c0 + e]; w2[e] = a.in[I_CONVW][6144 + c0 + e]; w3[e] = a.in[I_CONVW][9216 + c0 + e]; bb[e] = a.in[I_CONVB][c0 + e]; }
        for (int t0 = 0; t0 < nrows; t0 += 8) {
            u32x4 raw[8];
#pragma unroll
            for (int k = 0; k < 8; ++k) raw[k] = *(const u32x4*)(xc + (size_t)(row0 + t0 + k) * 3072 + c0);
#pragma unroll
            for (int k = 0; k < 8; ++k) { float x[8], y[8];
#pragma unroll
                for (int e = 0; e < 4; ++e) { x[2 * e] = bflo(raw[k][e]); x[2 * e + 1] = bfhi(raw[k][e]); }
#pragma unroll
                for (int e = 0; e < 8; ++e) { y[e] = silu_f(bb[e] + w0[e] * p0[e] + w1[e] * p1[e] + w2[e] * p2[e] + w3[e] * x[e]); p0[e] = p1[e]; p1[e] = p2[e]; p2[e] = x[e]; }
                u32x4 o; o.x = cvtpk(y[0], y[1]); o.y = cvtpk(y[2], y[3]); o.z = cvtpk(y[4], y[5]); o.w = cvtpk(y[6], y[7]);
                *(u32x4*)(xc + (size_t)(row0 + t0 + k) * 3072 + c0) = o; }
        }
    }
}

__device__ __forceinline__ void p6_phase(const Args& a, LAS unsigned char* L, const int wave) {
    const int lane = lane_id(); int tid = wave * 64 + lane; asm volatile("" : "+v"(tid)); tid &= 511;
    unsigned char* ws = a.ws; const bf16_t* xc = (const bf16_t*)(ws + WS_X); const float* dt = (const float*)(ws + WS_DT); const float* acs = (const float*)(ws + WS_ACS);
    const float* tot = (const float*)(ws + WS_TOT); bf16_t* S = (bf16_t*)(ws + WS_S);
    LAS bf16_t* Bs = (LAS bf16_t*)L; LAS bf16_t* Xs = (LAS bf16_t*)(L + 18432); LAS float* scs = (LAS float*)(L + 86016);
    const int li = lane & 15, quad = lane >> 4;
    const unsigned voffB = (unsigned)((tid >> 4) * 3072 + (tid & 15) * 8), voffX = (unsigned)((tid >> 6) * 3072 + (tid & 63) * 8);
    for (int unit = blockIdx.x; unit < NCHUNK * 4; unit += gridDim.x) {
        const int ci = unit >> 2, g = unit & 3, h = 8 * g + wave; int row0, ntok; chunk_info(ci, row0, ntok);
        f32x4 acc[8][4];
#pragma unroll
        for (int nb = 0; nb < 8; ++nb)
#pragma unroll
            for (int pb = 0; pb < 4; ++pb) acc[nb][pb] = (f32x4){0.f, 0.f, 0.f, 0.f};
        const int nsub = (ntok + 63) >> 6;
        for (int jb = 0; jb < nsub; ++jb) {
            const int rj = row0 + 64 * jb;
            __syncthreads();
            { const int hh = tid >> 6, t = tid & 63; const size_t r = (size_t)(rj + t) * 32 + 8 * g + hh; float v = 0.f;
              if (64 * jb + t < ntok) v = __expf(tot[ci * 32 + 8 * g + hh] - acs[r]) * dt[r];
              scs[hh * 64 + t] = v; }
#pragma unroll
            for (int i = 0; i < 2; ++i) { const bf16_t* gb = xc + (size_t)(rj + 32 * i) * 3072 + 2048 + 128 * g;
                *(LAS u32x4*)(Bs + ((tid >> 4) + 32 * i) * 144 + (tid & 15) * 8) = *(const u32x4*)(gb + voffB); }
            __syncthreads();
#pragma unroll
            for (int i = 0; i < 8; ++i) { const int t = (tid >> 6) + 8 * i, c = tid & 63; const bf16_t* gb = xc + (size_t)(rj + 8 * i) * 3072 + 512 * g;
                const u32x4 v = *(const u32x4*)(gb + voffX); const float s = scs[(c >> 3) * 64 + t];
                u32x4 o; o.x = cvtpk(bflo(v.x) * s, bfhi(v.x) * s); o.y = cvtpk(bflo(v.y) * s, bfhi(v.y) * s); o.z = cvtpk(bflo(v.z) * s, bfhi(v.z) * s); o.w = cvtpk(bflo(v.w) * s, bfhi(v.w) * s);
                *(LAS u32x4*)(Xs + t * 528 + c * 8) = o; }
            __syncthreads();
#pragma unroll
            for (int s2 = 0; s2 < 2; ++s2) {
                const int tok0 = 32 * s2 + 4 * quad + (li >> 2), cq4 = 4 * (li & 3);
                bf16x8 Bf[4];
#pragma unroll
                for (int pb = 0; pb < 4; ++pb) Bf[pb] = cat8(ldtr(Xs + tok0 * 528 + 64 * wave + 16 * pb + cq4), ldtr(Xs + (tok0 + 16) * 528 + 64 * wave + 16 * pb + cq4));
#pragma unroll
                for (int nb = 0; nb < 8; ++nb) { const bf16x8 Af = cat8(ldtr(Bs + tok0 * 144 + 16 * nb + cq4), ldtr(Bs + (tok0 + 16) * 144 + 16 * nb + cq4));
#pragma unroll
                    for (int pb = 0; pb < 4; ++pb) acc[nb][pb] = MFMA16(Af, Bf[pb], acc[nb][pb]); }
            }
        }
        bf16_t* Sp = S + ((size_t)(ci * 32 + h) * 64) * 128;
#pragma unroll
        for (int nb = 0; nb < 8; ++nb)
#pragma unroll
            for (int pb = 0; pb < 4; ++pb) { u32x2 o = {cvtpk(acc[nb][pb][0], acc[nb][pb][1]), cvtpk(acc[nb][pb][2], acc[nb][pb][3])};
                *(u32x2*)(Sp + (size_t)(16 * pb + li) * 128 + 16 * nb + 4 * quad) = o; }
    }
}

__device__ __forceinline__ void p7_phase(const Args& a, const int wave) {
    int tid = wave * 64 + lane_id(); asm volatile("" : "+v"(tid)); tid &= 511;
    unsigned char* ws = a.ws; bf16_t* S = (bf16_t*)(ws + WS_S); const float* tot = (const float*)(ws + WS_TOT);
    const int gt = blockIdx.x * 512 + tid, NT = gridDim.x * 512;
    for (int e = gt; e < 131072; e += NT) {
        const int b = e >> 16, rem = e & 65535, h = rem >> 11; f32x4 st = {0.f, 0.f, 0.f, 0.f};
        for (int k0 = 0; k0 < 65; k0 += 5) { u32x2 v[5]; float dec[5];
#pragma unroll
            for (int k = 0; k < 5; ++k) { const int ci = b * 65 + k0 + k; v[k] = *(const u32x2*)(S + (size_t)ci * 262144 + rem * 4); dec[k] = __expf(tot[ci * 32 + h]); }
#pragma unroll
            for (int k = 0; k < 5; ++k) { const int ci = b * 65 + k0 + k; u32x2 o = {cvtpk(st[0], st[1]), cvtpk(st[2], st[3])}; *(u32x2*)(S + (size_t)ci * 262144 + rem * 4) = o;
                st[0] = st[0] * dec[k] + bflo(v[k].x); st[1] = st[1] * dec[k] + bfhi(v[k].x); st[2] = st[2] * dec[k] + bflo(v[k].y); st[3] = st[3] * dec[k] + bfhi(v[k].y); } }
        *(f32x4*)(a.out + OUT_SSMP + (size_t)b * 262144 + rem * 4) = st;
    }
    for (int e = gt; e < 16 * 65536; e += NT) {
        const int db = e >> 16, rem = e & 65535, h = rem >> 11, ci = 130 + db;
        const f32x4 s0 = *(const f32x4*)(a.in[I_SSSM] + (size_t)db * 262144 + rem * 4); const u32x2 v = *(const u32x2*)(S + (size_t)ci * 262144 + rem * 4); const float dec = __expf(tot[ci * 32 + h]);
        u32x2 o = {cvtpk(s0[0], s0[1]), cvtpk(s0[2], s0[3])}; *(u32x2*)(S + (size_t)ci * 262144 + rem * 4) = o;
        const f32x4 r = {s0[0] * dec + bflo(v.x), s0[1] * dec + bfhi(v.x), s0[2] * dec + bflo(v.y), s0[3] * dec + bfhi(v.y)};
        *(f32x4*)(a.out + OUT_SSMS + (size_t)db * 262144 + rem * 4) = r;
    }
}

__device__ __forceinline__ void p8_phase(const Args& a, LAS unsigned char* L, const int wave) {
    const int lane = lane_id(); int tid = wave * 64 + lane; asm volatile("" : "+v"(tid)); tid &= 511;
    unsigned char* ws = a.ws; const bf16_t* xc = (const bf16_t*)(ws + WS_X); const float* dt = (const float*)(ws + WS_DT); const float* acs = (const float*)(ws + WS_ACS);
    const bf16_t* S = (const bf16_t*)(ws + WS_S); bf16_t* zb = (bf16_t*)(ws + WS_Z);
    LAS bf16_t* Cs = (LAS bf16_t*)L; LAS bf16_t* Bs = (LAS bf16_t*)(L + 18432); LAS bf16_t* Xs = (LAS bf16_t*)(L + 36864);
    LAS float* aj = (LAS float*)(L + 104448); LAS float* dj = (LAS float*)(L + 106496); LAS float* red = (LAS float*)(L + 108544);
    const int li = lane & 15, quad = lane >> 4;
    const unsigned voffB = (unsigned)((tid >> 4) * 3072 + (tid & 15) * 8), voffX = (unsigned)((tid >> 6) * 3072 + (tid & 63) * 8);
    for (int u = blockIdx.x; u < 2120; u += gridDim.x) {
        int ci, i, g;
        if (u < 2048) { i = 3 - (u >> 9); const int rest = u & 511; ci = (rest >> 8) * 65 + 1 + ((rest & 255) >> 2); g = rest & 3; }
        else { int v = u - 2048; i = 0; g = v & 3; if (v < 8) ci = (v >> 2) * 65; else ci = 130 + ((v - 8) >> 2); }
        int row0, ntok; chunk_info(ci, row0, ntok);
        const int rb = row0 + 64 * i, nti = (ntok - 64 * i) < 64 ? (ntok - 64 * i) : 64, h = 8 * g + wave;
        __syncthreads();
#pragma unroll
        for (int i2 = 0; i2 < 2; ++i2) { const bf16_t* gb = xc + (size_t)(rb + 32 * i2) * 3072 + 2560 + 128 * g;
            *(LAS u32x4*)(Cs + ((tid >> 4) + 32 * i2) * 144 + (tid & 15) * 8) = *(const u32x4*)(gb + voffB); }
        __syncthreads();
        const bf16_t* Sp = S + ((size_t)(ci * 32 + h) * 64) * 128;
        const float Dh = a.in[I_SSMD][h];
        { constexpr int ih = 0;
        f32x4 acc[4][4];
#pragma unroll
        for (int pb = 0; pb < 4; ++pb)
#pragma unroll
            for (int ib = 0; ib < 4; ++ib) acc[pb][ib] = (f32x4){0.f, 0.f, 0.f, 0.f};
        float ai[4];
#pragma unroll
        for (int ib = 0; ib < 4; ++ib) ai[ib] = acs[(size_t)(rb + 32 * ih + 16 * ib + li) * 32 + h];
        { bf16x8 Af[4][4];
#pragma unroll
          for (int ks = 0; ks < 4; ++ks)
#pragma unroll
            for (int pb = 0; pb < 4; ++pb) Af[ks][pb] = *(const bf16x8*)(Sp + (size_t)(16 * pb + li) * 128 + 32 * ks + 8 * quad);
#pragma unroll
          for (int ks = 0; ks < 4; ++ks) { bf16x8 Bf[4];
#pragma unroll
            for (int ib = 0; ib < 4; ++ib) Bf[ib] = *(const LAS bf16x8*)(Cs + (32 * ih + 16 * ib + li) * 144 + 32 * ks + 8 * quad);
#pragma unroll
            for (int pb = 0; pb < 4; ++pb)
#pragma unroll
                for (int ib = 0; ib < 4; ++ib) acc[pb][ib] = MFMA16(Af[ks][pb], Bf[ib], acc[pb][ib]);
            __builtin_amdgcn_sched_barrier(0); } }
#pragma unroll
        for (int ib = 0; ib < 4; ++ib) { const float e = __expf(ai[ib]);
#pragma unroll
            for (int pb = 0; pb < 4; ++pb) acc[pb][ib] = acc[pb][ib] * e; }
        for (int j = 0; j <= i; ++j) {
            const int rj = row0 + 64 * j;
            __syncthreads();
#pragma unroll
            for (int i2 = 0; i2 < 2; ++i2) { const bf16_t* gb = xc + (size_t)(rj + 32 * i2) * 3072 + 2048 + 128 * g;
                *(LAS u32x4*)(Bs + ((tid >> 4) + 32 * i2) * 144 + (tid & 15) * 8) = *(const u32x4*)(gb + voffB); }
#pragma unroll
            for (int i2 = 0; i2 < 8; ++i2) { const bf16_t* gb = xc + (size_t)(rj + 8 * i2) * 3072 + 512 * g;
                *(LAS u32x4*)(Xs + ((tid >> 6) + 8 * i2) * 528 + (tid & 63) * 8) = *(const u32x4*)(gb + voffX); }
            { const int hh = tid >> 6, t = tid & 63; const size_t r = (size_t)(rj + t) * 32 + 8 * g + hh; aj[hh * 64 + t] = acs[r]; dj[hh * 64 + t] = dt[r]; }
            __syncthreads();
            bf16x8 XA[4][2]; f32x4 a4v[4], d4v[4];
#pragma unroll
            for (int s2 = 0; s2 < 2; ++s2) { const LAS bf16_t* xp = Xs + (32 * s2 + 4 * quad + (li >> 2)) * 528 + 64 * wave + 4 * (li & 3);
#pragma unroll
                for (int pb = 0; pb < 4; ++pb) XA[pb][s2] = cat8(ldtr(xp + 16 * pb), ldtr(xp + 16 * 528 + 16 * pb)); }
#pragma unroll
            for (int jb = 0; jb < 4; ++jb) { a4v[jb] = *(const LAS f32x4*)(aj + wave * 64 + 16 * jb + 4 * quad); d4v[jb] = *(const LAS f32x4*)(dj + wave * 64 + 16 * jb + 4 * quad); }
            __builtin_amdgcn_sched_barrier(0);
#pragma unroll
            for (int ib = 0; ib < 4; ++ib) {
                f32x4 cb[4];
#pragma unroll
                for (int jb = 0; jb < 4; ++jb) cb[jb] = (f32x4){0.f, 0.f, 0.f, 0.f};
#pragma unroll
                for (int ks = 0; ks < 4; ++ks) { const bf16x8 Bc = *(const LAS bf16x8*)(Cs + (32 * ih + 16 * ib + li) * 144 + 32 * ks + 8 * quad);
#pragma unroll
                    for (int jb = 0; jb < 4; ++jb) { const bf16x8 Ab = *(const LAS bf16x8*)(Bs + (16 * jb + li) * 144 + 32 * ks + 8 * quad); cb[jb] = MFMA16(Ab, Bc, cb[jb]); } }
                const int ti = 32 * ih + 16 * ib + li;
#pragma unroll
                for (int jb = 0; jb < 4; ++jb) { const f32x4 a4 = a4v[jb], d4 = d4v[jb];
#pragma unroll
                    for (int jj = 0; jj < 4; ++jj) { const int tj = 16 * jb + 4 * quad + jj; float val = cb[jb][jj] * __expf(fminf(ai[ib] - a4[jj], 0.f)) * d4[jj];
                        if (j == i && tj > ti) val = 0.f; cb[jb][jj] = val; } }
#pragma unroll
                for (int s2 = 0; s2 < 2; ++s2) { u32x4 pk = {cvtpk(cb[2 * s2][0], cb[2 * s2][1]), cvtpk(cb[2 * s2][2], cb[2 * s2][3]), cvtpk(cb[2 * s2 + 1][0], cb[2 * s2 + 1][1]), cvtpk(cb[2 * s2 + 1][2], cb[2 * s2 + 1][3])};
                    const bf16x8 P = __builtin_bit_cast(bf16x8, pk);
#pragma unroll
                    for (int pb = 0; pb < 4; ++pb) acc[pb][ib] = MFMA16(XA[pb][s2], P, acc[pb][ib]); }
                __builtin_amdgcn_sched_barrier(0);
            }
        }
        float ss[4];
#pragma unroll
        for (int ib = 0; ib < 4; ++ib) { ss[ib] = 0.f; const int ti = 32 * ih + 16 * ib + li;
#pragma unroll
            for (int pb = 0; pb < 4; ++pb) { const int p0 = 16 * pb + 4 * quad; const u32x2 xr = *(const LAS u32x2*)(Xs + ti * 528 + 64 * wave + p0);
                const u32x2 zr = *(const u32x2*)(zb + (size_t)(rb + ti) * 2048 + 64 * h + p0);
                const float x4[4] = {bflo(xr.x), bfhi(xr.x), bflo(xr.y), bfhi(xr.y)}, z4[4] = {bflo(zr.x), bfhi(zr.x), bflo(zr.y), bfhi(zr.y)};
#pragma unroll
                for (int jj = 0; jj < 4; ++jj) { const float y = (acc[pb][ib][jj] + Dh * x4[jj]) * silu_f(z4[jj]); acc[pb][ib][jj] = y; ss[ib] += y * y; } }
            ss[ib] += __shfl_xor(ss[ib], 16); ss[ib] += __shfl_xor(ss[ib], 32);
            if (quad == 0) red[wave * 64 + ti] = ss[ib]; }
        __syncthreads();
#pragma unroll
        for (int ib = 0; ib < 4; ++ib) { const int ti = 32 * ih + 16 * ib + li; float t8 = 0.f;
#pragma unroll
            for (int w = 0; w < 8; ++w) t8 += red[w * 64 + ti];
            const float rs = rsqrtf(t8 * (1.f / 512.f) + EPS);
            if (ti < nti) {
#pragma unroll
                for (int pb = 0; pb < 4; ++pb) { const int p0 = 16 * pb + 4 * quad; const f32x4 gn = *(const f32x4*)(a.in[I_SSMN] + 64 * h + p0);
                    u32x2 o = {cvtpk(acc[pb][ib][0] * rs * gn[0], acc[pb][ib][1] * rs * gn[1]), cvtpk(acc[pb][ib][2] * rs * gn[2], acc[pb][ib][3] * rs * gn[3])};
                    *(u32x2*)(zb + (size_t)(rb + ti) * 2048 + 64 * h + p0) = o; } } }
        }
    }
}

__device__ __forceinline__ void attn_tile(bool prompt, int b_or_db, int tt, int& row0, int& nv) {
    if (tt == 0) { row0 = R_M0; nv = 16; return; }
    if (prompt) { row0 = b_or_db * 16384 + 64 * (tt - 1); nv = 64; }
    else if (tt <= 16) { row0 = R_C0 + 1024 * b_or_db + 64 * (tt - 1); nv = 64; }
    else { row0 = R_S0 + 32 * b_or_db; nv = 32; }
}
__device__ __forceinline__ void p11_phase(const Args& a, LAS unsigned char* L, const int wave) {
    const int lane = lane_id(); int tid = wave * 64 + lane; asm volatile("" : "+v"(tid)); tid &= 511;
    unsigned char* ws = a.ws; const bf16_t* Q = (const bf16_t*)(ws + WS_Q); const bf16_t* Kn = (const bf16_t*)(ws + WS_KN); const bf16_t* Vt = (const bf16_t*)(ws + WS_VT);
    const bf16_t* krb = (const bf16_t*)(ws + WS_KRB); bf16_t* O = (bf16_t*)(ws + WS_O); const float* rope = (const float*)(ws + WS_ROPE);
    constexpr int KSZ = 64 * 104, VSZ = 80 * 72, BUF = KSZ + VSZ;
    LAS bf16_t* LB = (LAS bf16_t*)L;
    const int li = lane & 15, quad = lane >> 4;
    const unsigned vo_kn = (unsigned)((tid >> 3) * 1024 + (tid & 7) * 8), vo_kr = (unsigned)(((tid & 255) >> 2) * 32 + (tid & 3) * 8), vo_vt = (unsigned)((tid >> 3) * RK + (tid & 7) * 8);
    const int so_kn = (tid >> 3) * 104 + (tid & 7) * 8, so_kr = ((tid & 255) >> 2) * 104 + 64 + (tid & 3) * 8, so_vt = KSZ + (tid >> 3) * 72 + (tid & 7) * 8;
    for (int e = tid; e < 2 * 16 * 72; e += 512) { const int bsel = e / 1152, r = (e % 1152) / 72, c = e % 72; LB[bsel * BUF + KSZ + (64 + r) * 72 + c] = (bf16_t)(r == 0 ? 0x3F80 : 0); }
    for (int u = blockIdx.x; u < 2304; u += gridDim.x) {
        bool prompt, active; int bq, hd, qr0, ntiles, limit;
        if (u < 2048) { const int k = u >> 8, c32 = (u & 255) >> 5, qblk = 63 - 8 * k - ((k & 1) ? 7 - c32 : c32); prompt = true; bq = (u & 31) >> 4; hd = u & 15;
            qr0 = bq * 16384 + 256 * qblk; ntiles = 4 * qblk + 5; limit = 4 * qblk + (wave >> 1) + 1; active = true; }
        else { const int v = u - 2048; prompt = false; bq = v >> 4; hd = v & 15; qr0 = R_S0 + 32 * bq; ntiles = 18; limit = 17; active = (wave == 0); }
        const int qrow = qr0 + 32 * wave;
        bf16x8 qf[2][3];
#pragma unroll
        for (int qb = 0; qb < 2; ++qb) {
            const int r = active ? qrow + 16 * qb + li : 0; const bf16_t* qp = Q + (size_t)r * 1536;
            qf[qb][0] = *(const bf16x8*)(qp + hd * 64 + 8 * quad); qf[qb][1] = *(const bf16x8*)(qp + hd * 64 + 32 + 8 * quad);
            const u32x4 x1 = *(const u32x4*)(qp + 1024 + hd * 32 + 8 * (quad & 1)), x2 = *(const u32x4*)(qp + 1024 + hd * 32 + 16 + 8 * (quad & 1));
            const float* rp = rope + ((size_t)pos_idx(r) * 16 + 8 * (quad & 1)) * 2; float ov[8];
#pragma unroll
            for (int e = 0; e < 4; ++e) { const f32x4 cs = *(const f32x4*)(rp + 4 * e);
                const float a0 = bflo(x1[e]), a1 = bfhi(x1[e]), b0 = bflo(x2[e]), b1 = bfhi(x2[e]);
                ov[2 * e] = quad < 2 ? a0 * cs[0] - b0 * cs[1] : a0 * cs[1] + b0 * cs[0]; ov[2 * e + 1] = quad < 2 ? a1 * cs[2] - b1 * cs[3] : a1 * cs[3] + b1 * cs[2]; }
            u32x4 pkq = {cvtpk(ov[0], ov[1]), cvtpk(ov[2], ov[3]), cvtpk(ov[4], ov[5]), cvtpk(ov[6], ov[7])}; qf[qb][2] = __builtin_bit_cast(bf16x8, pkq);
        }
        float mrun[2] = {-INFINITY, -INFINITY}; f32x4 o[4][2], ol[2] = {{0.f, 0.f, 0.f, 0.f}, {0.f, 0.f, 0.f, 0.f}};
#pragma unroll
        for (int db = 0; db < 4; ++db) { o[db][0] = (f32x4){0.f, 0.f, 0.f, 0.f}; o[db][1] = o[db][0]; }
        int row0, nv, nvn; attn_tile(prompt, bq, 0, row0, nv);
        u32x4 pkn = *(const u32x4*)(Kn + (size_t)row0 * 1024 + hd * 64 + vo_kn);
        u32x4 pkr = *(const u32x4*)(krb + (size_t)row0 * 32 + vo_kr);
        u32x4 pvt = *(const u32x4*)(Vt + (size_t)hd * 64 * RK + row0 + vo_vt);
        __syncthreads();
        *(LAS u32x4*)(LB + so_kn) = pkn; if (tid < 256) *(LAS u32x4*)(LB + so_kr) = pkr; *(LAS u32x4*)(LB + so_vt) = pvt;
        attn_tile(prompt, bq, 1, row0, nvn);
        pkn = *(const u32x4*)(Kn + (size_t)row0 * 1024 + hd * 64 + vo_kn); pkr = *(const u32x4*)(krb + (size_t)row0 * 32 + vo_kr); pvt = *(const u32x4*)(Vt + (size_t)hd * 64 * RK + row0 + vo_vt);
        for (int tt = 0; tt < ntiles; ++tt) {
            const int nvc = nv; nv = nvn;
            __syncthreads();
            if (tt + 1 < ntiles) { LAS bf16_t* nb = LB + ((tt + 1) & 1) * BUF;
                *(LAS u32x4*)(nb + so_kn) = pkn; if (tid < 256) *(LAS u32x4*)(nb + so_kr) = pkr; *(LAS u32x4*)(nb + so_vt) = pvt;
                if (tt + 2 < ntiles) { attn_tile(prompt, bq, tt + 2, row0, nvn);
                    pkn = *(const u32x4*)(Kn + (size_t)row0 * 1024 + hd * 64 + vo_kn); pkr = *(const u32x4*)(krb + (size_t)row0 * 32 + vo_kr); pvt = *(const u32x4*)(Vt + (size_t)hd * 64 * RK + row0 + vo_vt); } }
            if (active && tt <= limit) {
                const LAS bf16_t* Ks = LB + (tt & 1) * BUF; const LAS bf16_t* Vs = Ks + KSZ;
                f32x4 s[4][2];
                const float m0 = mrun[0] == -INFINITY ? 0.f : mrun[0], m1 = mrun[1] == -INFINITY ? 0.f : mrun[1];
#pragma unroll
                for (int kb = 0; kb < 4; ++kb) { s[kb][0] = (f32x4){-m0, -m0, -m0, -m0}; s[kb][1] = (f32x4){-m1, -m1, -m1, -m1}; }
#pragma unroll
                for (int ks = 0; ks < 3; ++ks)
#pragma unroll
                    for (int kb = 0; kb < 4; ++kb) { const bf16x8 kf = *(const LAS bf16x8*)(Ks + (16 * kb + li) * 104 + 32 * ks + 8 * quad);
                        s[kb][0] = MFMA16(kf, qf[0][ks], s[kb][0]); s[kb][1] = MFMA16(kf, qf[1][ks], s[kb][1]); }
                if (nvc < 64) {
#pragma unroll
                    for (int kb = 0; kb < 4; ++kb)
#pragma unroll
                        for (int jj = 0; jj < 4; ++jj) if (16 * kb + 4 * quad + jj >= nvc) { s[kb][0][jj] = -INFINITY; s[kb][1][jj] = -INFINITY; } }
                bf16x8 P[2][2];
#pragma unroll
                for (int qb = 0; qb < 2; ++qb) {
                    float mx = fmaxf(fmaxf(s[0][qb][0], s[0][qb][1]), s[0][qb][2]);
                    mx = fmaxf(fmaxf(mx, s[0][qb][3]), s[1][qb][0]); mx = fmaxf(fmaxf(mx, s[1][qb][1]), s[1][qb][2]); mx = fmaxf(fmaxf(mx, s[1][qb][3]), s[2][qb][0]);
                    mx = fmaxf(fmaxf(mx, s[2][qb][1]), s[2][qb][2]); mx = fmaxf(fmaxf(mx, s[2][qb][3]), s[3][qb][0]); mx = fmaxf(fmaxf(mx, s[3][qb][1]), s[3][qb][2]); mx = fmaxf(mx, s[3][qb][3]);
                    const bool first = (mrun[qb] == -INFINITY);
                    if (__builtin_amdgcn_ballot_w64(first || mx > 16.f) != 0ull) {
                        mx = fmaxf(mx, __shfl_xor(mx, 16)); mx = fmaxf(mx, __shfl_xor(mx, 32));
                        const float mold = qb == 0 ? m0 : m1, d = first ? mx : fmaxf(mx, 0.f);
                        const float alpha = first ? 0.f : __builtin_amdgcn_exp2f(-d); mrun[qb] = mold + d; ol[qb] = ol[qb] * alpha;
#pragma unroll
                        for (int kb = 0; kb < 4; ++kb) s[kb][qb] = s[kb][qb] - d;
#pragma unroll
                        for (int db = 0; db < 4; ++db) o[db][qb] = o[db][qb] * alpha; }
#pragma unroll
                    for (int kb = 0; kb < 4; ++kb) { f32x4 t = s[kb][qb];
                        t[0] = __builtin_amdgcn_exp2f(t[0]); t[1] = __builtin_amdgcn_exp2f(t[1]); t[2] = __builtin_amdgcn_exp2f(t[2]); t[3] = __builtin_amdgcn_exp2f(t[3]); s[kb][qb] = t; }
#pragma unroll
                    for (int s2 = 0; s2 < 2; ++s2) { u32x4 pk = {cvtpk(s[2 * s2][qb][0], s[2 * s2][qb][1]), cvtpk(s[2 * s2][qb][2], s[2 * s2][qb][3]), cvtpk(s[2 * s2 + 1][qb][0], s[2 * s2 + 1][qb][1]), cvtpk(s[2 * s2 + 1][qb][2], s[2 * s2 + 1][qb][3])};
                        P[qb][s2] = __builtin_bit_cast(bf16x8, pk); }
                }
#pragma unroll
                for (int s2 = 0; s2 < 2; ++s2)
#pragma unroll
                    for (int db = 0; db < 4; ++db) { const LAS bf16_t* vp = Vs + (16 * db + li) * 72 + 32 * s2 + 4 * quad;
                        const bf16x8 vf = cat8u(*(const LAS u32x2*)vp, *(const LAS u32x2*)(vp + 16));
                        o[db][0] = MFMA16(vf, P[0][s2], o[db][0]); o[db][1] = MFMA16(vf, P[1][s2], o[db][1]); }
#pragma unroll
                for (int s2 = 0; s2 < 2; ++s2) { const LAS bf16_t* vp = Vs + (64 + li) * 72 + 32 * s2 + 4 * quad;
                    const bf16x8 vf = cat8u(*(const LAS u32x2*)vp, *(const LAS u32x2*)(vp + 16));
                    ol[0] = MFMA16(vf, P[0][s2], ol[0]); ol[1] = MFMA16(vf, P[1][s2], ol[1]); }
            }
        }
        if (active) {
#pragma unroll
            for (int qb = 0; qb < 2; ++qb) { const float l = __shfl(ol[qb][0], li); const float inv = 1.f / l;
#pragma unroll
                for (int db = 0; db < 4; ++db) { u32x2 w = {cvtpk(o[db][qb][0] * inv, o[db][qb][1] * inv), cvtpk(o[db][qb][2] * inv, o[db][qb][3] * inv)};
                    *(u32x2*)(O + (size_t)(qrow + 16 * qb + li) * 1024 + hd * 64 + 16 * db + 4 * quad) = w; } }
        }
    }
}

#ifndef ONLY_PHASE
#define ONLY_PHASE -1
#endif
#define PH(k) (ONLY_PHASE < 0 || ONLY_PHASE == (k))
constexpr int NPHASE = 20;
constexpr int LDS_BYTES = 131072;
__device__ __forceinline__ void grid_barrier(unsigned* bar, unsigned k, int wave) {
    __syncthreads();
    if (wave == 0) {
        __builtin_amdgcn_fence(__ATOMIC_RELEASE, "agent");
        if (lane_id() == 0) {
            const unsigned g = blockIdx.x & 7u, ngrp = gridDim.x < 8u ? gridDim.x : 8u, ng = (gridDim.x - g + 7u) >> 3;
            unsigned* cnt = bar + 64 * g; unsigned* top = bar + 64 * 8; unsigned* rel = bar + 64 * (9 + g);
            const unsigned old = __hip_atomic_fetch_add(cnt, 1u, __ATOMIC_RELAXED, __HIP_MEMORY_SCOPE_AGENT);
            if (old + 1u == ng * k) {
                const unsigned old2 = __hip_atomic_fetch_add(top, 1u, __ATOMIC_RELAXED, __HIP_MEMORY_SCOPE_AGENT);
                if (old2 + 1u == ngrp * k) { for (unsigned j = 0; j < ngrp; ++j) __hip_atomic_store(bar + 64 * (9 + j), k, __ATOMIC_RELAXED, __HIP_MEMORY_SCOPE_AGENT); }
            }
            while (__hip_atomic_load(rel, __ATOMIC_RELAXED, __HIP_MEMORY_SCOPE_AGENT) < k) __builtin_amdgcn_s_sleep(1);
        }
        __builtin_amdgcn_fence(__ATOMIC_ACQUIRE, "agent");
    }
    __syncthreads();
}
__global__ void __launch_bounds__(512, 2) fwd_megakernel(Args a) {
    extern __shared__ __attribute__((aligned(16))) unsigned char lds_raw[];
    LAS unsigned char* L = (LAS unsigned char*)lds_raw;
    unsigned char* ws = a.ws;
    bf16_t* W_IN = (bf16_t*)(ws + WS_W_IN); bf16_t* W_GU = (bf16_t*)(ws + WS_W_GU); bf16_t* W_D = (bf16_t*)(ws + WS_W_D); bf16_t* W_SO = (bf16_t*)(ws + WS_W_SO);
    bf16_t* W_UQ = (bf16_t*)(ws + WS_W_UQ); bf16_t* W_K = (bf16_t*)(ws + WS_W_K); bf16_t* W_V = (bf16_t*)(ws + WS_W_V); bf16_t* W_MO = (bf16_t*)(ws + WS_W_MO); bf16_t* W_MIX = (bf16_t*)(ws + WS_W_MIX);
    float* hmeta = (float*)(ws + WS_HMETA);
    const RowMap rm{a.out, hmeta, a.in[I_XP], a.in[I_XS], a.in[I_META]};
    const int wave = __builtin_amdgcn_readfirstlane((int)threadIdx.x >> 6);
    unsigned* bar = (unsigned*)(ws + WS_BAR);
    if (a.ph_hi > 1000) { cg::grid_group grid = cg::this_grid(); grid.sync(); }
    const int lo = a.ph_lo, hi = a.ph_hi;
    __builtin_amdgcn_fence(__ATOMIC_ACQUIRE, "agent");
#define TIDS const int lane = lane_id(); int tid = wave * 64 + lane; asm volatile("" : "+v"(tid)); tid &= 511; const int gw = blockIdx.x * 8 + wave, NGW = gridDim.x * 8; (void)tid; (void)lane; (void)gw; (void)NGW;
#define IN(k) (PH(k) && lo <= (k) && (k) < hi)
    unsigned nbar = 0;
#ifdef TIME_PHASE
    unsigned long long t_a = 0, t_b = 0;
#endif
#define SEAM(k) do { if ((k) + 1 < hi) { ++nbar; grid_barrier(bar, nbar, wave); } } while (0)
    {
        {
#ifdef TIME_PHASE
        if (TIME_PHASE == 0) t_a = __builtin_amdgcn_s_memrealtime();
#endif
        if (IN(0)) { { TIDS
            LAS float* scr = (LAS float*)L;
            xpose_matrix(a.in[I_F1GU], 1024, 2 * FFN, W_GU, 2 * FFN, 1, scr, tid);
            xpose_matrix(a.in[I_F1D], FFN, 1024, W_D, 1024, 0, scr, tid);
            xpose_matrix(a.in[I_WIN], 1024, 7872, W_IN, 7936, 2, scr, tid);
            xpose_matrix(a.in[I_WSO], 2048, 1024, W_SO, 1024, 0, scr, tid);
            xpose_matrix(a.in[I_WUQ], 384, 1536, W_UQ, 1536, 3, scr, tid);
            xpose_matrix(a.in[I_WUKV], 256, 2048, W_K, 1024, 4, scr, tid);
            xpose_matrix(a.in[I_WUKV], 256, 2048, W_V, 1024, 5, scr, tid);
            xpose_matrix(a.in[I_WMO], 1024, 1024, W_MO, 1024, 0, scr, tid);
            xpose_matrix(a.in[I_WMIX], 1024, 1024, W_MIX, 1024, 0, scr, tid);
            __syncthreads();
            bf16_t* xn = (bf16_t*)(ws + WS_U);
            for (int row = gw; row < R1; row += 2 * NGW) { const int r1 = row + NGW; if (r1 < R1) norm_row2_bf16(xrow(rm, row), xrow(rm, r1), a.in[I_F1N], xn + (size_t)row * D, xn + (size_t)r1 * D, lane); else norm_row_bf16(xrow(rm, row), a.in[I_F1N], xn + (size_t)row * D, lane); }
            float* rope = (float*)(ws + WS_ROPE);
            for (int e = blockIdx.x * 512 + tid; e < 16400 * 16; e += gridDim.x * 512) { const int i = e & 15, pos = (e >> 4) - 16;
                const float inv = __builtin_amdgcn_exp2f(-(float)i * 0.83048202372184058f); const float ang = (float)pos * inv;
                double rev = (double)ang * 0.15915494309189535; rev -= __builtin_rint(rev); const float r = (float)rev;
                rope[2 * e] = __builtin_amdgcn_cosf(r); rope[2 * e + 1] = __builtin_amdgcn_sinf(r); }
        } SEAM(0); }
#ifdef TIME_PHASE
        if (TIME_PHASE == 0) t_b = __builtin_amdgcn_s_memrealtime();
#endif
#ifdef TIME_PHASE
        if (TIME_PHASE == 1) t_a = __builtin_amdgcn_s_memrealtime();
#endif
        if (IN(1)) { { EpiSwiglu E{(bf16_t*)(ws + WS_ACT)}; run_gemm(L, (const bf16_t*)(ws + WS_U), W_GU, R1, 2 * FFN, 1024, E, wave); } SEAM(1); }
#ifdef TIME_PHASE
        if (TIME_PHASE == 1) t_b = __builtin_amdgcn_s_memrealtime();
#endif
#ifdef TIME_PHASE
        if (TIME_PHASE == 2) t_a = __builtin_amdgcn_s_memrealtime();
#endif
        if (IN(2)) { { ElResid T{rm, 0.5f, 0}; tail_gemm((const bf16_t*)(ws + WS_ACT), W_D, FFN, 32768, R1, T, wave); EpiResid E{rm, 0.5f, 0}; run_gemm(L, (const bf16_t*)(ws + WS_ACT), W_D, 32768, 1024, FFN, E, wave); } SEAM(2); }
#ifdef TIME_PHASE
        if (TIME_PHASE == 2) t_b = __builtin_amdgcn_s_memrealtime();
#endif
#ifdef TIME_PHASE
        if (TIME_PHASE == 3) t_a = __builtin_amdgcn_s_memrealtime();
#endif
        if (IN(3)) { { TIDS
            bf16_t* un = (bf16_t*)(ws + WS_U);
            for (int row = gw; row < R1; row += 2 * NGW) { const int r1 = row + NGW; if (r1 < R1) norm_row2_bf16(hrow(rm, row), hrow(rm, r1), a.in[I_MIXN], un + (size_t)row * D, un + (size_t)r1 * D, lane); else norm_row_bf16(hrow(rm, row), a.in[I_MIXN], un + (size_t)row * D, lane); }
            LAS float* scr = (LAS float*)L;
            xpose_matrix(a.in[I_F2GU], 1024, 2 * FFN, W_GU, 2 * FFN, 1, scr, tid);
            xpose_matrix(a.in[I_F2D], FFN, 1024, W_D, 1024, 0, scr, tid);
            __syncthreads();
        } SEAM(3); }
#ifdef TIME_PHASE
        if (TIME_PHASE == 3) t_b = __builtin_amdgcn_s_memrealtime();
#endif
#ifdef TIME_PHASE
        if (TIME_PHASE == 4) t_a = __builtin_amdgcn_s_memrealtime();
#endif
        if (IN(4)) { { EpiProj E{(bf16_t*)(ws + WS_Z), (bf16_t*)(ws + WS_X), (bf16_t*)(ws + WS_MISC), (bf16_t*)(ws + WS_HALO), a.out};
                  run_gemm(L, (const bf16_t*)(ws + WS_U), W_IN, R1, 5888, 1024, E, wave); } SEAM(4); }
#ifdef TIME_PHASE
        if (TIME_PHASE == 4) t_b = __builtin_amdgcn_s_memrealtime();
#endif
#ifdef TIME_PHASE
        if (TIME_PHASE == 5) t_a = __builtin_amdgcn_s_memrealtime();
#endif
        if (IN(5)) { p5_phase(a, wave); SEAM(5); }
#ifdef TIME_PHASE
        if (TIME_PHASE == 5) t_b = __builtin_amdgcn_s_memrealtime();
#endif
#ifdef TIME_PHASE
        if (TIME_PHASE == 6) t_a = __builtin_amdgcn_s_memrealtime();
#endif
        if (IN(6)) { p6_phase(a, L, wave); SEAM(6); }
#ifdef TIME_PHASE
        if (TIME_PHASE == 6) t_b = __builtin_amdgcn_s_memrealtime();
#endif
#ifdef TIME_PHASE
        if (TIME_PHASE == 7) t_a = __builtin_amdgcn_s_memrealtime();
#endif
        if (IN(7)) { p7_phase(a, wave); SEAM(7); }
#ifdef TIME_PHASE
        if (TIME_PHASE == 7) t_b = __builtin_amdgcn_s_memrealtime();
#endif
#ifdef TIME_PHASE
        if (TIME_PHASE == 8) t_a = __builtin_amdgcn_s_memrealtime();
#endif
        if (IN(8)) { p8_phase(a, L, wave); SEAM(8); }
#ifdef TIME_PHASE
        if (TIME_PHASE == 8) t_b = __builtin_amdgcn_s_memrealtime();
#endif
#ifdef TIME_PHASE
        if (TIME_PHASE == 9) t_a = __builtin_amdgcn_s_memrealtime();
#endif
        if (IN(9)) { { ElBf16 T{(bf16_t*)(ws + WS_YS), 1024}; tail_gemm((const bf16_t*)(ws + WS_Z), W_SO, 2048, 32768, R2, T, wave); EpiBf16 E{(bf16_t*)(ws + WS_YS), 1024, 1.0f}; run_gemm(L, (const bf16_t*)(ws + WS_Z), W_SO, 32768, 1024, 2048, E, wave); } SEAM(9); }
#ifdef TIME_PHASE
        if (TIME_PHASE == 9) t_b = __builtin_amdgcn_s_memrealtime();
#endif
#ifdef TIME_PHASE
        if (TIME_PHASE == 10) t_a = __builtin_amdgcn_s_memrealtime();
#endif
        if (IN(10)) { {
            for (int gi = 0; gi < 3; ++gi) {
                const bf16_t* A = gi == 0 ? (const bf16_t*)(ws + WS_CQN) : (gi == 1 ? (const bf16_t*)(ws + WS_CKVB) : W_V);
                const bf16_t* B = gi == 0 ? W_UQ : (gi == 1 ? W_K : (const bf16_t*)(ws + WS_CKVB));
                const int M = gi == 0 ? R2 : (gi == 1 ? RK : 1024), N = gi == 0 ? 1536 : (gi == 1 ? 1024 : RK), K = gi == 0 ? 384 : 256;
                EpiBf16 E{gi == 0 ? (bf16_t*)(ws + WS_Q) : (gi == 1 ? (bf16_t*)(ws + WS_KN) : (bf16_t*)(ws + WS_VT)), N, gi == 0 ? QSCALE : 1.0f};
                run_gemm(L, A, B, M, N, K, E, wave);
            }
        } SEAM(10); }
#ifdef TIME_PHASE
        if (TIME_PHASE == 10) t_b = __builtin_amdgcn_s_memrealtime();
#endif
#ifdef TIME_PHASE
        if (TIME_PHASE == 11) t_a = __builtin_amdgcn_s_memrealtime();
#endif
        if (IN(11)) { p11_phase(a, L, wave); SEAM(11); }
#ifdef TIME_PHASE
        if (TIME_PHASE == 11) t_b = __builtin_amdgcn_s_memrealtime();
#endif
#ifdef TIME_PHASE
        if (TIME_PHASE == 12) t_a = __builtin_amdgcn_s_memrealtime();
#endif
        if (IN(12)) { { TIDS bf16_t* un = (bf16_t*)(ws + WS_Z); for (int row = gw; row < R2; row += 2 * NGW) { const int r1 = row + NGW; if (r1 < R2) norm_row2_bf16(hrow(rm, row), hrow(rm, r1), a.in[I_MIXN], un + (size_t)row * D, un + (size_t)r1 * D, lane); else norm_row_bf16(hrow(rm, row), a.in[I_MIXN], un + (size_t)row * D, lane); } } SEAM(12); }
#ifdef TIME_PHASE
        if (TIME_PHASE == 12) t_b = __builtin_amdgcn_s_memrealtime();
#endif
#ifdef TIME_PHASE
        if (TIME_PHASE == 13) t_a = __builtin_amdgcn_s_memrealtime();
#endif
        if (IN(13)) { { EpiGate E{(bf16_t*)(ws + WS_G), a.in[I_GBIAS]}; run_gemm(L, (const bf16_t*)(ws + WS_Z), W_IN + (size_t)5888 * 1024, R2, 2048, 1024, E, wave); } SEAM(13); }
#ifdef TIME_PHASE
        if (TIME_PHASE == 13) t_b = __builtin_amdgcn_s_memrealtime();
#endif
#ifdef TIME_PHASE
        if (TIME_PHASE == 14) t_a = __builtin_amdgcn_s_memrealtime();
#endif
        if (IN(14)) { { ElMerge T{(const bf16_t*)(ws + WS_G), (bf16_t*)(ws + WS_YS)}; tail_gemm((const bf16_t*)(ws + WS_O), W_MO, 1024, 32768, R2, T, wave); EpiMerge E{(const bf16_t*)(ws + WS_G), (bf16_t*)(ws + WS_YS)}; run_gemm(L, (const bf16_t*)(ws + WS_O), W_MO, 32768, 1024, 1024, E, wave); } SEAM(14); }
#ifdef TIME_PHASE
        if (TIME_PHASE == 14) t_b = __builtin_amdgcn_s_memrealtime();
#endif
#ifdef TIME_PHASE
        if (TIME_PHASE == 15) t_a = __builtin_amdgcn_s_memrealtime();
#endif
        if (IN(15)) { { ElResid T{rm, 1.0f, 1}; tail_gemm((const bf16_t*)(ws + WS_YS), W_MIX, 1024, 32768, R2, T, wave); EpiResid E{rm, 1.0f, 1}; run_gemm(L, (const bf16_t*)(ws + WS_YS), W_MIX, 32768, 1024, 1024, E, wave); } SEAM(15); }
#ifdef TIME_PHASE
        if (TIME_PHASE == 15) t_b = __builtin_amdgcn_s_memrealtime();
#endif
#ifdef TIME_PHASE
        if (TIME_PHASE == 16) t_a = __builtin_amdgcn_s_memrealtime();
#endif
        if (IN(16)) { { TIDS bf16_t* hn = (bf16_t*)(ws + WS_Z); for (int row = gw; row < R2; row += 2 * NGW) { const int r1 = row + NGW; if (r1 < R2) norm_row2_bf16(hrow(rm, row), hrow(rm, r1), a.in[I_F2N], hn + (size_t)row * D, hn + (size_t)r1 * D, lane); else norm_row_bf16(hrow(rm, row), a.in[I_F2N], hn + (size_t)row * D, lane); } } SEAM(16); }
#ifdef TIME_PHASE
        if (TIME_PHASE == 16) t_b = __builtin_amdgcn_s_memrealtime();
#endif
#ifdef TIME_PHASE
        if (TIME_PHASE == 17) t_a = __builtin_amdgcn_s_memrealtime();
#endif
        if (IN(17)) { { EpiSwiglu E{(bf16_t*)(ws + WS_ACT)}; run_gemm(L, (const bf16_t*)(ws + WS_Z), W_GU, R2, 2 * FFN, 1024, E, wave); } SEAM(17); }
#ifdef TIME_PHASE
        if (TIME_PHASE == 17) t_b = __builtin_amdgcn_s_memrealtime();
#endif
#ifdef TIME_PHASE
        if (TIME_PHASE == 18) t_a = __builtin_amdgcn_s_memrealtime();
#endif
        if (IN(18)) { { ElResid T{rm, 0.5f, 1}; tail_gemm((const bf16_t*)(ws + WS_ACT), W_D, FFN, 32768, R2, T, wave); EpiResid E{rm, 0.5f, 1}; run_gemm(L, (const bf16_t*)(ws + WS_ACT), W_D, 32768, 1024, FFN, E, wave); } SEAM(18); }
#ifdef TIME_PHASE
        if (TIME_PHASE == 18) t_b = __builtin_amdgcn_s_memrealtime();
#endif
#ifdef TIME_PHASE
        if (TIME_PHASE == 19) t_a = __builtin_amdgcn_s_memrealtime();
#endif
        if (IN(19)) { { TIDS
            for (int row = gw; row < R2; row += NGW) { float* hp = a.out + (size_t)row * D; f32x4 v[4]; float s = 0.f;
#pragma unroll
                for (int j = 0; j < 4; ++j) { v[j] = ((const f32x4*)hp)[lane + 64 * j]; s += v[j][0] * v[j][0] + v[j][1] * v[j][1] + v[j][2] * v[j][2] + v[j][3] * v[j][3]; }
                const float rs = rsqrtf(wave_sum(s) * (1.f / 1024.f) + EPS);
#pragma unroll
                for (int j = 0; j < 4; ++j) { const f32x4 g = ((const f32x4*)a.in[I_FINN])[lane + 64 * j]; ((f32x4*)hp)[lane + 64 * j] = v[j] * rs * g; } }
        } SEAM(19); }
#ifdef TIME_PHASE
        if (TIME_PHASE == 19) t_b = __builtin_amdgcn_s_memrealtime();
#endif
        }
    }
#ifdef TIME_PHASE
    if (blockIdx.x == 0 && threadIdx.x == 0) a.out[0] = (float)(t_b - t_a) * 0.01f;
#endif
    __builtin_amdgcn_fence(__ATOMIC_RELEASE, "agent");
}

#ifndef N_LAUNCH_MODE
#define N_LAUNCH_MODE 1
#endif
extern "C" void kernel_launch(void* const* d_in, const int* in_sizes, int n_in, void* d_out, int out_size, void* d_ws, size_t ws_size, hipStream_t stream) {
    static int grid = 0;
    if (grid == 0) {
        if (n_in != 30 || ws_size < WS_END) { fprintf(stderr, "kernel_launch: unexpected n_in %d / ws_size %zu (need %zu)\n", n_in, ws_size, (size_t)WS_END); grid = -1; return; }
        int dev = 0, cus = 0, per_cu = 0;
        hipGetDevice(&dev); hipDeviceGetAttribute(&cus, hipDeviceAttributeMultiprocessorCount, dev);
        if (hipFuncSetAttribute((const void*)fwd_megakernel, hipFuncAttributeMaxDynamicSharedMemorySize, LDS_BYTES) != hipSuccess) { fprintf(stderr, "kernel_launch: hipFuncSetAttribute failed\n"); grid = -1; return; }
        if (hipOccupancyMaxActiveBlocksPerMultiprocessor(&per_cu, (const void*)fwd_megakernel, 512, LDS_BYTES) != hipSuccess || per_cu < 1) per_cu = 1;
        (void)hipGetLastError();
        grid = cus * 1;
        if (grid <= 0) grid = 256;
    }
    if (grid < 0) return;
    Args a{};
    for (int i = 0; i < 30; ++i) a.in[i] = (const float*)d_in[i];
    a.out = (float*)d_out; a.ws = (unsigned char*)d_ws;
#if N_LAUNCH_MODE == 1
    a.ph_lo = 0; a.ph_hi = NPHASE;
    if (hipMemsetAsync((unsigned char*)d_ws + WS_BAR, 0, 8192, stream) != hipSuccess) { fprintf(stderr, "memset failed\n"); return; }
    void* args[] = {&a};
    hipError_t e = hipLaunchCooperativeKernel((const void*)fwd_megakernel, dim3(grid), dim3(512), args, LDS_BYTES, stream);
    if (e != hipSuccess) fprintf(stderr, "cooperative launch failed: %s (grid %d)\n", hipGetErrorString(e), grid);
#else
    for (int ph = 0; ph < NPHASE; ++ph) { a.ph_lo = ph; a.ph_hi = ph + 1; hipLaunchKernelGGL(fwd_megakernel, dim3(grid), dim3(512), LDS_BYTES, stream, a); }
#endif
}
```

```cpp
#include <hip/hip_runtime.h>
#include <hip/hip_cooperative_groups.h>
#include <cstdio>
#include <cstdint>
namespace cg = cooperative_groups;
namespace pg8 {
#define PG8_LAS __attribute__((address_space(3)))
typedef unsigned short bf16_t;
typedef short bf16x8 __attribute__((ext_vector_type(8)));
typedef float f32x4 __attribute__((ext_vector_type(4)));
typedef unsigned u32x4 __attribute__((ext_vector_type(4)));
constexpr int BM = 256, BK = 64, HALF = 128, HTB = HALF * BK * 2  , STAGE_BYTES = 8 * HTB, NXCD = 8, WGM = 8;

__host__ __device__ __forceinline__ int lds_byte(int r, int c) { const int st = (r >> 4) * 2 + (c >> 5), rr = r & 15, cc = c & 31, ob = rr * 64 + cc * 2; return st * 1024 + (ob ^ (((ob >> 9) & 1) << 5)); }
__host__ __device__ __forceinline__ void stage_rc(int b, int& R, int& C) { const int st = b / 1024, sb = b % 1024, swz = sb ^ (((sb >> 9) & 1) << 5); R = (st >> 1) * 16 + swz / 64; C = (st & 1) * 32 + (swz % 64) / 2; }
__host__ __device__ __forceinline__ int perm32(int rho) { const int n = rho >> 4, i = rho & 15; return 8 * (i >> 2) + 4 * n + (i & 3); }

struct Unit { int pm, pn; };
struct Gemm { const bf16_t* A; const bf16_t* Bt; int M, N, K; };

struct StaticOrder {
    int nM, nN, nwg, G, c;
    __host__ __device__ void init(int M, int N, int G_, int c_) { nM = M / BM; nN = N / BM; nwg = nM * nN; G = G_; c = c_; }
    __host__ __device__ bool next(int i, Unit& u) const {
        const long L = (long)i * G + c; if (L >= nwg) return false;
        int wgid = (int)L; { const int q = nwg / NXCD, r = nwg % NXCD, xcd = wgid % NXCD, off = wgid / NXCD; wgid = (xcd < r ? xcd * (q + 1) : r * (q + 1) + (xcd - r) * q) + off; }
        const int nig = WGM * nN, gid = wgid / nig, fm = gid * WGM, gsz = (nM - fm) < WGM ? (nM - fm) : WGM;
        u.pm = fm + ((wgid % nig) % gsz); u.pn = (wgid % nig) / gsz; return true;
    }
    __device__ __forceinline__ void a_ready(const Unit&) const {}
    __device__ __forceinline__ void done(const Unit&) const {}
};
template <class Epi, class Sched, bool ALIGN_EPI = false, bool SP2 = false>
__device__ __forceinline__ void gemm_phase(PG8_LAS unsigned char* lds, const Gemm g, const Sched& S, const Epi& E, const int wid) {
    const int lane = (int)(__builtin_amdgcn_mbcnt_hi(~0u, __builtin_amdgcn_mbcnt_lo(~0u, 0u)) & 63u), tid = wid * 64 + lane, wr = wid >> 2, wc = wid & 3, fr = lane & 15, fq = lane >> 4;
    const int K = g.K, nt = K / BK;
    unsigned voffA[2], voffB[2];
#pragma unroll
    for (int i = 0; i < 2; ++i) { int R, C; stage_rc(tid * 16 + i * 8192, R, C); const int Rb = Epi::PERM ? ((R & ~31) + perm32(R & 31)) : R;
        voffA[i] = (unsigned)(R * K + C) * 2u; voffB[i] = (unsigned)(Rb * K + C) * 2u; }
    const size_t kstep = (size_t)(BK * 2);
    const size_t hstep = (size_t)HALF * K * 2;
    const size_t tstep = 2 * hstep;
    const unsigned ldsw = (unsigned)wid * 1024u;
    const int aoff = lds_byte(wr * 64 + fr, fq * 8), boff = lds_byte(wc * 32 + fr, fq * 8);
#define PG8_SA(b, h) (((b) * 2 + (h)) * HTB)
#define PG8_SB(b, h) ((4 + (b) * 2 + (h)) * HTB)
#define PG8_STAGE(bufoff, gbase, voff) do { _Pragma("unroll") for (int _i = 0; _i < 2; ++_i) \
        __builtin_amdgcn_global_load_lds((const unsigned*)((const char*)(gbase) + (voff)[_i]), (PG8_LAS unsigned*)(lds + (bufoff) + ldsw + _i * 8192), 16, 0, 0); } while (0)
#define PG8_LDA(dst, b, h) do { _Pragma("unroll") for (int m = 0; m < 4; ++m) _Pragma("unroll") for (int k = 0; k < 2; ++k) dst[m][k] = *(const PG8_LAS bf16x8*)(lds + PG8_SA(b, h) + aoff + m * 2048 + k * 1024); } while (0)
#define PG8_LDB(dst, b, h) do { _Pragma("unroll") for (int n = 0; n < 2; ++n) _Pragma("unroll") for (int k = 0; k < 2; ++k) dst[n][k] = *(const PG8_LAS bf16x8*)(lds + PG8_SB(b, h) + boff + n * 2048 + k * 1024); } while (0)
#define PG8_MMA(ai, bj, At, Bt) do { __builtin_amdgcn_s_setprio(1); _Pragma("unroll") for (int m = 0; m < 4; ++m) _Pragma("unroll") for (int n = 0; n < 2; ++n) _Pragma("unroll") for (int k = 0; k < 2; ++k) \
        acc[ai][bj][m][n] = __builtin_amdgcn_mfma_f32_16x16x32_bf16(Bt[n][k], At[m][k], acc[ai][bj][m][n], 0, 0, 0); __builtin_amdgcn_s_setprio(0); } while (0)
#define PG8_WAIT_V(n) asm volatile("s_waitcnt vmcnt(" #n ")" ::: "memory")
#define PG8_WAIT_L(n) asm volatile("s_waitcnt lgkmcnt(" #n ")" ::: "memory")
#define PG8_BAR __builtin_amdgcn_s_barrier()
#define PG8_SCHED __builtin_amdgcn_sched_barrier(0)
    Unit cur, nxt; int ui = 0;
    if (!S.next(0, cur)) return;
    f32x4 acc[2][2][4][2];
#pragma unroll
    for (int a = 0; a < 2; ++a)
#pragma unroll
        for (int b = 0; b < 2; ++b)
#pragma unroll
            for (int m = 0; m < 4; ++m)
#pragma unroll
                for (int n = 0; n < 2; ++n) acc[a][b][m][n] = (f32x4){0.f, 0.f, 0.f, 0.f};
    bf16x8 At[4][2], B0[2][2], B1[2][2];
    const char* cA = (const char*)g.A + (size_t)cur.pm * tstep; const char* cB = (const char*)g.Bt + (size_t)cur.pn * tstep;
    S.a_ready(cur);
    if constexpr (SP2) {
        PG8_STAGE(PG8_SB(0, 0), cB, voffB); PG8_STAGE(PG8_SB(0, 1), cB + hstep, voffB); PG8_STAGE(PG8_SA(0, 0), cA, voffA); PG8_STAGE(PG8_SA(0, 1), cA + hstep, voffA);
        if (wr == 1) PG8_BAR;
        PG8_WAIT_V(2); PG8_BAR;
        PG8_STAGE(PG8_SB(1, 0), cB + kstep, voffB); PG8_STAGE(PG8_SA(1, 0), cA + kstep, voffA); PG8_STAGE(PG8_SB(1, 1), cB + hstep + kstep, voffB);
        PG8_WAIT_V(6); PG8_BAR;
    } else {
        PG8_STAGE(PG8_SB(0, 0), cB, voffB); PG8_STAGE(PG8_SA(0, 0), cA, voffA); PG8_STAGE(PG8_SB(0, 1), cB + hstep, voffB); PG8_STAGE(PG8_SA(0, 1), cA + hstep, voffA);
        if (wr == 1) PG8_BAR;
        PG8_WAIT_V(4); PG8_BAR;
        PG8_STAGE(PG8_SB(1, 0), cB + kstep, voffB); PG8_STAGE(PG8_SA(1, 0), cA + kstep, voffA); PG8_STAGE(PG8_SB(1, 1), cB + hstep + kstep, voffB);
        PG8_WAIT_V(6); PG8_BAR;
    }
    for (;;) {
        const bool has_next = S.next(ui + 1, nxt);
        const char* nA = has_next ? (const char*)g.A + (size_t)nxt.pm * tstep : cA; const char* nB = has_next ? (const char*)g.Bt + (size_t)nxt.pn * tstep : cB;
        for (int t = 0; t < nt; t += 2) {
            const bool last = (t == nt - 2);
            const char* a1 = cA + (size_t)(t + 1) * kstep;
            const char* a2 = last ? nA : cA + (size_t)(t + 2) * kstep; const char* b2 = last ? nB : cB + (size_t)(t + 2) * kstep;
            const char* a3 = a2 + kstep; const char* b3 = b2 + kstep;
            if (last && has_next) S.a_ready(nxt);
            if constexpr (SP2) {
            PG8_LDB(B0, 0, 0); PG8_LDB(B1, 0, 1); PG8_SCHED; PG8_LDA(At, 0, 0); PG8_STAGE(PG8_SA(1, 1), a1 + hstep, voffA);
            PG8_WAIT_V(8); PG8_WAIT_L(0); PG8_BAR; PG8_MMA(0, 0, At, B0); PG8_MMA(0, 1, At, B1); PG8_BAR; PG8_SCHED;
            PG8_LDA(At, 0, 1); PG8_STAGE(PG8_SB(0, 0), b2, voffB); PG8_STAGE(PG8_SB(0, 1), b2 + hstep, voffB); PG8_STAGE(PG8_SA(0, 0), a2, voffA);
            PG8_WAIT_V(8); PG8_WAIT_L(0); PG8_BAR; PG8_MMA(1, 0, At, B0); PG8_MMA(1, 1, At, B1); PG8_BAR; PG8_SCHED;
            PG8_LDB(B0, 1, 0); PG8_LDB(B1, 1, 1); PG8_SCHED; PG8_LDA(At, 1, 0); PG8_STAGE(PG8_SA(0, 1), a2 + hstep, voffA);
            PG8_WAIT_V(8); PG8_WAIT_L(0); PG8_BAR; PG8_MMA(0, 0, At, B0); PG8_MMA(0, 1, At, B1); PG8_BAR; PG8_SCHED;
            PG8_LDA(At, 1, 1); PG8_STAGE(PG8_SB(1, 0), b3, voffB); PG8_STAGE(PG8_SB(1, 1), b3 + hstep, voffB); PG8_STAGE(PG8_SA(1, 0), a3, voffA);
            PG8_WAIT_V(8); PG8_WAIT_L(0); PG8_BAR; PG8_MMA(1, 0, At, B0); PG8_MMA(1, 1, At, B1); PG8_BAR; PG8_SCHED;
            } else {
            PG8_LDB(B0, 0, 0); PG8_SCHED; PG8_LDA(At, 0, 0); PG8_STAGE(PG8_SA(1, 1), a1 + hstep, voffA);
            PG8_WAIT_L(8); PG8_BAR; PG8_WAIT_L(0); PG8_MMA(0, 0, At, B0); PG8_BAR; PG8_SCHED;
            PG8_LDB(B1, 0, 1); PG8_STAGE(PG8_SB(0, 0), b2, voffB);
            PG8_BAR; PG8_WAIT_L(0); PG8_MMA(0, 1, At, B1); PG8_BAR;
            PG8_LDA(At, 0, 1); PG8_STAGE(PG8_SA(0, 0), a2, voffA);
            PG8_BAR; PG8_WAIT_L(0); PG8_MMA(1, 0, At, B0); PG8_BAR; PG8_SCHED;
            PG8_STAGE(PG8_SB(0, 1), b2 + hstep, voffB);
            PG8_WAIT_V(6); PG8_BAR; PG8_MMA(1, 1, At, B1); PG8_BAR;
            PG8_LDB(B0, 1, 0); PG8_SCHED; PG8_LDA(At, 1, 0); PG8_STAGE(PG8_SA(0, 1), a2 + hstep, voffA);
            PG8_WAIT_L(8); PG8_BAR; PG8_WAIT_L(0); PG8_MMA(0, 0, At, B0); PG8_BAR; PG8_SCHED;
            PG8_LDB(B1, 1, 1); PG8_STAGE(PG8_SB(1, 0), b3, voffB);
            PG8_BAR; PG8_WAIT_L(0); PG8_MMA(0, 1, At, B1); PG8_BAR;
            PG8_LDA(At, 1, 1); PG8_STAGE(PG8_SA(1, 0), a3, voffA);
            PG8_BAR; PG8_WAIT_L(0); PG8_MMA(1, 0, At, B0); PG8_BAR; PG8_SCHED;
            PG8_STAGE(PG8_SB(1, 1), b3 + hstep, voffB);
            PG8_WAIT_V(6); PG8_BAR; PG8_MMA(1, 1, At, B1); PG8_BAR;
            }
        }
        if constexpr (ALIGN_EPI) { if (wr == 0) PG8_BAR; }
        if constexpr (!Epi::AFTER_DRAIN) { E(acc, cur, wr, wc, fr, fq); S.done(cur); }
        if (!has_next) break;
#pragma unroll
        for (int a = 0; a < 2; ++a)
#pragma unroll
            for (int b = 0; b < 2; ++b)
#pragma unroll
                for (int m = 0; m < 4; ++m)
#pragma unroll
                    for (int n = 0; n < 2; ++n) acc[a][b][m][n] = (f32x4){0.f, 0.f, 0.f, 0.f};
        cur = nxt; cA = nA; cB = nB; ++ui;
        if constexpr (ALIGN_EPI) { if (wr == 1) PG8_BAR; }
    }
    PG8_WAIT_V(0);
    if constexpr (!ALIGN_EPI) { if (wr == 0) PG8_BAR; }
    PG8_BAR;
    if constexpr (Epi::AFTER_DRAIN) { E.fused(acc, cur, wr, wc, fr, fq, lds, wid, lane); S.done(cur); }
#undef PG8_SA
#undef PG8_SB
#undef PG8_STAGE
#undef PG8_LDA
#undef PG8_LDB
#undef PG8_MMA
#undef PG8_WAIT_V
#undef PG8_WAIT_L
#undef PG8_BAR
#undef PG8_SCHED
}
}
using namespace pg8;
#define LAS __attribute__((address_space(3)))
typedef short v4i16_t __attribute__((ext_vector_type(4)));
typedef unsigned u32x2 __attribute__((ext_vector_type(2)));
typedef float f32x2 __attribute__((ext_vector_type(2)));

constexpr int D = 1024, FFN = 2816;
constexpr int R_S0 = 32768;
constexpr int R_M0 = 33280;
constexpr int R_ACT = 33296;
constexpr int R1 = 33536;
constexpr int R2 = 33280;
constexpr int RK = 49920;
constexpr int R_C0 = 33536;
constexpr int NCHUNK = 146;
constexpr float EPS = 1e-6f;
constexpr float QSCALE = 0.14724448f;

constexpr size_t MiB = 1048576;
constexpr size_t WS_W_IN = 0, WS_W_GU = 16252928, WS_W_D = 27787264, WS_W_SO = 33554432, WS_W_UQ = 37748736, WS_W_K = 38928384, WS_W_V = 39452672,
                 WS_W_MO = 39976960, WS_W_MIX = 42074112, WS_ROPE = 44171264, WS_HMETA = 46270464, WS_KRB = 47319040, WS_TOT = 50513920, WS_BAR = 50540544;
constexpr size_t WS_Z = 49 * MiB, WS_X = 180 * MiB, WS_U = 376 * MiB + MiB / 2, WS_MISC = 442 * MiB, WS_HALO = WS_MISC + (size_t)R1 * 768 * 2;
constexpr size_t WS_DT = WS_U, WS_ACS = WS_U + 4292608, WS_CQN = WS_U + 8585216, WS_CKVB = WS_U + 34144256, WS_S = WS_U + 57 * MiB;
constexpr size_t WS_YS = 447 * MiB, WS_Q = WS_Z, WS_KN = WS_X, WS_VT = WS_X + 102236160, WS_O = WS_U, WS_G = WS_X, WS_ACT = WS_X;
constexpr size_t WS_END = 512 * MiB;
static_assert(WS_S + (size_t)NCHUNK * 32 * 8192 * 2 <= WS_END && WS_O + (size_t)R2 * 1024 * 2 <= WS_YS && WS_YS + (size_t)R2 * 1024 * 2 <= WS_END, "ws map 4");
static_assert(WS_END <= 512 * MiB, "ws map");
static_assert(WS_CKVB + (size_t)RK * 256 * 2 <= WS_S, "ws map 2");
static_assert(WS_HALO + 514 * 3 * 3072 * 2 <= 512 * MiB, "ws map 3");

constexpr size_t OUT_YP = 0, OUT_YS = 33554432, OUT_CKVP = 34078720, OUT_KRP = 42475520, OUT_SSMP = 43525120, OUT_CONVP = 44049408,
                 OUT_CKVS = 44067840, OUT_KRS = 44198912, OUT_SSMS = 44215296, OUT_CONVS = 48409600;

enum { I_XP = 0, I_XS, I_CCKV, I_CKR, I_SSSM, I_SCONV, I_META, I_F1N, I_F1GU, I_F1D, I_MIXN, I_WIN, I_GBIAS, I_CONVW, I_CONVB, I_DTB, I_ALOG, I_SSMD,
       I_SSMN, I_WSO, I_QN, I_WUQ, I_KVN, I_WUKV, I_WMO, I_WMIX, I_F2N, I_F2GU, I_F2D, I_FINN };

struct Args { const float* in[30]; float* out; unsigned char* ws; int ph_lo, ph_hi; };

__device__ __forceinline__ unsigned f2bf(float f) { unsigned u = __builtin_bit_cast(unsigned, f); return (u + 0x7fffu + ((u >> 16) & 1u)) >> 16; }
typedef float f32x2_t __attribute__((ext_vector_type(2))); typedef __bf16 bf16x2_t __attribute__((ext_vector_type(2)));
__device__ __forceinline__ unsigned cvtpk(float lo, float hi) { f32x2_t v = {lo, hi}; bf16x2_t b = __builtin_convertvector(v, bf16x2_t); return __builtin_bit_cast(unsigned, b); }
__device__ __forceinline__ float bflo(unsigned u) { return __builtin_bit_cast(float, u << 16); }
__device__ __forceinline__ float bfhi(unsigned u) { return __builtin_bit_cast(float, u & 0xffff0000u); }
__device__ __forceinline__ float bf2f(bf16_t b) { return __builtin_bit_cast(float, (unsigned)b << 16); }
__device__ __forceinline__ float wave_sum(float v) {
#pragma unroll
    for (int o = 1; o < 64; o <<= 1) v += __shfl_xor(v, o);
    return v;
}
__device__ __forceinline__ float silu_f(float x) { return x * __builtin_amdgcn_rcpf(1.f + __expf(-x)); }
__device__ __forceinline__ float sigmoid_f(float x) { return __builtin_amdgcn_rcpf(1.f + __expf(-x)); }
__device__ __forceinline__ float softplus_f(float x) {
    const float e = __expf(x);
    const float sp = e < 0.02f ? e * (1.f - e * (0.5f - e * (0.33333334f - 0.25f * e))) : __logf(1.f + e);
    return x > 15.f ? x : sp;
}
__device__ __forceinline__ int pos_idx(int row) {
    if (row < R_S0) return (row & 16383) + 16;
    if (row < R_M0) return 1024 + ((row - R_S0) & 31) + 16;
    return row - R_M0;
}
__device__ __forceinline__ void chunk_info(int ci, int& row0, int& ntok) {
    if (ci < 130) { const int b = ci / 65, k = ci - b * 65; if (k == 0) { row0 = R_M0; ntok = 16; } else { row0 = b * 16384 + 256 * (k - 1); ntok = 256; } }
    else { row0 = R_S0 + 32 * (ci - 130); ntok = 32; }
}
__device__ __forceinline__ v4i16_t ldtr(const LAS bf16_t* p) { return __builtin_amdgcn_ds_read_tr16_b64_v4i16((LAS v4i16_t*)p); }
__device__ __forceinline__ bf16x8 cat8(v4i16_t a, v4i16_t b) { return __builtin_shufflevector(a, b, 0, 1, 2, 3, 4, 5, 6, 7); }
__device__ __forceinline__ bf16x8 cat8u(u32x2 a, u32x2 b) { u32x4 t = {a.x, a.y, b.x, b.y}; return __builtin_bit_cast(bf16x8, t); }
#define MFMA16(a, b, c) __builtin_amdgcn_mfma_f32_16x16x32_bf16((a), (b), (c), 0, 0, 0)

struct EpiSwiglu {
    static constexpr bool PERM = true, AFTER_DRAIN = false; bf16_t* O;
    __device__ __forceinline__ void operator()(const f32x4 (&acc)[2][2][4][2], const Unit& u, int wr, int wc, int fr, int fq) const {
        const int row0 = u.pm * 256 + wr * 64 + fr, col0 = u.pn * 128 + wc * 32 + 8 * fq;
#pragma unroll
        for (int ai = 0; ai < 2; ++ai)
#pragma unroll
            for (int m = 0; m < 4; ++m) {
                const f32x4 g0 = acc[ai][0][m][0], g1 = acc[ai][0][m][1], u0 = acc[ai][1][m][0], u1 = acc[ai][1][m][1];
                u32x4 w; w.x = cvtpk(silu_f(g0[0]) * u0[0], silu_f(g0[1]) * u0[1]); w.y = cvtpk(silu_f(g0[2]) * u0[2], silu_f(g0[3]) * u0[3]);
                w.z = cvtpk(silu_f(g1[0]) * u1[0], silu_f(g1[1]) * u1[1]); w.w = cvtpk(silu_f(g1[2]) * u1[2], silu_f(g1[3]) * u1[3]);
                *(u32x4*)(O + (size_t)(row0 + ai * 128 + m * 16) * FFN + col0) = w;
            }
    }
};
struct RowMap { float* out; float* hmeta; const float* xp; const float* xs; const float* meta; };
__device__ __forceinline__ float* hrow(const RowMap& a, int row) { return row < R2 ? a.out + (size_t)row * D : a.hmeta + (size_t)(row - R2) * D; }
__device__ __forceinline__ const float* xrow(const RowMap& a, int row) {
    if (row < R_S0) return a.xp + (size_t)row * D;
    if (row < R_M0) return a.xs + (size_t)(row - R_S0) * D;
    if (row < R_ACT) return a.meta + (size_t)(row - R_M0) * D;
    return nullptr;
}
struct EpiResid {
    static constexpr bool PERM = true, AFTER_DRAIN = false; RowMap a; float s; int mode;
    __device__ __forceinline__ void operator()(const f32x4 (&acc)[2][2][4][2], const Unit& u, int wr, int wc, int fr, int fq) const {
        const int row0 = u.pm * 256 + wr * 64 + fr, col0 = u.pn * 256 + wc * 32 + 8 * fq;
#pragma unroll
        for (int ai = 0; ai < 2; ++ai)
#pragma unroll
            for (int m = 0; m < 4; ++m) {
                const int row = row0 + ai * 128 + m * 16; float* hp = hrow(a, row); const float* bp = mode ? hp : xrow(a, row);
#pragma unroll
                for (int bj = 0; bj < 2; ++bj) {
                    const int c = col0 + bj * 128; f32x4 b0 = {0.f, 0.f, 0.f, 0.f}, b1 = b0;
                    if (bp) { b0 = *(const f32x4*)(bp + c); b1 = *(const f32x4*)(bp + c + 4); }
                    *(f32x4*)(hp + c) = b0 + acc[ai][bj][m][0] * s; *(f32x4*)(hp + c + 4) = b1 + acc[ai][bj][m][1] * s;
                }
            }
    }
};
struct EpiProj {
    static constexpr bool PERM = true, AFTER_DRAIN = false; bf16_t *Z, *X, *MISC, *HALO; float* out;
    __device__ __forceinline__ void operator()(const f32x4 (&acc)[2][2][4][2], const Unit& u, int wr, int wc, int fr, int fq) const {
        const int row0 = u.pm * 256 + wr * 64 + fr; const int pn = u.pn;
#pragma unroll
        for (int ai = 0; ai < 2; ++ai)
#pragma unroll
            for (int m = 0; m < 4; ++m) {
                const int row = row0 + ai * 128 + m * 16;
#pragma unroll
                for (int bj = 0; bj < 2; ++bj) {
                    const f32x4 v0 = acc[ai][bj][m][0], v1 = acc[ai][bj][m][1];
                    u32x4 w; w.x = cvtpk(v0[0], v0[1]); w.y = cvtpk(v0[2], v0[3]); w.z = cvtpk(v1[0], v1[1]); w.w = cvtpk(v1[2], v1[3]);
                    const int ct = bj * 128 + wc * 32 + 8 * fq;
                    if (pn < 8) { *(u32x4*)(Z + (size_t)row * 2048 + pn * 256 + ct) = w; }
                    else if (pn < 20) {
                        const int cx = (pn - 8) * 256 + ct;
                        *(u32x4*)(X + (size_t)row * 3072 + cx) = w;
                        if (row < R_S0) {
                            const int r6 = row & 63;
                            if (r6 >= 61) { const int T = (row >> 6) + 1; if (T & 255) *(u32x4*)(HALO + ((size_t)T * 3 + (r6 - 61)) * 3072 + cx) = w; }
                            const int t = row & 16383;
                            if (t >= 16381) { float* o = out + OUT_CONVP + ((size_t)(row >> 14) * 3 + (t - 16381)) * 3072 + cx; *(f32x4*)o = v0; *(f32x4*)(o + 4) = v1; }
                        } else if (row < R_M0) {
                            const int t = (row - R_S0) & 31, db = (row - R_S0) >> 5;
                            if (t >= 29) { float* o = out + OUT_CONVS + ((size_t)db * 3 + (t - 29)) * 3072 + cx; *(f32x4*)o = v0; *(f32x4*)(o + 4) = v1; }
                        } else if (row >= R_M0 + 13 && row < R_ACT) {
                            const int sl = row - R_M0 - 13;
                            *(u32x4*)(HALO + ((size_t)0 * 3 + sl) * 3072 + cx) = w; *(u32x4*)(HALO + ((size_t)256 * 3 + sl) * 3072 + cx) = w;
                        }
                    } else { *(u32x4*)(MISC + (size_t)row * 768 + (pn - 20) * 256 + ct) = w; }
                }
            }
    }
};
struct EpiBf16 {
    static constexpr bool PERM = true, AFTER_DRAIN = false; bf16_t* O; int ldc; float sc;
    __device__ __forceinline__ void operator()(const f32x4 (&acc)[2][2][4][2], const Unit& u, int wr, int wc, int fr, int fq) const {
        const int row0 = u.pm * 256 + wr * 64 + fr, col0 = u.pn * 256 + wc * 32 + 8 * fq;
#pragma unroll
        for (int ai = 0; ai < 2; ++ai)
#pragma unroll
            for (int m = 0; m < 4; ++m)
#pragma unroll
                for (int bj = 0; bj < 2; ++bj) {
                    const f32x4 v0 = acc[ai][bj][m][0] * sc, v1 = acc[ai][bj][m][1] * sc;
                    u32x4 w; w.x = cvtpk(v0[0], v0[1]); w.y = cvtpk(v0[2], v0[3]); w.z = cvtpk(v1[0], v1[1]); w.w = cvtpk(v1[2], v1[3]);
                    *(u32x4*)(O + (size_t)(row0 + ai * 128 + m * 16) * ldc + col0 + bj * 128) = w;
                }
    }
};
struct EpiGate {
    static constexpr bool PERM = true, AFTER_DRAIN = false; bf16_t* G; const float* bias;
    __device__ __forceinline__ void operator()(const f32x4 (&acc)[2][2][4][2], const Unit& u, int wr, int wc, int fr, int fq) const {
        const int row0 = u.pm * 256 + wr * 64 + fr, col0 = u.pn * 256 + wc * 32 + 8 * fq;
#pragma unroll
        for (int bj = 0; bj < 2; ++bj) {
            const int c = col0 + bj * 128; const f32x4 b0 = *(const f32x4*)(bias + c), b1 = *(const f32x4*)(bias + c + 4);
#pragma unroll
            for (int ai = 0; ai < 2; ++ai)
#pragma unroll
                for (int m = 0; m < 4; ++m) {
                    const f32x4 v0 = acc[ai][bj][m][0] + b0, v1 = acc[ai][bj][m][1] + b1;
                    u32x4 w; w.x = cvtpk(sigmoid_f(v0[0]), sigmoid_f(v0[1])); w.y = cvtpk(sigmoid_f(v0[2]), sigmoid_f(v0[3]));
                    w.z = cvtpk(sigmoid_f(v1[0]), sigmoid_f(v1[1])); w.w = cvtpk(sigmoid_f(v1[2]), sigmoid_f(v1[3]));
                    *(u32x4*)(G + (size_t)(row0 + ai * 128 + m * 16) * 2048 + c) = w;
                }
        }
    }
};
struct EpiMerge {
    static constexpr bool PERM = true, AFTER_DRAIN = false; const bf16_t* G; bf16_t* YS;
    __device__ __forceinline__ void operator()(const f32x4 (&acc)[2][2][4][2], const Unit& u, int wr, int wc, int fr, int fq) const {
        const int row0 = u.pm * 256 + wr * 64 + fr, col0 = u.pn * 256 + wc * 32 + 8 * fq;
#pragma unroll
        for (int ai = 0; ai < 2; ++ai)
#pragma unroll
            for (int m = 0; m < 4; ++m)
#pragma unroll
                for (int bj = 0; bj < 2; ++bj) {
                    const int row = row0 + ai * 128 + m * 16, c = col0 + bj * 128;
                    const u32x4 gs = *(const u32x4*)(G + (size_t)row * 2048 + c), gm = *(const u32x4*)(G + (size_t)row * 2048 + 1024 + c), ys = *(const u32x4*)(YS + (size_t)row * 1024 + c);
                    const f32x4 v0 = acc[ai][bj][m][0], v1 = acc[ai][bj][m][1];
                    u32x4 w;
                    w.x = cvtpk(bflo(gs.x) * bflo(ys.x) + bflo(gm.x) * v0[0], bfhi(gs.x) * bfhi(ys.x) + bfhi(gm.x) * v0[1]);
                    w.y = cvtpk(bflo(gs.y) * bflo(ys.y) + bflo(gm.y) * v0[2], bfhi(gs.y) * bfhi(ys.y) + bfhi(gm.y) * v0[3]);
                    w.z = cvtpk(bflo(gs.z) * bflo(ys.z) + bflo(gm.z) * v1[0], bfhi(gs.z) * bfhi(ys.z) + bfhi(gm.z) * v1[1]);
                    w.w = cvtpk(bflo(gs.w) * bflo(ys.w) + bflo(gm.w) * v1[2], bfhi(gs.w) * bfhi(ys.w) + bfhi(gm.w) * v1[3]);
                    *(u32x4*)(YS + (size_t)row * 1024 + c) = w;
                }
    }
};
__device__ __forceinline__ int lane_id() { return (int)(__builtin_amdgcn_mbcnt_hi(~0u, __builtin_amdgcn_mbcnt_lo(~0u, 0u)) & 63u); }
template <class Epi> __device__ __forceinline__ void run_gemm(LAS unsigned char* lds, const bf16_t* A, const bf16_t* Bt, int M, int N, int K, const Epi& E, int wave) {
    Gemm g{A, Bt, M, N, K}; StaticOrder S; S.init(M, N, (int)gridDim.x, (int)blockIdx.x);
    gemm_phase<Epi, StaticOrder, false, true>(lds, g, S, E, wave);
    __syncthreads();
}

struct ElResid { RowMap a; float s; int mode; __device__ __forceinline__ void operator()(int row, int col, float v) const {
    float* hp = hrow(a, row) + col; float b = 0.f; if (mode) b = *hp; else { const float* xp = xrow(a, row); if (xp) b = xp[col]; } *hp = b + s * v; } };
struct ElBf16 { bf16_t* O; int ldc; __device__ __forceinline__ void operator()(int row, int col, float v) const { O[(size_t)row * ldc + col] = (bf16_t)(cvtpk(v, 0.f) & 0xffffu); } };
struct ElMerge { const bf16_t* G; bf16_t* YS; __device__ __forceinline__ void operator()(int row, int col, float v) const {
    const float gs = bf2f(G[(size_t)row * 2048 + col]), gm = bf2f(G[(size_t)row * 2048 + 1024 + col]); bf16_t* p = YS + (size_t)row * 1024 + col; *p = (bf16_t)(cvtpk(gs * bf2f(*p) + gm * v, 0.f) & 0xffffu); } };
template <class El> __device__ __forceinline__ void tail_gemm(const bf16_t* A, const bf16_t* Bt, int K, int row_begin, int row_end, const El& E, int wave) {
    const int lane = lane_id(), li = lane & 15, quad = lane >> 4; const int gw = blockIdx.x * 8 + wave, NGW = gridDim.x * 8;
    const int total = ((row_end - row_begin) >> 4) * 64;
    for (int blk = gw; blk < total; blk += NGW) {
        const int rb = blk >> 6, cb = blk & 63;
        const bf16_t* ap = A + (size_t)(row_begin + 16 * rb + li) * K + 8 * quad; const bf16_t* bp = Bt + (size_t)(16 * cb + li) * K + 8 * quad;
        f32x4 acc = {0.f, 0.f, 0.f, 0.f};
        for (int k = 0; k < K; k += 256) { bf16x8 af[8], bf[8];
#pragma unroll
            for (int e = 0; e < 8; ++e) { af[e] = *(const bf16x8*)(ap + k + 32 * e); bf[e] = *(const bf16x8*)(bp + k + 32 * e); }
#pragma unroll
            for (int e = 0; e < 8; ++e) acc = MFMA16(af[e], bf[e], acc); }
#pragma unroll
        for (int j = 0; j < 4; ++j) E(row_begin + 16 * rb + 4 * quad + j, 16 * cb + li, acc[j]);
    }
}

__device__ __forceinline__ int srccol(int mapid, int n) {
    switch (mapid) {
        case 0: return n;
        case 1: { const int pn = n >> 8, bj = (n >> 7) & 1, i = n & 127; return (bj ? FFN : 0) + pn * 128 + i; }
        case 2: return n < 5824 ? n : (n < 5888 ? -1 : n - 64);
        case 3: return n < 1024 ? (n >> 6) * 96 + (n & 63) : ((n - 1024) >> 5) * 96 + 64 + ((n - 1024) & 31);
        case 4: return (n >> 6) * 128 + (n & 63);
        default: return (n >> 6) * 128 + 64 + (n & 63);
    }
}
__device__ __forceinline__ void xpose_matrix(const float* __restrict__ src, int K, int Nsrc, bf16_t* dst, int Ndst, int mapid, LAS float* scr, int tid) {
    const int nblk = Ndst >> 6, nitems = (K >> 6) * nblk;
    for (int item = blockIdx.x; item < nitems; item += gridDim.x) {
        const int kb = item / nblk, nb = item - kb * nblk, k0 = kb * 64, n0 = nb * 64;
        __syncthreads();
#pragma unroll
        for (int i = 0; i < 8; ++i) { const int idx = tid + 512 * i, kk = idx >> 6, nn = idx & 63; const int sc = srccol(mapid, n0 + nn);
            scr[nn * 65 + kk] = sc >= 0 ? src[(size_t)(k0 + kk) * Nsrc + sc] : 0.f; }
        __syncthreads();
        { const int nn = tid >> 3, c = tid & 7; const LAS float* s = scr + nn * 65 + 8 * c;
          u32x4 o; o.x = cvtpk(s[0], s[1]); o.y = cvtpk(s[2], s[3]); o.z = cvtpk(s[4], s[5]); o.w = cvtpk(s[6], s[7]);
          *(u32x4*)(dst + (size_t)(n0 + nn) * K + k0 + 8 * c) = o; }
    }
}
__device__ __forceinline__ void norm_row_bf16(const float* src, const float* gain, bf16_t* dst, int lane) {
    f32x4 v[4]; float s = 0.f;
#pragma unroll
    for (int j = 0; j < 4; ++j) { v[j] = src ? ((const f32x4*)src)[lane + 64 * j] : (f32x4){0.f, 0.f, 0.f, 0.f}; s += v[j][0] * v[j][0] + v[j][1] * v[j][1] + v[j][2] * v[j][2] + v[j][3] * v[j][3]; }
    const float rs = rsqrtf(wave_sum(s) * (1.f / 1024.f) + EPS);
#pragma unroll
    for (int j = 0; j < 4; ++j) { const f32x4 g = ((const f32x4*)gain)[lane + 64 * j];
        u32x2 o = {cvtpk(v[j][0] * rs * g[0], v[j][1] * rs * g[1]), cvtpk(v[j][2] * rs * g[2], v[j][3] * rs * g[3])}; ((u32x2*)dst)[lane + 64 * j] = o; }
}

__device__ __forceinline__ void norm_row2_bf16(const float* s0, const float* s1, const float* gain, bf16_t* d0, bf16_t* d1, int lane) {
    f32x4 v[4], w[4]; float a = 0.f, b = 0.f;
#pragma unroll
    for (int j = 0; j < 4; ++j) { v[j] = s0 ? ((const f32x4*)s0)[lane + 64 * j] : (f32x4){0.f, 0.f, 0.f, 0.f}; w[j] = s1 ? ((const f32x4*)s1)[lane + 64 * j] : (f32x4){0.f, 0.f, 0.f, 0.f}; }
#pragma unroll
    for (int j = 0; j < 4; ++j) { a += v[j][0] * v[j][0] + v[j][1] * v[j][1] + v[j][2] * v[j][2] + v[j][3] * v[j][3]; b += w[j][0] * w[j][0] + w[j][1] * w[j][1] + w[j][2] * w[j][2] + w[j][3] * w[j][3]; }
    const float ra = rsqrtf(wave_sum(a) * (1.f / 1024.f) + EPS), rb = rsqrtf(wave_sum(b) * (1.f / 1024.f) + EPS);
#pragma unroll
    for (int j = 0; j < 4; ++j) { const f32x4 g = ((const f32x4*)gain)[lane + 64 * j];
        u32x2 o = {cvtpk(v[j][0] * ra * g[0], v[j][1] * ra * g[1]), cvtpk(v[j][2] * ra * g[2], v[j][3] * ra * g[3])}; ((u32x2*)d0)[lane + 64 * j] = o;
        u32x2 p = {cvtpk(w[j][0] * rb * g[0], w[j][1] * rb * g[1]), cvtpk(w[j][2] * rb * g[2], w[j][3] * rb * g[3])}; ((u32x2*)d1)[lane + 64 * j] = p; }
}

__device__ __forceinline__ void p5_phase(const Args& a, const int wave) {
    const int lane = lane_id(); int tid = wave * 64 + lane; asm volatile("" : "+v"(tid)); tid &= 511; const int gw = blockIdx.x * 8 + wave, NGW = gridDim.x * 8;
    unsigned char* ws = a.ws;
    const bf16_t* misc = (const bf16_t*)(ws + WS_MISC); float* dt = (float*)(ws + WS_DT); float* acs = (float*)(ws + WS_ACS); float* tot = (float*)(ws + WS_TOT);
    bf16_t* cqn = (bf16_t*)(ws + WS_CQN); bf16_t* ckvb = (bf16_t*)(ws + WS_CKVB); bf16_t* krb = (bf16_t*)(ws + WS_KRB); bf16_t* xc = (bf16_t*)(ws + WS_X);
    const bf16_t* halo = (const bf16_t*)(ws + WS_HALO); const float* rope = (const float*)(ws + WS_ROPE);
    for (int ci = gw; ci < NCHUNK; ci += NGW) {
        int row0, ntok; chunk_info(ci, row0, ntok);
        const int h = lane & 31;
        const float A = -__expf(a.in[I_ALOG][h]), bias = a.in[I_DTB][h]; float accv = 0.f;
        for (int t = 0; t < ntok; t += 16) { float v[16];
#pragma unroll
            for (int k = 0; k < 16; ++k) v[k] = bf2f(misc[(size_t)(row0 + t + k) * 768 + h]);
#pragma unroll
            for (int k = 0; k < 16; ++k) { accv += softplus_f(v[k] + bias) * A; if (lane < 32) acs[(size_t)(row0 + t + k) * 32 + h] = accv; } }
        if (lane < 32) tot[ci * 32 + h] = accv;
    }
    for (int row = gw; row < R_ACT; row += NGW) {
        const bf16_t* mr = misc + (size_t)row * 768;
        if (lane < 32) dt[(size_t)row * 32 + lane] = softplus_f(bf2f(mr[lane]) + a.in[I_DTB][lane]);
        { const unsigned* cp = (const unsigned*)(mr + 32) + 3 * lane; const unsigned c0 = cp[0], c1 = cp[1], c2 = cp[2];
          float q[6] = {bflo(c0), bfhi(c0), bflo(c1), bfhi(c1), bflo(c2), bfhi(c2)}; float ss = 0.f;
#pragma unroll
          for (int e = 0; e < 6; ++e) ss += q[e] * q[e];
          const float rs = rsqrtf(wave_sum(ss) * (1.f / 384.f) + EPS);
          if (row < R2) { const float* gq = a.in[I_QN] + 6 * lane; unsigned* op = (unsigned*)(cqn + (size_t)row * 384) + 3 * lane;
              op[0] = cvtpk(q[0] * rs * gq[0], q[1] * rs * gq[1]); op[1] = cvtpk(q[2] * rs * gq[2], q[3] * rs * gq[3]); op[2] = cvtpk(q[4] * rs * gq[4], q[5] * rs * gq[5]); } }
        { const u32x2 kv = *(const u32x2*)(mr + 416 + 4 * lane); float v[4] = {bflo(kv.x), bfhi(kv.x), bflo(kv.y), bfhi(kv.y)};
          const float rs = rsqrtf(wave_sum(v[0] * v[0] + v[1] * v[1] + v[2] * v[2] + v[3] * v[3]) * (1.f / 256.f) + EPS);
          const f32x4 g = *(const f32x4*)(a.in[I_KVN] + 4 * lane); const f32x4 o = {v[0] * rs * g[0], v[1] * rs * g[1], v[2] * rs * g[2], v[3] * rs * g[3]};
          if (row < R_S0) *(f32x4*)(a.out + OUT_CKVP + ((size_t)(row >> 14) * 16400 + 16 + (row & 16383)) * 256 + 4 * lane) = o;
          else if (row < R_M0) *(f32x4*)(a.out + OUT_CKVS + (size_t)(row - R_S0) * 256 + 4 * lane) = o;
          else { *(f32x4*)(a.out + OUT_CKVP + (size_t)(row - R_M0) * 256 + 4 * lane) = o; *(f32x4*)(a.out + OUT_CKVP + (size_t)(16400 + row - R_M0) * 256 + 4 * lane) = o; }
          u32x2 ob = {cvtpk(o[0], o[1]), cvtpk(o[2], o[3])}; *(u32x2*)(ckvb + (size_t)row * 256 + 4 * lane) = ob; }
        if (lane < 16) { const float x1 = bf2f(mr[672 + lane]), x2 = bf2f(mr[688 + lane]); const f32x2 cs = *(const f32x2*)(rope + ((size_t)pos_idx(row) * 16 + lane) * 2);
          const float o1 = x1 * cs[0] - x2 * cs[1], o2 = x1 * cs[1] + x2 * cs[0];
          if (row < R_S0) { float* p = a.out + OUT_KRP + ((size_t)(row >> 14) * 16400 + 16 + (row & 16383)) * 32; p[lane] = o1; p[16 + lane] = o2; }
          else if (row < R_M0) { float* p = a.out + OUT_KRS + (size_t)(row - R_S0) * 32; p[lane] = o1; p[16 + lane] = o2; }
          else { float* p = a.out + OUT_KRP + (size_t)(row - R_M0) * 32; p[lane] = o1; p[16 + lane] = o2; p += (size_t)16400 * 32; p[lane] = o1; p[16 + lane] = o2; }
          krb[(size_t)row * 32 + lane] = (bf16_t)f2bf(o1); krb[(size_t)row * 32 + 16 + lane] = (bf16_t)f2bf(o2); }
    }
    for (int row = R_ACT + gw; row < R1; row += NGW) { u32x2 z = {0u, 0u}; *(u32x2*)(ckvb + (size_t)row * 256 + 4 * lane) = z; if (lane < 16) ((unsigned*)(krb + (size_t)row * 32))[lane] = 0u; }
    for (int r = gw; r < 16384; r += NGW) {
        const f32x4 v = *(const f32x4*)(a.in[I_CCKV] + (size_t)r * 256 + 4 * lane); u32x2 o = {cvtpk(v[0], v[1]), cvtpk(v[2], v[3])}; *(u32x2*)(ckvb + (size_t)(R_C0 + r) * 256 + 4 * lane) = o;
        if (lane < 8) { const f32x4 k = *(const f32x4*)(a.in[I_CKR] + (size_t)r * 32 + 4 * lane); u32x2 ok = {cvtpk(k[0], k[1]), cvtpk(k[2], k[3])}; *(u32x2*)(krb + (size_t)(R_C0 + r) * 32 + 4 * lane) = ok; }
    }
    for (int item = NGW - 1 - gw; item < 529 * 6; item += NGW) {
        const int T = item / 6, cc = item - T * 6, c0 = cc * 512 + lane * 8;
        int row0, nrows; float p0[8], p1[8], p2[8];
        if (T < 512) { row0 = T * 64; nrows = 64; const bf16_t* hp = halo + (size_t)T * 3 * 3072 + c0;
            const u32x4 h0 = *(const u32x4*)hp, h1 = *(const u32x4*)(hp + 3072), h2 = *(const u32x4*)(hp + 6144);
#pragma unroll
            for (int e = 0; e < 4; ++e) { p0[2 * e] = bflo(h0[e]); p0[2 * e + 1] = bfhi(h0[e]); p1[2 * e] = bflo(h1[e]); p1[2 * e + 1] = bfhi(h1[e]); p2[2 * e] = bflo(h2[e]); p2[2 * e + 1] = bfhi(h2[e]); } }
        else if (T == 512) { row0 = R_M0; nrows = 16;
#pragma unroll
            for (int e = 0; e < 8; ++e) { p0[e] = 0.f; p1[e] = 0.f; p2[e] = 0.f; } }
        else { const int db = T - 513; row0 = R_S0 + 32 * db; nrows = 32; const float* sp = a.in[I_SCONV] + (size_t)db * 3 * 3072 + c0;
#pragma unroll
            for (int e = 0; e < 8; ++e) { p0[e] = sp[e]; p1[e] = sp[3072 + e]; p2[e] = sp[6144 + e]; } }
        float w0[8], w1[8], w2[8], w3[8], bb[8];
#pragma unroll
        for (int e = 0; e < 8; ++e) { w0[e] = a.in[I_CONVW][c0 + e]; w1[e] = a.in[I_CONVW][3072 + c0 + e]; w2[e] = a.in[I_CONVW][6144 + c0 + e]; w3[e] = a.in[I_CONVW][9216 + c0 + e]; bb[e] = a.in[I_CONVB][c0 + e]; }
        for (int t0 = 0; t0 < nrows; t0 += 8) {
            u32x4 raw[8];
#pragma unroll
            for (int k = 0; k < 8; ++k) raw[k] = *(const u32x4*)(xc + (size_t)(row0 + t0 + k) * 3072 + c0);
#pragma unroll
            for (int k = 0; k < 8; ++k) { float x[8], y[8];
#pragma unroll
                for (int e = 0; e < 4; ++e) { x[2 * e] = bflo(raw[k][e]); x[2 * e + 1] = bfhi(raw[k][e]); }
#pragma unroll
                for (int e = 0; e < 8; ++e) { y[e] = silu_f(bb[e] + w0[e] * p0[e] + w1[e] * p1[e] + w2[e] * p2[e] + w3[e] * x[e]); p0[e] = p1[e]; p1[e] = p2[e]; p2[e] = x[e]; }
                u32x4 o; o.x = cvtpk(y[0], y[1]); o.y = cvtpk(y[2], y[3]); o.z = cvtpk(y[4], y[5]); o.w = cvtpk(y[6], y[7]);
                *(u32x4*)(xc + (size_t)(row0 + t0 + k) * 3072 + c0) = o; }
        }
    }
}

__device__ __forceinline__ void p6_phase(const Args& a, LAS unsigned char* L, const int wave) {
    const int lane = lane_id(); int tid = wave * 64 + lane; asm volatile("" : "+v"(tid)); tid &= 511;
    unsigned char* ws = a.ws; const bf16_t* xc = (const bf16_t*)(ws + WS_X); const float* dt = (const float*)(ws + WS_DT); const float* acs = (const float*)(ws + WS_ACS);
    const float* tot = (const float*)(ws + WS_TOT); bf16_t* S = (bf16_t*)(ws + WS_S);
    LAS bf16_t* Bs = (LAS bf16_t*)L; LAS bf16_t* Xs = (LAS bf16_t*)(L + 18432); LAS float* scs = (LAS float*)(L + 86016);
    const int li = lane & 15, quad = lane >> 4;
    const unsigned voffB = (unsigned)((tid >> 4) * 3072 + (tid & 15) * 8), voffX = (unsigned)((tid >> 6) * 3072 + (tid & 63) * 8);
    for (int unit = blockIdx.x; unit < NCHUNK * 4; unit += gridDim.x) {
        const int ci = unit >> 2, g = unit & 3, h = 8 * g + wave; int row0, ntok; chunk_info(ci, row0, ntok);
        f32x4 acc[8][4];
#pragma unroll
        for (int nb = 0; nb < 8; ++nb)
#pragma unroll
            for (int pb = 0; pb < 4; ++pb) acc[nb][pb] = (f32x4){0.f, 0.f, 0.f, 0.f};
        const int nsub = (ntok + 63) >> 6;
        for (int jb = 0; jb < nsub; ++jb) {
            const int rj = row0 + 64 * jb;
            __syncthreads();
            { const int hh = tid >> 6, t = tid & 63; const size_t r = (size_t)(rj + t) * 32 + 8 * g + hh; float v = 0.f;
              if (64 * jb + t < ntok) v = __expf(tot[ci * 32 + 8 * g + hh] - acs[r]) * dt[r];
              scs[hh * 64 + t] = v; }
#pragma unroll
            for (int i = 0; i < 2; ++i) { const bf16_t* gb = xc + (size_t)(rj + 32 * i) * 3072 + 2048 + 128 * g;
                *(LAS u32x4*)(Bs + ((tid >> 4) + 32 * i) * 144 + (tid & 15) * 8) = *(const u32x4*)(gb + voffB); }
            __syncthreads();
#pragma unroll
            for (int i = 0; i < 8; ++i) { const int t = (tid >> 6) + 8 * i, c = tid & 63; const bf16_t* gb = xc + (size_t)(rj + 8 * i) * 3072 + 512 * g;
                const u32x4 v = *(const u32x4*)(gb + voffX); const float s = scs[(c >> 3) * 64 + t];
                u32x4 o; o.x = cvtpk(bflo(v.x) * s, bfhi(v.x) * s); o.y = cvtpk(bflo(v.y) * s, bfhi(v.y) * s); o.z = cvtpk(bflo(v.z) * s, bfhi(v.z) * s); o.w = cvtpk(bflo(v.w) * s, bfhi(v.w) * s);
                *(LAS u32x4*)(Xs + t * 528 + c * 8) = o; }
            __syncthreads();
#pragma unroll
            for (int s2 = 0; s2 < 2; ++s2) {
                const int tok0 = 32 * s2 + 4 * quad + (li >> 2), cq4 = 4 * (li & 3);
                bf16x8 Bf[4];
#pragma unroll
                for (int pb = 0; pb < 4; ++pb) Bf[pb] = cat8(ldtr(Xs + tok0 * 528 + 64 * wave + 16 * pb + cq4), ldtr(Xs + (tok0 + 16) * 528 + 64 * wave + 16 * pb + cq4));
#pragma unroll
                for (int nb = 0; nb < 8; ++nb) { const bf16x8 Af = cat8(ldtr(Bs + tok0 * 144 + 16 * nb + cq4), ldtr(Bs + (tok0 + 16) * 144 + 16 * nb + cq4));
#pragma unroll
                    for (int pb = 0; pb < 4; ++pb) acc[nb][pb] = MFMA16(Af, Bf[pb], acc[nb][pb]); }
            }
        }
        bf16_t* Sp = S + ((size_t)(ci * 32 + h) * 64) * 128;
#pragma unroll
        for (int nb = 0; nb < 8; ++nb)
#pragma unroll
            for (int pb = 0; pb < 4; ++pb) { u32x2 o = {cvtpk(acc[nb][pb][0], acc[nb][pb][1]), cvtpk(acc[nb][pb][2], acc[nb][pb][3])};
                *(u32x2*)(Sp + (size_t)(16 * pb + li) * 128 + 16 * nb + 4 * quad) = o; }
    }
}

__device__ __forceinline__ void p7_phase(const Args& a, const int wave) {
    int tid = wave * 64 + lane_id(); asm volatile("" : "+v"(tid)); tid &= 511;
    unsigned char* ws = a.ws; bf16_t* S = (bf16_t*)(ws + WS_S); const float* tot = (const float*)(ws + WS_TOT);
    const int gt = blockIdx.x * 512 + tid, NT = gridDim.x * 512;
    for (int e = gt; e < 131072; e += NT) {
        const int b = e >> 16, rem = e & 65535, h = rem >> 11; f32x4 st = {0.f, 0.f, 0.f, 0.f};
        for (int k0 = 0; k0 < 65; k0 += 5) { u32x2 v[5]; float dec[5];
#pragma unroll
            for (int k = 0; k < 5; ++k) { const int ci = b * 65 + k0 + k; v[k] = *(const u32x2*)(S + (size_t)ci * 262144 + rem * 4); dec[k] = __expf(tot[ci * 32 + h]); }
#pragma unroll
            for (int k = 0; k < 5; ++k) { const int ci = b * 65 + k0 + k; u32x2 o = {cvtpk(st[0], st[1]), cvtpk(st[2], st[3])}; *(u32x2*)(S + (size_t)ci * 262144 + rem * 4) = o;
                st[0] = st[0] * dec[k] + bflo(v[k].x); st[1] = st[1] * dec[k] + bfhi(v[k].x); st[2] = st[2] * dec[k] + bflo(v[k].y); st[3] = st[3] * dec[k] + bfhi(v[k].y); } }
        *(f32x4*)(a.out + OUT_SSMP + (size_t)b * 262144 + rem * 4) = st;
    }
    for (int e = gt; e < 16 * 65536; e += NT) {
        const int db = e >> 16, rem = e & 65535, h = rem >> 11, ci = 130 + db;
        const f32x4 s0 = *(const f32x4*)(a.in[I_SSSM] + (size_t)db * 262144 + rem * 4); const u32x2 v = *(const u32x2*)(S + (size_t)ci * 262144 + rem * 4); const float dec = __expf(tot[ci * 32 + h]);
        u32x2 o = {cvtpk(s0[0], s0[1]), cvtpk(s0[2], s0[3])}; *(u32x2*)(S + (size_t)ci * 262144 + rem * 4) = o;
        const f32x4 r = {s0[0] * dec + bflo(v.x), s0[1] * dec + bfhi(v.x), s0[2] * dec + bflo(v.y), s0[3] * dec + bfhi(v.y)};
        *(f32x4*)(a.out + OUT_SSMS + (size_t)db * 262144 + rem * 4) = r;
    }
}

__device__ __forceinline__ void p8_phase(const Args& a, LAS unsigned char* L, const int wave) {
    const int lane = lane_id(); int tid = wave * 64 + lane; asm volatile("" : "+v"(tid)); tid &= 511;
    unsigned char* ws = a.ws; const bf16_t* xc = (const bf16_t*)(ws + WS_X); const float* dt = (const float*)(ws + WS_DT); const float* acs = (const float*)(ws + WS_ACS);
    const bf16_t* S = (const bf16_t*)(ws + WS_S); bf16_t* zb = (bf16_t*)(ws + WS_Z);
    LAS bf16_t* Cs = (LAS bf16_t*)L; LAS bf16_t* Bs = (LAS bf16_t*)(L + 18432); LAS bf16_t* Xs = (LAS bf16_t*)(L + 36864);
    LAS float* aj = (LAS float*)(L + 104448); LAS float* dj = (LAS float*)(L + 106496); LAS float* red = (LAS float*)(L + 108544);
    const int li = lane & 15, quad = lane >> 4;
    const unsigned voffB = (unsigned)((tid >> 4) * 3072 + (tid & 15) * 8), voffX = (unsigned)((tid >> 6) * 3072 + (tid & 63) * 8);
    for (int u = blockIdx.x; u < 2120; u += gridDim.x) {
        int ci, i, g;
        if (u < 2048) { i = 3 - (u >> 9); const int rest = u & 511; ci = (rest >> 8) * 65 + 1 + ((rest & 255) >> 2); g = rest & 3; }
        else { int v = u - 2048; i = 0; g = v & 3; if (v < 8) ci = (v >> 2) * 65; else ci = 130 + ((v - 8) >> 2); }
        int row0, ntok; chunk_info(ci, row0, ntok);
        const int rb = row0 + 64 * i, nti = (ntok - 64 * i) < 64 ? (ntok - 64 * i) : 64, h = 8 * g + wave;
        __syncthreads();
#pragma unroll
        for (int i2 = 0; i2 < 2; ++i2) { const bf16_t* gb = xc + (size_t)(rb + 32 * i2) * 3072 + 2560 + 128 * g;
            *(LAS u32x4*)(Cs + ((tid >> 4) + 32 * i2) * 144 + (tid & 15) * 8) = *(const u32x4*)(gb + voffB); }
        __syncthreads();
        const bf16_t* Sp = S + ((size_t)(ci * 32 + h) * 64) * 128;
        const float Dh = a.in[I_SSMD][h];
        { constexpr int ih = 0;
        f32x4 acc[4][4];
#pragma unroll
        for (int pb = 0; pb < 4; ++pb)
#pragma unroll
            for (int ib = 0; ib < 4; ++ib) acc[pb][ib] = (f32x4){0.f, 0.f, 0.f, 0.f};
        float ai[4];
#pragma unroll
        for (int ib = 0; ib < 4; ++ib) ai[ib] = acs[(size_t)(rb + 32 * ih + 16 * ib + li) * 32 + h];
        { bf16x8 Af[4][4];
#pragma unroll
          for (int ks = 0; ks < 4; ++ks)
#pragma unroll
            for (int pb = 0; pb < 4; ++pb) Af[ks][pb] = *(const bf16x8*)(Sp + (size_t)(16 * pb + li) * 128 + 32 * ks + 8 * quad);
#pragma unroll
          for (int ks = 0; ks < 4; ++ks) { bf16x8 Bf[4];
#pragma unroll
            for (int ib = 0; ib < 4; ++ib) Bf[ib] = *(const LAS bf16x8*)(Cs + (32 * ih + 16 * ib + li) * 144 + 32 * ks + 8 * quad);
#pragma unroll
            for (int pb = 0; pb < 4; ++pb)
#pragma unroll
                for (int ib = 0; ib < 4; ++ib) acc[pb][ib] = MFMA16(Af[ks][pb], Bf[ib], acc[pb][ib]);
            __builtin_amdgcn_sched_barrier(0); } }
#pragma unroll
        for (int ib = 0; ib < 4; ++ib) { const float e = __expf(ai[ib]);
#pragma unroll
            for (int pb = 0; pb < 4; ++pb) acc[pb][ib] = acc[pb][ib] * e; }
        for (int j = 0; j <= i; ++j) {
            const int rj = row0 + 64 * j;
            __syncthreads();
#pragma unroll
            for (int i2 = 0; i2 < 2; ++i2) { const bf16_t* gb = xc + (size_t)(rj + 32 * i2) * 3072 + 2048 + 128 * g;
                *(LAS u32x4*)(Bs + ((tid >> 4) + 32 * i2) * 144 + (tid & 15) * 8) = *(const u32x4*)(gb + voffB); }
#pragma unroll
            for (int i2 = 0; i2 < 8; ++i2) { const bf16_t* gb = xc + (size_t)(rj + 8 * i2) * 3072 + 512 * g;
                *(LAS u32x4*)(Xs + ((tid >> 6) + 8 * i2) * 528 + (tid & 63) * 8) = *(const u32x4*)(gb + voffX); }
            { const int hh = tid >> 6, t = tid & 63; const size_t r = (size_t)(rj + t) * 32 + 8 * g + hh; aj[hh * 64 + t] = acs[r]; dj[hh * 64 + t] = dt[r]; }
            __syncthreads();
            bf16x8 XA[4][2]; f32x4 a4v[4], d4v[4];
#pragma unroll
            for (int s2 = 0; s2 < 2; ++s2) { const LAS bf16_t* xp = Xs + (32 * s2 + 4 * quad + (li >> 2)) * 528 + 64 * wave + 4 * (li & 3);
#pragma unroll
                for (int pb = 0; pb < 4; ++pb) XA[pb][s2] = cat8(ldtr(xp + 16 * pb), ldtr(xp + 16 * 528 + 16 * pb)); }
#pragma unroll
            for (int jb = 0; jb < 4; ++jb) { a4v[jb] = *(const LAS f32x4*)(aj + wave * 64 + 16 * jb + 4 * quad); d4v[jb] = *(const LAS f32x4*)(dj + wave * 64 + 16 * jb + 4 * quad); }
            __builtin_amdgcn_sched_barrier(0);
#pragma unroll
            for (int ib = 0; ib < 4; ++ib) {
                f32x4 cb[4];
#pragma unroll
                for (int jb = 0; jb < 4; ++jb) cb[jb] = (f32x4){0.f, 0.f, 0.f, 0.f};
#pragma unroll
                for (int ks = 0; ks < 4; ++ks) { const bf16x8 Bc = *(const LAS bf16x8*)(Cs + (32 * ih + 16 * ib + li) * 144 + 32 * ks + 8 * quad);
#pragma unroll
                    for (int jb = 0; jb < 4; ++jb) { const bf16x8 Ab = *(const LAS bf16x8*)(Bs + (16 * jb + li) * 144 + 32 * ks + 8 * quad); cb[jb] = MFMA16(Ab, Bc, cb[jb]); } }
                const int ti = 32 * ih + 16 * ib + li;
#pragma unroll
                for (int jb = 0; jb < 4; ++jb) { const f32x4 a4 = a4v[jb], d4 = d4v[jb];
#pragma unroll
                    for (int jj = 0; jj < 4; ++jj) { const int tj = 16 * jb + 4 * quad + jj; float val = cb[jb][jj] * __expf(fminf(ai[ib] - a4[jj], 0.f)) * d4[jj];
                        if (j == i && tj > ti) val = 0.f; cb[jb][jj] = val; } }
#pragma unroll
                for (int s2 = 0; s2 < 2; ++s2) { u32x4 pk = {cvtpk(cb[2 * s2][0], cb[2 * s2][1]), cvtpk(cb[2 * s2][2], cb[2 * s2][3]), cvtpk(cb[2 * s2 + 1][0], cb[2 * s2 + 1][1]), cvtpk(cb[2 * s2 + 1][2], cb[2 * s2 + 1][3])};
                    const bf16x8 P = __builtin_bit_cast(bf16x8, pk);
#pragma unroll
                    for (int pb = 0; pb < 4; ++pb) acc[pb][ib] = MFMA16(XA[pb][s2], P, acc[pb][ib]); }
                __builtin_amdgcn_sched_barrier(0);
            }
        }
        float ss[4];
#pragma unroll
        for (int ib = 0; ib < 4; ++ib) { ss[ib] = 0.f; const int ti = 32 * ih + 16 * ib + li;
#pragma unroll
            for (int pb = 0; pb < 4; ++pb) { const int p0 = 16 * pb + 4 * quad; const u32x2 xr = *(const LAS u32x2*)(Xs + ti * 528 + 64 * wave + p0);
                const u32x2 zr = *(const u32x2*)(zb + (size_t)(rb + ti) * 2048 + 64 * h + p0);
                const float x4[4] = {bflo(xr.x), bfhi(xr.x), bflo(xr.y), bfhi(xr.y)}, z4[4] = {bflo(zr.x), bfhi(zr.x), bflo(zr.y), bfhi(zr.y)};
#pragma unroll
                for (int jj = 0; jj < 4; ++jj) { const float y = (acc[pb][ib][jj] + Dh * x4[jj]) * silu_f(z4[jj]); acc[pb][ib][jj] = y; ss[ib] += y * y; } }
            ss[ib] += __shfl_xor(ss[ib], 16); ss[ib] += __shfl_xor(ss[ib], 32);
            if (quad == 0) red[wave * 64 + ti] = ss[ib]; }
        __syncthreads();
#pragma unroll
        for (int ib = 0; ib < 4; ++ib) { const int ti = 32 * ih + 16 * ib + li; float t8 = 0.f;
#pragma unroll
            for (int w = 0; w < 8; ++w) t8 += red[w * 64 + ti];
            const float rs = rsqrtf(t8 * (1.f / 512.f) + EPS);
            if (ti < nti) {
#pragma unroll
                for (int pb = 0; pb < 4; ++pb) { const int p0 = 16 * pb + 4 * quad; const f32x4 gn = *(const f32x4*)(a.in[I_SSMN] + 64 * h + p0);
                    u32x2 o = {cvtpk(acc[pb][ib][0] * rs * gn[0], acc[pb][ib][1] * rs * gn[1]), cvtpk(acc[pb][ib][2] * rs * gn[2], acc[pb][ib][3] * rs * gn[3])};
                    *(u32x2*)(zb + (size_t)(rb + ti) * 2048 + 64 * h + p0) = o; } } }
        }
    }
}

__device__ __forceinline__ void attn_tile(bool prompt, int b_or_db, int tt, int& row0, int& nv) {
    if (tt == 0) { row0 = R_M0; nv = 16; return; }
    if (prompt) { row0 = b_or_db * 16384 + 64 * (tt - 1); nv = 64; }
    else if (tt <= 16) { row0 = R_C0 + 1024 * b_or_db + 64 * (tt - 1); nv = 64; }
    else { row0 = R_S0 + 32 * b_or_db; nv = 32; }
}
__device__ __forceinline__ void p11_phase(const Args& a, LAS unsigned char* L, const int wave) {
    const int lane = lane_id(); int tid = wave * 64 + lane; asm volatile("" : "+v"(tid)); tid &= 511;
    unsigned char* ws = a.ws; const bf16_t* Q = (const bf16_t*)(ws + WS_Q); const bf16_t* Kn = (const bf16_t*)(ws + WS_KN); const bf16_t* Vt = (const bf16_t*)(ws + WS_VT);
    const bf16_t* krb = (const bf16_t*)(ws + WS_KRB); bf16_t* O = (bf16_t*)(ws + WS_O); const float* rope = (const float*)(ws + WS_ROPE);
    constexpr int KSZ = 64 * 104, VSZ = 80 * 72, BUF = KSZ + VSZ;
    LAS bf16_t* LB = (LAS bf16_t*)L;
    const int li = lane & 15, quad = lane >> 4;
    const unsigned vo_kn = (unsigned)((tid >> 3) * 1024 + (tid & 7) * 8), vo_kr = (unsigned)(((tid & 255) >> 2) * 32 + (tid & 3) * 8), vo_vt = (unsigned)((tid >> 3) * RK + (tid & 7) * 8);
    const int so_kn = (tid >> 3) * 104 + (tid & 7) * 8, so_kr = ((tid & 255) >> 2) * 104 + 64 + (tid & 3) * 8, so_vt = KSZ + (tid >> 3) * 72 + (tid & 7) * 8;
    for (int e = tid; e < 2 * 16 * 72; e += 512) { const int bsel = e / 1152, r = (e % 1152) / 72, c = e % 72; LB[bsel * BUF + KSZ + (64 + r) * 72 + c] = (bf16_t)(r == 0 ? 0x3F80 : 0); }
    for (int u = blockIdx.x; u < 2304; u += gridDim.x) {
        bool prompt, active; int bq, hd, qr0, ntiles, limit;
        if (u < 2048) { const int k = u >> 8, c32 = (u & 255) >> 5, qblk = 63 - 8 * k - ((k & 1) ? 7 - c32 : c32); prompt = true; bq = (u & 31) >> 4; hd = u & 15;
            qr0 = bq * 16384 + 256 * qblk; ntiles = 4 * qblk + 5; limit = 4 * qblk + (wave >> 1) + 1; active = true; }
        else { const int v = u - 2048; prompt = false; bq = v >> 4; hd = v & 15; qr0 = R_S0 + 32 * bq; ntiles = 18; limit = 17; active = (wave == 0); }
        const int qrow = qr0 + 32 * wave;
        bf16x8 qf[2][3];
#pragma unroll
        for (int qb = 0; qb < 2; ++qb) {
            const int r = active ? qrow + 16 * qb + li : 0; const bf16_t* qp = Q + (size_t)r * 1536;
            qf[qb][0] = *(const bf16x8*)(qp + hd * 64 + 8 * quad); qf[qb][1] = *(const bf16x8*)(qp + hd * 64 + 32 + 8 * quad);
            const u32x4 x1 = *(const u32x4*)(qp + 1024 + hd * 32 + 8 * (quad & 1)), x2 = *(const u32x4*)(qp + 1024 + hd * 32 + 16 + 8 * (quad & 1));
            const float* rp = rope + ((size_t)pos_idx(r) * 16 + 8 * (quad & 1)) * 2; float ov[8];
#pragma unroll
            for (int e = 0; e < 4; ++e) { const f32x4 cs = *(const f32x4*)(rp + 4 * e);
                const float a0 = bflo(x1[e]), a1 = bfhi(x1[e]), b0 = bflo(x2[e]), b1 = bfhi(x2[e]);
                ov[2 * e] = quad < 2 ? a0 * cs[0] - b0 * cs[1] : a0 * cs[1] + b0 * cs[0]; ov[2 * e + 1] = quad < 2 ? a1 * cs[2] - b1 * cs[3] : a1 * cs[3] + b1 * cs[2]; }
            u32x4 pkq = {cvtpk(ov[0], ov[1]), cvtpk(ov[2], ov[3]), cvtpk(ov[4], ov[5]), cvtpk(ov[6], ov[7])}; qf[qb][2] = __builtin_bit_cast(bf16x8, pkq);
        }
        float mrun[2] = {-INFINITY, -INFINITY}; f32x4 o[4][2], ol[2] = {{0.f, 0.f, 0.f, 0.f}, {0.f, 0.f, 0.f, 0.f}};
#pragma unroll
        for (int db = 0; db < 4; ++db) { o[db][0] = (f32x4){0.f, 0.f, 0.f, 0.f}; o[db][1] = o[db][0]; }
        int row0, nv, nvn; attn_tile(prompt, bq, 0, row0, nv);
        u32x4 pkn = *(const u32x4*)(Kn + (size_t)row0 * 1024 + hd * 64 + vo_kn);
        u32x4 pkr = *(const u32x4*)(krb + (size_t)row0 * 32 + vo_kr);
        u32x4 pvt = *(const u32x4*)(Vt + (size_t)hd * 64 * RK + row0 + vo_vt);
        __syncthreads();
        *(LAS u32x4*)(LB + so_kn) = pkn; if (tid < 256) *(LAS u32x4*)(LB + so_kr) = pkr; *(LAS u32x4*)(LB + so_vt) = pvt;
        attn_tile(prompt, bq, 1, row0, nvn);
        pkn = *(const u32x4*)(Kn + (size_t)row0 * 1024 + hd * 64 + vo_kn); pkr = *(const u32x4*)(krb + (size_t)row0 * 32 + vo_kr); pvt = *(const u32x4*)(Vt + (size_t)hd * 64 * RK + row0 + vo_vt);
        for (int tt = 0; tt < ntiles; ++tt) {
            const int nvc = nv; nv = nvn;
            __syncthreads();
            if (tt + 1 < ntiles) { LAS bf16_t* nb = LB + ((tt + 1) & 1) * BUF;
                *(LAS u32x4*)(nb + so_kn) = pkn; if (tid < 256) *(LAS u32x4*)(nb + so_kr) = pkr; *(LAS u32x4*)(nb + so_vt) = pvt;
                if (tt + 2 < ntiles) { attn_tile(prompt, bq, tt + 2, row0, nvn);
                    pkn = *(const u32x4*)(Kn + (size_t)row0 * 1024 + hd * 64 + vo_kn); pkr = *(const u32x4*)(krb + (size_t)row0 * 32 + vo_kr); pvt = *(const u32x4*)(Vt + (size_t)hd * 64 * RK + row0 + vo_vt); } }
            if (active && tt <= limit) {
                const LAS bf16_t* Ks = LB + (tt & 1) * BUF; const LAS bf16_t* Vs = Ks + KSZ;
                f32x4 s[4][2];
                const float m0 = mrun[0] == -INFINITY ? 0.f : mrun[0], m1 = mrun[1] == -INFINITY ? 0.f : mrun[1];
#pragma unroll
                for (int kb = 0; kb < 4; ++kb) { s[kb][0] = (f32x4){-m0, -m0, -m0, -m0}; s[kb][1] = (f32x4){-m1, -m1, -m1, -m1}; }
#pragma unroll
                for (int ks = 0; ks < 3; ++ks)
#pragma unroll
                    for (int kb = 0; kb < 4; ++kb) { const bf16x8 kf = *(const LAS bf16x8*)(Ks + (16 * kb + li) * 104 + 32 * ks + 8 * quad);
                        s[kb][0] = MFMA16(kf, qf[0][ks], s[kb][0]); s[kb][1] = MFMA16(kf, qf[1][ks], s[kb][1]); }
                if (nvc < 64) {
#pragma unroll
                    for (int kb = 0; kb < 4; ++kb)
#pragma unroll
                        for (int jj = 0; jj < 4; ++jj) if (16 * kb + 4 * quad + jj >= nvc) { s[kb][0][jj] = -INFINITY; s[kb][1][jj] = -INFINITY; } }
                bf16x8 P[2][2];
#pragma unroll
                for (int qb = 0; qb < 2; ++qb) {
                    float mx = fmaxf(fmaxf(s[0][qb][0], s[0][qb][1]), s[0][qb][2]);
                    mx = fmaxf(fmaxf(mx, s[0][qb][3]), s[1][qb][0]); mx = fmaxf(fmaxf(mx, s[1][qb][1]), s[1][qb][2]); mx = fmaxf(fmaxf(mx, s[1][qb][3]), s[2][qb][0]);
                    mx = fmaxf(fmaxf(mx, s[2][qb][1]), s[2][qb][2]); mx = fmaxf(fmaxf(mx, s[2][qb][3]), s[3][qb][0]); mx = fmaxf(fmaxf(mx, s[3][qb][1]), s[3][qb][2]); mx = fmaxf(mx, s[3][qb][3]);
                    const bool first = (mrun[qb] == -INFINITY);
                    if (__builtin_amdgcn_ballot_w64(first || mx > 16.f) != 0ull) {
                        mx = fmaxf(mx, __shfl_xor(mx, 16)); mx = fmaxf(mx, __shfl_xor(mx, 32));
                        const float mold = qb == 0 ? m0 : m1, d = first ? mx : fmaxf(mx, 0.f);
                        const float alpha = first ? 0.f : __builtin_amdgcn_exp2f(-d); mrun[qb] = mold + d; ol[qb] = ol[qb] * alpha;
#pragma unroll
                        for (int kb = 0; kb < 4; ++kb) s[kb][qb] = s[kb][qb] - d;
#pragma unroll
                        for (int db = 0; db < 4; ++db) o[db][qb] = o[db][qb] * alpha; }
#pragma unroll
                    for (int kb = 0; kb < 4; ++kb) { f32x4 t = s[kb][qb];
                        t[0] = __builtin_amdgcn_exp2f(t[0]); t[1] = __builtin_amdgcn_exp2f(t[1]); t[2] = __builtin_amdgcn_exp2f(t[2]); t[3] = __builtin_amdgcn_exp2f(t[3]); s[kb][qb] = t; }
#pragma unroll
                    for (int s2 = 0; s2 < 2; ++s2) { u32x4 pk = {cvtpk(s[2 * s2][qb][0], s[2 * s2][qb][1]), cvtpk(s[2 * s2][qb][2], s[2 * s2][qb][3]), cvtpk(s[2 * s2 + 1][qb][0], s[2 * s2 + 1][qb][1]), cvtpk(s[2 * s2 + 1][qb][2], s[2 * s2 + 1][qb][3])};
                        P[qb][s2] = __builtin_bit_cast(bf16x8, pk); }
                }
#pragma unroll
                for (int s2 = 0; s2 < 2; ++s2)
#pragma unroll
                    for (int db = 0; db < 4; ++db) { const LAS bf16_t* vp = Vs + (16 * db + li) * 72 + 32 * s2 + 4 * quad;
                        const bf16x8 vf = cat8u(*(const LAS u32x2*)vp, *(const LAS u32x2*)(vp + 16));
                        o[db][0] = MFMA16(vf, P[0][s2], o[db][0]); o[db][1] = MFMA16(vf, P[1][s2], o[db][1]); }
#pragma unroll
                for (int s2 = 0; s2 < 2; ++s2) { const LAS bf16_t* vp = Vs + (64 + li) * 72 + 32 * s2 + 4 * quad;
                    const bf16x8 vf = cat8u(*(const LAS u32x2*)vp, *(const LAS u32x2*)(vp + 16));
                    ol[0] = MFMA16(vf, P[0][s2], ol[0]); ol[1] = MFMA16(vf, P[1][s2], ol[1]); }
            }
        }
        if (active) {
#pragma unroll
            for (int qb = 0; qb < 2; ++qb) { const float l = __shfl(ol[qb][0], li); const float inv = 1.f / l;
#pragma unroll
                for (int db = 0; db < 4; ++db) { u32x2 w = {cvtpk(o[db][qb][0] * inv, o[db][qb][1] * inv), cvtpk(o[db][qb][2] * inv, o[db][qb][3] * inv)};
                    *(u32x2*)(O + (size_t)(qrow + 16 * qb + li) * 1024 + hd * 64 + 16 * db + 4 * quad) = w; } }
        }
    }
}

#ifndef ONLY_PHASE
#define ONLY_PHASE -1
#endif
#define PH(k) (ONLY_PHASE < 0 || ONLY_PHASE == (k))
constexpr int NPHASE = 20;
constexpr int LDS_BYTES = 131072;
__device__ __forceinline__ void grid_barrier(unsigned* bar, unsigned k, int wave) {
    __syncthreads();
    if (wave == 0) {
        __builtin_amdgcn_fence(__ATOMIC_RELEASE, "agent");
        if (lane_id() == 0) {
            const unsigned g = blockIdx.x & 7u, ngrp = gridDim.x < 8u ? gridDim.x : 8u, ng = (gridDim.x - g + 7u) >> 3;
            unsigned* cnt = bar + 64 * g; unsigned* top = bar + 64 * 8; unsigned* rel = bar + 64 * 9;
            const unsigned old = __hip_atomic_fetch_add(cnt, 1u, __ATOMIC_RELAXED, __HIP_MEMORY_SCOPE_AGENT);
            if (old + 1u == ng * k) {
                const unsigned old2 = __hip_atomic_fetch_add(top, 1u, __ATOMIC_RELAXED, __HIP_MEMORY_SCOPE_AGENT);
                if (old2 + 1u == ngrp * k) __hip_atomic_store(bar + 64 * 9, k, __ATOMIC_RELAXED, __HIP_MEMORY_SCOPE_AGENT);
            }
            while (__hip_atomic_load(rel, __ATOMIC_RELAXED, __HIP_MEMORY_SCOPE_AGENT) < k) __builtin_amdgcn_s_sleep(1);
        }
        __builtin_amdgcn_fence(__ATOMIC_ACQUIRE, "agent");
    }
    __syncthreads();
}
__global__ void __launch_bounds__(512, 2) fwd_megakernel(Args a) {
    extern __shared__ __attribute__((aligned(16))) unsigned char lds_raw[];
    LAS unsigned char* L = (LAS unsigned char*)lds_raw;
    unsigned char* ws = a.ws;
    bf16_t* W_IN = (bf16_t*)(ws + WS_W_IN); bf16_t* W_GU = (bf16_t*)(ws + WS_W_GU); bf16_t* W_D = (bf16_t*)(ws + WS_W_D); bf16_t* W_SO = (bf16_t*)(ws + WS_W_SO);
    bf16_t* W_UQ = (bf16_t*)(ws + WS_W_UQ); bf16_t* W_K = (bf16_t*)(ws + WS_W_K); bf16_t* W_V = (bf16_t*)(ws + WS_W_V); bf16_t* W_MO = (bf16_t*)(ws + WS_W_MO); bf16_t* W_MIX = (bf16_t*)(ws + WS_W_MIX);
    float* hmeta = (float*)(ws + WS_HMETA);
    const RowMap rm{a.out, hmeta, a.in[I_XP], a.in[I_XS], a.in[I_META]};
    const int wave = __builtin_amdgcn_readfirstlane((int)threadIdx.x >> 6);
    unsigned* bar = (unsigned*)(ws + WS_BAR);
    if (a.ph_hi > 1000) { cg::grid_group grid = cg::this_grid(); grid.sync(); }
    const int lo = a.ph_lo, hi = a.ph_hi;
    __builtin_amdgcn_fence(__ATOMIC_ACQUIRE, "agent");
#define TIDS const int lane = lane_id(); int tid = wave * 64 + lane; asm volatile("" : "+v"(tid)); tid &= 511; const int gw = blockIdx.x * 8 + wave, NGW = gridDim.x * 8; (void)tid; (void)lane; (void)gw; (void)NGW;
#define IN(k) (PH(k) && lo <= (k) && (k) < hi)
    unsigned nbar = 0;
#ifdef TIME_PHASE
    unsigned long long t_a = 0, t_b = 0;
#endif
#define SEAM(k) do { if ((k) + 1 < hi) { ++nbar; grid_barrier(bar, nbar, wave); } } while (0)
    {
        {
#ifdef TIME_PHASE
        if (TIME_PHASE == 0) t_a = __builtin_amdgcn_s_memrealtime();
#endif
        if (IN(0)) { { TIDS
            LAS float* scr = (LAS float*)L;
            xpose_matrix(a.in[I_F1GU], 1024, 2 * FFN, W_GU, 2 * FFN, 1, scr, tid);
            xpose_matrix(a.in[I_F1D], FFN, 1024, W_D, 1024, 0, scr, tid);
            xpose_matrix(a.in[I_WIN], 1024, 7872, W_IN, 7936, 2, scr, tid);
            xpose_matrix(a.in[I_WSO], 2048, 1024, W_SO, 1024, 0, scr, tid);
            xpose_matrix(a.in[I_WUQ], 384, 1536, W_UQ, 1536, 3, scr, tid);
            xpose_matrix(a.in[I_WUKV], 256, 2048, W_K, 1024, 4, scr, tid);
            xpose_matrix(a.in[I_WUKV], 256, 2048, W_V, 1024, 5, scr, tid);
            xpose_matrix(a.in[I_WMO], 1024, 1024, W_MO, 1024, 0, scr, tid);
            xpose_matrix(a.in[I_WMIX], 1024, 1024, W_MIX, 1024, 0, scr, tid);
            __syncthreads();
            bf16_t* xn = (bf16_t*)(ws + WS_U);
            for (int row = gw; row < R1; row += 2 * NGW) { const int r1 = row + NGW; if (r1 < R1) norm_row2_bf16(xrow(rm, row), xrow(rm, r1), a.in[I_F1N], xn + (size_t)row * D, xn + (size_t)r1 * D, lane); else norm_row_bf16(xrow(rm, row), a.in[I_F1N], xn + (size_t)row * D, lane); }
            float* rope = (float*)(ws + WS_ROPE);
            for (int e = blockIdx.x * 512 + tid; e < 16400 * 16; e += gridDim.x * 512) { const int i = e & 15, pos = (e >> 4) - 16;
                const float inv = __builtin_amdgcn_exp2f(-(float)i * 0.83048202372184058f); const float ang = (float)pos * inv;
                double rev = (double)ang * 0.15915494309189535; rev -= __builtin_rint(rev); const float r = (float)rev;
                rope[2 * e] = __builtin_amdgcn_cosf(r); rope[2 * e + 1] = __builtin_amdgcn_sinf(r); }
        } SEAM(0); }
#ifdef TIME_PHASE
        if (TIME_PHASE == 0) t_b = __builtin_amdgcn_s_memrealtime();
#endif
#ifdef TIME_PHASE
        if (TIME_PHASE == 1) t_a = __builtin_amdgcn_s_memrealtime();
#endif
        if (IN(1)) { { EpiSwiglu E{(bf16_t*)(ws + WS_ACT)}; run_gemm(L, (const bf16_t*)(ws + WS_U), W_GU, R1, 2 * FFN, 1024, E, wave); } SEAM(1); }
#ifdef TIME_PHASE
        if (TIME_PHASE == 1) t_b = __builtin_amdgcn_s_memrealtime();
#endif
#ifdef TIME_PHASE
        if (TIME_PHASE == 2) t_a = __builtin_amdgcn_s_memrealtime();
#endif
        if (IN(2)) { { ElResid T{rm, 0.5f, 0}; tail_gemm((const bf16_t*)(ws + WS_ACT), W_D, FFN, 32768, R1, T, wave); EpiResid E{rm, 0.5f, 0}; run_gemm(L, (const bf16_t*)(ws + WS_ACT), W_D, 32768, 1024, FFN, E, wave); } SEAM(2); }
#ifdef TIME_PHASE
        if (TIME_PHASE == 2) t_b = __builtin_amdgcn_s_memrealtime();
#endif
#ifdef TIME_PHASE
        if (TIME_PHASE == 3) t_a = __builtin_amdgcn_s_memrealtime();
#endif
        if (IN(3)) { { TIDS
            bf16_t* un = (bf16_t*)(ws + WS_U);
            for (int row = gw; row < R1; row += 2 * NGW) { const int r1 = row + NGW; if (r1 < R1) norm_row2_bf16(hrow(rm, row), hrow(rm, r1), a.in[I_MIXN], un + (size_t)row * D, un + (size_t)r1 * D, lane); else norm_row_bf16(hrow(rm, row), a.in[I_MIXN], un + (size_t)row * D, lane); }
            LAS float* scr = (LAS float*)L;
            xpose_matrix(a.in[I_F2GU], 1024, 2 * FFN, W_GU, 2 * FFN, 1, scr, tid);
            xpose_matrix(a.in[I_F2D], FFN, 1024, W_D, 1024, 0, scr, tid);
            __syncthreads();
        } SEAM(3); }
#ifdef TIME_PHASE
        if (TIME_PHASE == 3) t_b = __builtin_amdgcn_s_memrealtime();
#endif
#ifdef TIME_PHASE
        if (TIME_PHASE == 4) t_a = __builtin_amdgcn_s_memrealtime();
#endif
        if (IN(4)) { { EpiProj E{(bf16_t*)(ws + WS_Z), (bf16_t*)(ws + WS_X), (bf16_t*)(ws + WS_MISC), (bf16_t*)(ws + WS_HALO), a.out};
                  run_gemm(L, (const bf16_t*)(ws + WS_U), W_IN, R1, 5888, 1024, E, wave); } SEAM(4); }
#ifdef TIME_PHASE
        if (TIME_PHASE == 4) t_b = __builtin_amdgcn_s_memrealtime();
#endif
#ifdef TIME_PHASE
        if (TIME_PHASE == 5) t_a = __builtin_amdgcn_s_memrealtime();
#endif
        if (IN(5)) { p5_phase(a, wave); SEAM(5); }
#ifdef TIME_PHASE
        if (TIME_PHASE == 5) t_b = __builtin_amdgcn_s_memrealtime();
#endif
#ifdef TIME_PHASE
        if (TIME_PHASE == 6) t_a = __builtin_amdgcn_s_memrealtime();
#endif
        if (IN(6)) { p6_phase(a, L, wave); SEAM(6); }
#ifdef TIME_PHASE
        if (TIME_PHASE == 6) t_b = __builtin_amdgcn_s_memrealtime();
#endif
#ifdef TIME_PHASE
        if (TIME_PHASE == 7) t_a = __builtin_amdgcn_s_memrealtime();
#endif
        if (IN(7)) { p7_phase(a, wave); SEAM(7); }
#ifdef TIME_PHASE
        if (TIME_PHASE == 7) t_b = __builtin_amdgcn_s_memrealtime();
#endif
#ifdef TIME_PHASE
        if (TIME_PHASE == 8) t_a = __builtin_amdgcn_s_memrealtime();
#endif
        if (IN(8)) { p8_phase(a, L, wave); SEAM(8); }
#ifdef TIME_PHASE
        if (TIME_PHASE == 8) t_b = __builtin_amdgcn_s_memrealtime();
#endif
#ifdef TIME_PHASE
        if (TIME_PHASE == 9) t_a = __builtin_amdgcn_s_memrealtime();
#endif
        if (IN(9)) { { ElBf16 T{(bf16_t*)(ws + WS_YS), 1024}; tail_gemm((const bf16_t*)(ws + WS_Z), W_SO, 2048, 32768, R2, T, wave); EpiBf16 E{(bf16_t*)(ws + WS_YS), 1024, 1.0f}; run_gemm(L, (const bf16_t*)(ws + WS_Z), W_SO, 32768, 1024, 2048, E, wave); } SEAM(9); }
#ifdef TIME_PHASE
        if (TIME_PHASE == 9) t_b = __builtin_amdgcn_s_memrealtime();
#endif
#ifdef TIME_PHASE
        if (TIME_PHASE == 10) t_a = __builtin_amdgcn_s_memrealtime();
#endif
        if (IN(10)) { {
            for (int gi = 0; gi < 3; ++gi) {
                const bf16_t* A = gi == 0 ? (const bf16_t*)(ws + WS_CQN) : (gi == 1 ? (const bf16_t*)(ws + WS_CKVB) : W_V);
                const bf16_t* B = gi == 0 ? W_UQ : (gi == 1 ? W_K : (const bf16_t*)(ws + WS_CKVB));
                const int M = gi == 0 ? R2 : (gi == 1 ? RK : 1024), N = gi == 0 ? 1536 : (gi == 1 ? 1024 : RK), K = gi == 0 ? 384 : 256;
                EpiBf16 E{gi == 0 ? (bf16_t*)(ws + WS_Q) : (gi == 1 ? (bf16_t*)(ws + WS_KN) : (bf16_t*)(ws + WS_VT)), N, gi == 0 ? QSCALE : 1.0f};
                run_gemm(L, A, B, M, N, K, E, wave);
            }
        } SEAM(10); }
#ifdef TIME_PHASE
        if (TIME_PHASE == 10) t_b = __builtin_amdgcn_s_memrealtime();
#endif
#ifdef TIME_PHASE
        if (TIME_PHASE == 11) t_a = __builtin_amdgcn_s_memrealtime();
#endif
        if (IN(11)) { p11_phase(a, L, wave); SEAM(11); }
#ifdef TIME_PHASE
        if (TIME_PHASE == 11) t_b = __builtin_amdgcn_s_memrealtime();
#endif
#ifdef TIME_PHASE
        if (TIME_PHASE == 12) t_a = __builtin_amdgcn_s_memrealtime();
#endif
        if (IN(12)) { { TIDS bf16_t* un = (bf16_t*)(ws + WS_Z); for (int row = gw; row < R2; row += 2 * NGW) { const int r1 = row + NGW; if (r1 < R2) norm_row2_bf16(hrow(rm, row), hrow(rm, r1), a.in[I_MIXN], un + (size_t)row * D, un + (size_t)r1 * D, lane); else norm_row_bf16(hrow(rm, row), a.in[I_MIXN], un + (size_t)row * D, lane); } } SEAM(12); }
#ifdef TIME_PHASE
        if (TIME_PHASE == 12) t_b = __builtin_amdgcn_s_memrealtime();
#endif
#ifdef TIME_PHASE
        if (TIME_PHASE == 13) t_a = __builtin_amdgcn_s_memrealtime();
#endif
        if (IN(13)) { { EpiGate E{(bf16_t*)(ws + WS_G), a.in[I_GBIAS]}; run_gemm(L, (const bf16_t*)(ws + WS_Z), W_IN + (size_t)5888 * 1024, R2, 2048, 1024, E, wave); } SEAM(13); }
#ifdef TIME_PHASE
        if (TIME_PHASE == 13) t_b = __builtin_amdgcn_s_memrealtime();
#endif
#ifdef TIME_PHASE
        if (TIME_PHASE == 14) t_a = __builtin_amdgcn_s_memrealtime();
#endif
        if (IN(14)) { { ElMerge T{(const bf16_t*)(ws + WS_G), (bf16_t*)(ws + WS_YS)}; tail_gemm((const bf16_t*)(ws + WS_O), W_MO, 1024, 32768, R2, T, wave); EpiMerge E{(const bf16_t*)(ws + WS_G), (bf16_t*)(ws + WS_YS)}; run_gemm(L, (const bf16_t*)(ws + WS_O), W_MO, 32768, 1024, 1024, E, wave); } SEAM(14); }
#ifdef TIME_PHASE
        if (TIME_PHASE == 14) t_b = __builtin_amdgcn_s_memrealtime();
#endif
#ifdef TIME_PHASE
        if (TIME_PHASE == 15) t_a = __builtin_amdgcn_s_memrealtime();
#endif
        if (IN(15)) { { ElResid T{rm, 1.0f, 1}; tail_gemm((const bf16_t*)(ws + WS_YS), W_MIX, 1024, 32768, R2, T, wave); EpiResid E{rm, 1.0f, 1}; run_gemm(L, (const bf16_t*)(ws + WS_YS), W_MIX, 32768, 1024, 1024, E, wave); } SEAM(15); }
#ifdef TIME_PHASE
        if (TIME_PHASE == 15) t_b = __builtin_amdgcn_s_memrealtime();
#endif
#ifdef TIME_PHASE
        if (TIME_PHASE == 16) t_a = __builtin_amdgcn_s_memrealtime();
#endif
        if (IN(16)) { { TIDS bf16_t* hn = (bf16_t*)(ws + WS_Z); for (int row = gw; row < R2; row += 2 * NGW) { const int r1 = row + NGW; if (r1 < R2) norm_row2_bf16(hrow(rm, row), hrow(rm, r1), a.in[I_F2N], hn + (size_t)row * D, hn + (size_t)r1 * D, lane); else norm_row_bf16(hrow(rm, row), a.in[I_F2N], hn + (size_t)row * D, lane); } } SEAM(16); }
#ifdef TIME_PHASE
        if (TIME_PHASE == 16) t_b = __builtin_amdgcn_s_memrealtime();
#endif
#ifdef TIME_PHASE
        if (TIME_PHASE == 17) t_a = __builtin_amdgcn_s_memrealtime();
#endif
        if (IN(17)) { { EpiSwiglu E{(bf16_t*)(ws + WS_ACT)}; run_gemm(L, (const bf16_t*)(ws + WS_Z), W_GU, R2, 2 * FFN, 1024, E, wave); } SEAM(17); }
#ifdef TIME_PHASE
        if (TIME_PHASE == 17) t_b = __builtin_amdgcn_s_memrealtime();
#endif
#ifdef TIME_PHASE
        if (TIME_PHASE == 18) t_a = __builtin_amdgcn_s_memrealtime();
#endif
        if (IN(18)) { { ElResid T{rm, 0.5f, 1}; tail_gemm((const bf16_t*)(ws + WS_ACT), W_D, FFN, 32768, R2, T, wave); EpiResid E{rm, 0.5f, 1}; run_gemm(L, (const bf16_t*)(ws + WS_ACT), W_D, 32768, 1024, FFN, E, wave); } SEAM(18); }
#ifdef TIME_PHASE
        if (TIME_PHASE == 18) t_b = __builtin_amdgcn_s_memrealtime();
#endif
#ifdef TIME_PHASE
        if (TIME_PHASE == 19) t_a = __builtin_amdgcn_s_memrealtime();
#endif
        if (IN(19)) { { TIDS
            for (int row = gw; row < R2; row += NGW) { float* hp = a.out + (size_t)row * D; f32x4 v[4]; float s = 0.f;
#pragma unroll
                for (int j = 0; j < 4; ++j) { v[j] = ((const f32x4*)hp)[lane + 64 * j]; s += v[j][0] * v[j][0] + v[j][1] * v[j][1] + v[j][2] * v[j][2] + v[j][3] * v[j][3]; }
                const float rs = rsqrtf(wave_sum(s) * (1.f / 1024.f) + EPS);
#pragma unroll
                for (int j = 0; j < 4; ++j) { const f32x4 g = ((const f32x4*)a.in[I_FINN])[lane + 64 * j]; ((f32x4*)hp)[lane + 64 * j] = v[j] * rs * g; } }
        } SEAM(19); }
#ifdef TIME_PHASE
        if (TIME_PHASE == 19) t_b = __builtin_amdgcn_s_memrealtime();
#endif
        }
    }
#ifdef TIME_PHASE
    if (blockIdx.x == 0 && threadIdx.x == 0) a.out[0] = (float)(t_b - t_a) * 0.01f;
#endif
    __builtin_amdgcn_fence(__ATOMIC_RELEASE, "agent");
}

#ifndef N_LAUNCH_MODE
#define N_LAUNCH_MODE 1
#endif
extern "C" void kernel_launch(void* const* d_in, const int* in_sizes, int n_in, void* d_out, int out_size, void* d_ws, size_t ws_size, hipStream_t stream) {
    static int grid = 0;
    if (grid == 0) {
        if (n_in != 30 || ws_size < WS_END) { fprintf(stderr, "kernel_launch: unexpected n_in %d / ws_size %zu (need %zu)\n", n_in, ws_size, (size_t)WS_END); grid = -1; return; }
        int dev = 0, cus = 0, per_cu = 0;
        hipGetDevice(&dev); hipDeviceGetAttribute(&cus, hipDeviceAttributeMultiprocessorCount, dev);
        if (hipFuncSetAttribute((const void*)fwd_megakernel, hipFuncAttributeMaxDynamicSharedMemorySize, LDS_BYTES) != hipSuccess) { fprintf(stderr, "kernel_launch: hipFuncSetAttribute failed\n"); grid = -1; return; }
        if (hipOccupancyMaxActiveBlocksPerMultiprocessor(&per_cu, (const void*)fwd_megakernel, 512, LDS_BYTES) != hipSuccess || per_cu < 1) per_cu = 1;
        (void)hipGetLastError();
        grid = cus * 1;
        if (grid <= 0) grid = 256;
    }
    if (grid < 0) return;
    Args a{};
    for (int i = 0; i < 30; ++i) a.in[i] = (const float*)d_in[i];
    a.out = (float*)d_out; a.ws = (unsigned char*)d_ws;
#if N_LAUNCH_MODE == 1
    a.ph_lo = 0; a.ph_hi = NPHASE;
    if (hipMemsetAsync((unsigned char*)d_ws + WS_BAR, 0, 8192, stream) != hipSuccess) { fprintf(stderr, "memset failed\n"); return; }
    void* args[] = {&a};
    hipError_t e = hipLaunchCooperativeKernel((const void*)fwd_megakernel, dim3(grid), dim3(512), args, LDS_BYTES, stream);
    if (e != hipSuccess) fprintf(stderr, "cooperative launch failed: %s (grid %d)\n", hipGetErrorString(e), grid);
#else
    for (int ph = 0; ph < NPHASE; ++ph) { a.ph_lo = ph; a.ph_hi = ph + 1; hipLaunchKernelGGL(fwd_megakernel, dim3(grid), dim3(512), LDS_BYTES, stream, a); }
#endif
}
```
